# Optimizing an MI355X kernel written in HIP

```python
import math
import jax, jax.numpy as jnp
from jax import lax
import numpy as np

D_MODEL = 2048
BATCH = 4
SEQ = 8192
DEPTH = 4

RET_HEADS = 8
RET_DK = D_MODEL // RET_HEADS
RET_DV = D_MODEL // RET_HEADS
RET_W = RET_HEADS * RET_DV
RET_CHUNK = 128
SGU_GROUPS = 8
SGU_W = D_MODEL
SGU_GC = SGU_W // SGU_GROUPS
SGU_CHUNK = 128
D_FF = 5632
ROPE_BASE = 10000.0
EPS = 1e-6
N_BRANCH = 2
IN_SPLITS = (RET_HEADS * RET_DK, RET_HEADS * RET_DK, RET_W, RET_W, SGU_W, SGU_W, D_MODEL, D_MODEL)
IN_COLS = sum(IN_SPLITS)

kernel_name = "hybrid_retention_sgu_macaron"


def _rmsnorm(x, g):
    xf = x.astype(jnp.float32)
    y = xf * lax.rsqrt(jnp.mean(xf * xf, axis=-1, keepdims=True) + EPS)
    return (y * g.astype(jnp.float32)).astype(x.dtype)


def _layernorm(x, g, axis_size_last=True):
    xf = x.astype(jnp.float32)
    mu = jnp.mean(xf, axis=-1, keepdims=True)
    var = jnp.mean(jnp.square(xf - mu), axis=-1, keepdims=True)
    y = (xf - mu) * lax.rsqrt(var + EPS)
    return y * g.astype(jnp.float32)


def _swiglu(x, w_gu, w_down):
    a, g = jnp.split(x @ w_gu, 2, axis=-1)
    return (jax.nn.silu(g) * a) @ w_down


def _rotary(x, positions):
    half = x.shape[-1] // 2
    inv = ROPE_BASE ** (-jnp.arange(half, dtype=jnp.float32) / half)
    ang = positions.astype(jnp.float32)[..., None] * inv
    cos = jnp.cos(ang)[:, :, None, :].astype(x.dtype)
    sin = jnp.sin(ang)[:, :, None, :].astype(x.dtype)
    x1, x2 = x[..., :half], x[..., half:]
    return jnp.concatenate([x1 * cos - x2 * sin, x1 * sin + x2 * cos], axis=-1)


def _retention(q, k, v):
    B, S, H, DK = q.shape
    DV = v.shape[-1]
    nc = S // RET_CHUNK
    dt = q.dtype
    log_gamma = jnp.log1p(-jnp.exp2(-5.0 - jnp.arange(H, dtype=jnp.float32)))
    idx = jnp.arange(RET_CHUNK, dtype=jnp.float32)
    diff = idx[:, None] - idx[None, :]
    causal = diff >= 0
    dmask = jnp.where(causal[None], jnp.exp(jnp.where(causal, diff, 0.0)[None] * log_gamma[:, None, None]), 0.0).astype(dt)
    xi = jnp.exp((idx[:, None] + 1.0) * log_gamma[None]).astype(dt)
    zeta = jnp.exp((RET_CHUNK - 1.0 - idx)[:, None] * log_gamma[None]).astype(dt)
    gamma_c = jnp.exp(RET_CHUNK * log_gamma).astype(dt)

    k = k * jnp.asarray(DK ** -0.5, dt)
    qc = q.reshape(B, nc, RET_CHUNK, H, DK)
    kc = k.reshape(B, nc, RET_CHUNK, H, DK)
    vc = v.reshape(B, nc, RET_CHUNK, H, DV)
    scores = jnp.einsum('bnihd,bnjhd->bnhij', qc, kc) * dmask
    intra = jnp.einsum('bnhij,bnjhe->bnihe', scores, vc)

    def step(R, inp):
        q_i, k_i, v_i = inp
        cross = jnp.einsum('bihd,bhde->bihe', q_i, R) * xi[None, :, :, None]
        R = R * gamma_c[None, :, None, None] + jnp.einsum('bjhd,bjhe->bhde', k_i * zeta[None, :, :, None], v_i)
        return R, cross

    R0 = jnp.zeros((B, H, DK, DV), dt)
    _, cross = lax.scan(step, R0, (jnp.moveaxis(qc, 1, 0), jnp.moveaxis(kc, 1, 0), jnp.moveaxis(vc, 1, 0)))
    cross = jnp.moveaxis(cross, 0, 1)
    return (intra + cross).reshape(B, S, H, DV)


def _spatial_gating(u, v, ln_g, w_s, b_s):
    B, S, _ = v.shape
    nc = S // SGU_CHUNK
    u = jax.nn.gelu(u, approximate=False)
    v = _layernorm(jax.nn.gelu(v, approximate=False), ln_g).astype(u.dtype)
    vg = v.reshape(B, nc, SGU_CHUNK, SGU_GROUPS, SGU_GC)
    tril = jnp.tril(jnp.ones((SGU_CHUNK, SGU_CHUNK), dtype=bool))
    w_m = jnp.where(tril[None], w_s, jnp.zeros((), w_s.dtype))
    mixed = jnp.einsum('gij,bnjgc->bnigc', w_m, vg) + b_s.T[None, None, :, :, None]
    return u * mixed.reshape(B, S, SGU_W)


def _layer(x, positions, ffn1_norm, ffn1_w_gu, ffn1_w_down, mix_norm, w_in, b_gate, ret_gn,
           sgu_ln, sgu_w, sgu_b, w_branch_ret, w_branch_sgu, w_out, ffn2_norm, ffn2_w_gu, ffn2_w_down):
    B, S, D = x.shape
    x = x + 0.5 * _swiglu(_rmsnorm(x, ffn1_norm), ffn1_w_gu, ffn1_w_down)
    h = _rmsnorm(x, mix_norm)
    proj = h @ w_in
    offs = list(np.cumsum(IN_SPLITS)[:-1])
    q, k, v, g_ret, u_s, v_s, gate_ret, gate_sgu = jnp.split(proj, offs, axis=-1)
    q = _rotary(q.reshape(B, S, RET_HEADS, RET_DK), positions)
    k = _rotary(k.reshape(B, S, RET_HEADS, RET_DK), positions)
    v = v.reshape(B, S, RET_HEADS, RET_DV)
    y_ret = _retention(q, k, v)
    y_ret = _layernorm(y_ret, ret_gn.reshape(RET_HEADS, RET_DV)).astype(x.dtype).reshape(B, S, RET_W)
    y_ret = jax.nn.silu(g_ret) * y_ret
    y_sgu = _spatial_gating(u_s, v_s, sgu_ln, sgu_w, sgu_b)
    gates = jax.nn.sigmoid(jnp.concatenate([gate_ret, gate_sgu], axis=-1) + b_gate)
    ga, gb = jnp.split(gates, 2, axis=-1)
    merged = ga * (y_ret @ w_branch_ret) + gb * (y_sgu @ w_branch_sgu)
    x = x + merged @ w_out
    x = x + 0.5 * _swiglu(_rmsnorm(x, ffn2_norm), ffn2_w_gu, ffn2_w_down)
    return x


def setup_inputs(seed: int = 0) -> dict:
    key = jax.random.key(seed)
    ks = jax.random.split(key, 20)
    L, D = DEPTH, D_MODEL

    def nrm(k, shape, scale):
        return jax.random.normal(k, shape, jnp.float32) * scale

    def gain(k, shape):
        return 1.0 + 0.02 * jax.random.normal(k, shape, jnp.float32)

    x = jax.random.normal(ks[0], (BATCH, SEQ, D), jnp.float32)
    positions = jnp.tile(jnp.arange(SEQ, dtype=jnp.int32)[None, :], (BATCH, 1))
    return {
        "x": x,
        "positions": positions,
        "ffn1_norm": gain(ks[1], (L, D)),
        "ffn1_w_gu": nrm(ks[2], (L, D, 2 * D_FF), D ** -0.5),
        "ffn1_w_down": nrm(ks[3], (L, D_FF, D), D_FF ** -0.5),
        "mix_norm": gain(ks[4], (L, D)),
        "w_in": nrm(ks[5], (L, D, IN_COLS), D ** -0.5),
        "b_gate": nrm(ks[6], (L, N_BRANCH * D), 0.02),
        "ret_gn": gain(ks[7], (L, RET_W)),
        "sgu_ln": gain(ks[8], (L, SGU_W)),
        "sgu_w": nrm(ks[9], (L, SGU_GROUPS, SGU_CHUNK, SGU_CHUNK), SGU_CHUNK ** -0.5),
        "sgu_b": gain(ks[10], (L, SGU_GROUPS, SGU_CHUNK)),
        "w_branch_ret": nrm(ks[11], (L, RET_W, D), RET_W ** -0.5),
        "w_branch_sgu": nrm(ks[12], (L, SGU_W, D), SGU_W ** -0.5),
        "w_out": nrm(ks[13], (L, D, D), D ** -0.5),
        "ffn2_norm": gain(ks[14], (L, D)),
        "ffn2_w_gu": nrm(ks[15], (L, D, 2 * D_FF), D ** -0.5),
        "ffn2_w_down": nrm(ks[16], (L, D_FF, D), D_FF ** -0.5),
        "final_norm": gain(ks[17], (D,)),
    }


def reference(x, positions, ffn1_norm, ffn1_w_gu, ffn1_w_down, mix_norm, w_in, b_gate, ret_gn,
              sgu_ln, sgu_w, sgu_b, w_branch_ret, w_branch_sgu, w_out, ffn2_norm, ffn2_w_gu,
              ffn2_w_down, final_norm):
    for l in range(DEPTH):
        x = _layer(x, positions, ffn1_norm[l], ffn1_w_gu[l], ffn1_w_down[l], mix_norm[l], w_in[l],
                   b_gate[l], ret_gn[l], sgu_ln[l], sgu_w[l], sgu_b[l], w_branch_ret[l],
                   w_branch_sgu[l], w_out[l], ffn2_norm[l], ffn2_w_gu[l], ffn2_w_down[l])
    return _rmsnorm(x, final_norm)
```

```cpp
#include <hip/hip_runtime.h>
#include <cstdio>
#include <cstdint>
#include <cmath>
namespace pg8 {
#define PG8_LAS __attribute__((address_space(3)))
typedef unsigned short bf16_t;
typedef short bf16x8 __attribute__((ext_vector_type(8)));
typedef float f32x4 __attribute__((ext_vector_type(4)));
typedef unsigned u32x4 __attribute__((ext_vector_type(4)));
constexpr int BM = 256, BK = 64, HALF = 128, HTB = HALF * BK * 2  , STAGE_BYTES = 8 * HTB, NXCD = 8, WGM = 8;

__host__ __device__ __forceinline__ int lds_byte(int r, int c) { const int st = (r >> 4) * 2 + (c >> 5), rr = r & 15, cc = c & 31, ob = rr * 64 + cc * 2; return st * 1024 + (ob ^ (((ob >> 9) & 1) << 5)); }
__host__ __device__ __forceinline__ void stage_rc(int b, int& R, int& C) { const int st = b / 1024, sb = b % 1024, swz = sb ^ (((sb >> 9) & 1) << 5); R = (st >> 1) * 16 + swz / 64; C = (st & 1) * 32 + (swz % 64) / 2; }
__host__ __device__ __forceinline__ int perm32(int rho) { const int n = rho >> 4, i = rho & 15; return 8 * (i >> 2) + 4 * n + (i & 3); }

struct Unit { int pm, pn; };
struct Gemm { const bf16_t* A; const bf16_t* Bt; int M, N, K; };

struct StaticOrder {
    int nM, nN, nwg, G, c;
    __host__ __device__ void init(int M, int N, int G_, int c_) { nM = M / BM; nN = N / BM; nwg = nM * nN; G = G_; c = c_; }
    __host__ __device__ bool next(int i, Unit& u) const {
        const long L = (long)i * G + c; if (L >= nwg) return false;
        int wgid = (int)L; { const int q = nwg / NXCD, r = nwg % NXCD, xcd = wgid % NXCD, off = wgid / NXCD; wgid = (xcd < r ? xcd * (q + 1) : r * (q + 1) + (xcd - r) * q) + off; }
        const int nig = WGM * nN, gid = wgid / nig, fm = gid * WGM, gsz = (nM - fm) < WGM ? (nM - fm) : WGM;
        u.pm = fm + ((wgid % nig) % gsz); u.pn = (wgid % nig) / gsz; return true;
    }
    __device__ __forceinline__ void a_ready(const Unit&) const {}
    __device__ __forceinline__ void done(const Unit&) const {}
};
__device__ __forceinline__ unsigned cvt_pk_bf16(float lo, float hi) { unsigned r; asm volatile("v_cvt_pk_bf16_f32 %0, %1, %2" : "=v"(r) : "v"(lo), "v"(hi)); return r; }
typedef float f32x2 __attribute__((ext_vector_type(2)));
__device__ __forceinline__ f32x2 gelu_pk(f32x2 v) {
    const f32x2 av = __builtin_elementwise_abs(v), d = av * 0.2316418882f + 1.0f;
    f32x2 t; t.x = __builtin_amdgcn_rcpf(d.x); t.y = __builtin_amdgcn_rcpf(d.y);
    f32x2 q = t * 0.5307027145f + (-0.7265760135f); q = q * t + 0.7107068705f; q = q * t + (-0.142248368f); q = q * t + 0.127414796f; q = q * t;
    const f32x2 s = (v * v) * (-0.72134752044f);
    f32x2 e; e.x = __builtin_amdgcn_exp2f(s.x); e.y = __builtin_amdgcn_exp2f(s.y);
    const f32x2 m = v * (q * e), r = v - m;
    f32x2 o; o.x = v.x < 0.f ? m.x : r.x; o.y = v.y < 0.f ? m.y : r.y; return o;
}

__device__ __forceinline__ float bf_lo(unsigned u) { return __uint_as_float(u << 16); }
__device__ __forceinline__ float bf_hi(unsigned u) { return __uint_as_float(u & 0xffff0000u); }
__device__ __forceinline__ float silu_f(float g) { return g * __builtin_amdgcn_rcpf(1.0f + __builtin_amdgcn_exp2f(-1.44269504f * g)); }
__device__ __forceinline__ float sigmoid_f(float g) { return __builtin_amdgcn_rcpf(1.0f + __builtin_amdgcn_exp2f(-1.44269504f * g)); }

struct EpiSwiglu {
    static constexpr bool PERM = true, AFTER_DRAIN = false;
    bf16_t* O; int ldc;
    __device__ __forceinline__ void operator()(const f32x4 (&acc)[2][2][4][2], const Unit& u, int wr, int wc, int fr, int fq) const {
        const int row0 = u.pm * BM + wr * 64 + fr, col0 = u.pn * HALF + wc * 32 + 8 * fq;
#pragma unroll
        for (int ai = 0; ai < 2; ++ai)
#pragma unroll
            for (int m = 0; m < 4; ++m) { bf16_t* rowp = O + (size_t)(row0 + ai * HALF + m * 16) * ldc + col0;
                const f32x4 a0 = acc[ai][0][m][0], a1 = acc[ai][0][m][1], g0 = acc[ai][1][m][0], g1 = acc[ai][1][m][1];
                u32x4 w; w.x = cvt_pk_bf16(a0[0] * silu_f(g0[0]), a0[1] * silu_f(g0[1])); w.y = cvt_pk_bf16(a0[2] * silu_f(g0[2]), a0[3] * silu_f(g0[3]));
                w.z = cvt_pk_bf16(a1[0] * silu_f(g1[0]), a1[1] * silu_f(g1[1])); w.w = cvt_pk_bf16(a1[2] * silu_f(g1[2]), a1[3] * silu_f(g1[3]));
                *(u32x4*)rowp = w; }
    }
};
struct EpiResid {
    static constexpr bool PERM = false, AFTER_DRAIN = false;
    float* X; int ldc; float scale;
    __device__ __forceinline__ void operator()(const f32x4 (&acc)[2][2][4][2], const Unit& u, int wr, int wc, int fr, int fq) const {
        const int row0 = u.pm * BM + wr * 64 + fr, col0 = u.pn * BM + wc * 32 + 4 * fq;
#pragma unroll
        for (int ai = 0; ai < 2; ++ai)
#pragma unroll
            for (int m = 0; m < 4; ++m) { float* rowp = X + (size_t)(row0 + ai * HALF + m * 16) * ldc + col0;
                f32x4 v[2][2];
#pragma unroll
                for (int bj = 0; bj < 2; ++bj)
#pragma unroll
                    for (int n = 0; n < 2; ++n) v[bj][n] = *(const f32x4*)(rowp + bj * HALF + n * 16);
#pragma unroll
                for (int bj = 0; bj < 2; ++bj)
#pragma unroll
                    for (int n = 0; n < 2; ++n) *(f32x4*)(rowp + bj * HALF + n * 16) = v[bj][n] + acc[ai][bj][m][n] * scale;
                asm volatile("" ::: "memory"); }
    }
};
struct EpiIn {
    static constexpr bool PERM = true, AFTER_DRAIN = false;
    bf16_t* O; size_t tstride; const float* cs; const float* bgate;
    __device__ __forceinline__ void operator()(const f32x4 (&acc)[2][2][4][2], const Unit& u, int wr, int wc, int fr, int fq) const {
        const int t = u.pn >> 3, hh = u.pn & 7;
        bf16_t* base = O + (size_t)t * tstride;
        const int row0 = u.pm * BM + wr * 64 + fr, cw = wc * 32 + 8 * fq, col0 = hh * BM + cw;
        if (t <= 1) {
            const float sc = (t == 1) ? 0.0625f : 1.0f;
#pragma unroll
            for (int ai = 0; ai < 2; ++ai)
#pragma unroll
                for (int m = 0; m < 4; ++m) { const int row = row0 + ai * HALF + m * 16;
                    const f32x4* cp = (const f32x4*)(cs + ((size_t)row * 128 + cw) * 2);
                    const f32x4 c0 = cp[0], c1 = cp[1], c2 = cp[2], c3 = cp[3];
                    const f32x4 xa0 = acc[ai][0][m][0], xa1 = acc[ai][0][m][1], xb0 = acc[ai][1][m][0], xb1 = acc[ai][1][m][1];
                    const float co[8] = {c0[0], c0[2], c1[0], c1[2], c2[0], c2[2], c3[0], c3[2]};
                    const float si[8] = {c0[1], c0[3], c1[1], c1[3], c2[1], c2[3], c3[1], c3[3]};
                    const float x1[8] = {xa0[0], xa0[1], xa0[2], xa0[3], xa1[0], xa1[1], xa1[2], xa1[3]};
                    const float x2[8] = {xb0[0], xb0[1], xb0[2], xb0[3], xb1[0], xb1[1], xb1[2], xb1[3]};
                    float o1[8], o2[8];
#pragma unroll
                    for (int j = 0; j < 8; ++j) { o1[j] = (x1[j] * co[j] - x2[j] * si[j]) * sc; o2[j] = (x1[j] * si[j] + x2[j] * co[j]) * sc; }
                    u32x4 w1, w2;
                    w1.x = cvt_pk_bf16(o1[0], o1[1]); w1.y = cvt_pk_bf16(o1[2], o1[3]); w1.z = cvt_pk_bf16(o1[4], o1[5]); w1.w = cvt_pk_bf16(o1[6], o1[7]);
                    w2.x = cvt_pk_bf16(o2[0], o2[1]); w2.y = cvt_pk_bf16(o2[2], o2[3]); w2.z = cvt_pk_bf16(o2[4], o2[5]); w2.w = cvt_pk_bf16(o2[6], o2[7]);
                    bf16_t* rowp = base + (size_t)row * 2048 + col0;
                    *(u32x4*)rowp = w1; *(u32x4*)(rowp + HALF) = w2;
                    asm volatile("" ::: "memory"); }
        } else {
            f32x4 bv[2][2];
#pragma unroll
            for (int bj = 0; bj < 2; ++bj)
#pragma unroll
                for (int n = 0; n < 2; ++n) bv[bj][n] = (t >= 6) ? *(const f32x4*)(bgate + (t - 6) * 2048 + col0 + bj * HALF + 4 * n) : (f32x4){0.f, 0.f, 0.f, 0.f};
#pragma unroll
            for (int ai = 0; ai < 2; ++ai)
#pragma unroll
                for (int m = 0; m < 4; ++m) { bf16_t* rowp = base + (size_t)(row0 + ai * HALF + m * 16) * 2048 + col0;
#pragma unroll
                    for (int bj = 0; bj < 2; ++bj) { f32x4 v0 = acc[ai][bj][m][0] + bv[bj][0], v1 = acc[ai][bj][m][1] + bv[bj][1];
                        if (t == 3) {
#pragma unroll
                            for (int j = 0; j < 4; ++j) { v0[j] = silu_f(v0[j]); v1[j] = silu_f(v1[j]); } }
                        else if (t == 4 || t == 5) { f32x2 a = gelu_pk((f32x2){v0[0], v0[1]}), b = gelu_pk((f32x2){v0[2], v0[3]}), c = gelu_pk((f32x2){v1[0], v1[1]}), d = gelu_pk((f32x2){v1[2], v1[3]});
                            v0 = (f32x4){a.x, a.y, b.x, b.y}; v1 = (f32x4){c.x, c.y, d.x, d.y}; }
                        else if (t >= 6) {
#pragma unroll
                            for (int j = 0; j < 4; ++j) { v0[j] = sigmoid_f(v0[j]); v1[j] = sigmoid_f(v1[j]); } }
                        u32x4 w; w.x = cvt_pk_bf16(v0[0], v0[1]); w.y = cvt_pk_bf16(v0[2], v0[3]); w.z = cvt_pk_bf16(v1[0], v1[1]); w.w = cvt_pk_bf16(v1[2], v1[3]);
                        *(u32x4*)(rowp + bj * HALF) = w; } }
        }
    }
};
template <int MODE> struct EpiBr {
    static constexpr bool PERM = true, AFTER_DRAIN = false;
    bf16_t* T; const bf16_t* gate;
    __device__ __forceinline__ void operator()(const f32x4 (&acc)[2][2][4][2], const Unit& u, int wr, int wc, int fr, int fq) const {
        const int row0 = u.pm * BM + wr * 64 + fr, col0 = u.pn * BM + wc * 32 + 8 * fq;
#pragma unroll
        for (int ai = 0; ai < 2; ++ai)
#pragma unroll
            for (int m = 0; m < 4; ++m) { const size_t off = (size_t)(row0 + ai * HALF + m * 16) * 2048 + col0;
#pragma unroll
                for (int bj = 0; bj < 2; ++bj) { const u32x4 gw = *(const u32x4*)(gate + off + bj * HALF);
                    const f32x4 a0 = acc[ai][bj][m][0], a1 = acc[ai][bj][m][1];
                    float o[8] = {a0[0] * bf_lo(gw.x), a0[1] * bf_hi(gw.x), a0[2] * bf_lo(gw.y), a0[3] * bf_hi(gw.y), a1[0] * bf_lo(gw.z), a1[1] * bf_hi(gw.z), a1[2] * bf_lo(gw.w), a1[3] * bf_hi(gw.w)};
                    if (MODE == 1) { const u32x4 pw = *(const u32x4*)(T + off + bj * HALF);
                        o[0] += bf_lo(pw.x); o[1] += bf_hi(pw.x); o[2] += bf_lo(pw.y); o[3] += bf_hi(pw.y); o[4] += bf_lo(pw.z); o[5] += bf_hi(pw.z); o[6] += bf_lo(pw.w); o[7] += bf_hi(pw.w); }
                    u32x4 w; w.x = cvt_pk_bf16(o[0], o[1]); w.y = cvt_pk_bf16(o[2], o[3]); w.z = cvt_pk_bf16(o[4], o[5]); w.w = cvt_pk_bf16(o[6], o[7]);
                    *(u32x4*)(T + off + bj * HALF) = w; }
                asm volatile("" ::: "memory"); }
    }
};
template <class Epi, class Sched, bool ALIGN_EPI = false, bool SP2 = false>
__device__ __forceinline__ void gemm_phase(PG8_LAS unsigned char* lds, const Gemm g, const Sched& S, const Epi& E) {
    int tid_l = threadIdx.x; asm volatile("" : "+v"(tid_l));
    const int tid = tid_l, wid = __builtin_amdgcn_readfirstlane(tid >> 6), lane = tid & 63, wr = wid >> 2, wc = wid & 3, fr = lane & 15, fq = lane >> 4;
    const int K = g.K, nt = K / BK;
    unsigned voffA[2], voffB[2];
#pragma unroll
    for (int i = 0; i < 2; ++i) { int R, C; stage_rc(tid * 16 + i * 8192, R, C); const int Rb = Epi::PERM ? ((R & ~31) + perm32(R & 31)) : R;
        voffA[i] = (unsigned)(R * K + C) * 2u; voffB[i] = (unsigned)(Rb * K + C) * 2u; }
    const size_t kstep = (size_t)(BK * 2);
    const size_t hstep = (size_t)HALF * K * 2;
    const size_t tstep = 2 * hstep;
    const unsigned ldsw = (unsigned)wid * 1024u;
    const int aoff = lds_byte(wr * 64 + fr, fq * 8), boff = lds_byte(wc * 32 + fr, fq * 8);
#define PG8_SA(b, h) (((b) * 2 + (h)) * HTB)
#define PG8_SB(b, h) ((4 + (b) * 2 + (h)) * HTB)
#define PG8_STAGE(bufoff, gbase, voff) do { _Pragma("unroll") for (int _i = 0; _i < 2; ++_i) \
        __builtin_amdgcn_global_load_lds((const unsigned*)((const char*)(gbase) + (voff)[_i]), (PG8_LAS unsigned*)(lds + (bufoff) + ldsw + _i * 8192), 16, 0, 0); } while (0)
#define PG8_LDA(dst, b, h) do { _Pragma("unroll") for (int m = 0; m < 4; ++m) _Pragma("unroll") for (int k = 0; k < 2; ++k) dst[m][k] = *(const PG8_LAS bf16x8*)(lds + PG8_SA(b, h) + aoff + m * 2048 + k * 1024); } while (0)
#define PG8_LDB(dst, b, h) do { _Pragma("unroll") for (int n = 0; n < 2; ++n) _Pragma("unroll") for (int k = 0; k < 2; ++k) dst[n][k] = *(const PG8_LAS bf16x8*)(lds + PG8_SB(b, h) + boff + n * 2048 + k * 1024); } while (0)
#define PG8_MMA(ai, bj, At, Bt) do { __builtin_amdgcn_s_setprio(1); _Pragma("unroll") for (int m = 0; m < 4; ++m) _Pragma("unroll") for (int n = 0; n < 2; ++n) _Pragma("unroll") for (int k = 0; k < 2; ++k) \
        acc[ai][bj][m][n] = __builtin_amdgcn_mfma_f32_16x16x32_bf16(Bt[n][k], At[m][k], acc[ai][bj][m][n], 0, 0, 0); __builtin_amdgcn_s_setprio(0); } while (0)
#define PG8_WAIT_V(n) asm volatile("s_waitcnt vmcnt(" #n ")" ::: "memory")
#define PG8_WAIT_L(n) asm volatile("s_waitcnt lgkmcnt(" #n ")" ::: "memory")
#define PG8_BAR __builtin_amdgcn_s_barrier()
#define PG8_SCHED __builtin_amdgcn_sched_barrier(0)
    Unit cur, nxt; int ui = 0;
    if (!S.next(0, cur)) return;
    f32x4 acc[2][2][4][2];
#pragma unroll
    for (int a = 0; a < 2; ++a)
#pragma unroll
        for (int b = 0; b < 2; ++b)
#pragma unroll
            for (int m = 0; m < 4; ++m)
#pragma unroll
                for (int n = 0; n < 2; ++n) acc[a][b][m][n] = (f32x4){0.f, 0.f, 0.f, 0.f};
    bf16x8 At[4][2], B0[2][2], B1[2][2];
    const char* cA = (const char*)g.A + (size_t)cur.pm * tstep; const char* cB = (const char*)g.Bt + (size_t)cur.pn * tstep;
    S.a_ready(cur);
    if constexpr (SP2) {
        PG8_STAGE(PG8_SB(0, 0), cB, voffB); PG8_STAGE(PG8_SB(0, 1), cB + hstep, voffB); PG8_STAGE(PG8_SA(0, 0), cA, voffA); PG8_STAGE(PG8_SA(0, 1), cA + hstep, voffA);
        if (wr == 1) PG8_BAR;
        PG8_WAIT_V(2); PG8_BAR;
        PG8_STAGE(PG8_SB(1, 0), cB + kstep, voffB); PG8_STAGE(PG8_SA(1, 0), cA + kstep, voffA); PG8_STAGE(PG8_SB(1, 1), cB + hstep + kstep, voffB);
        PG8_WAIT_V(6); PG8_BAR;
    } else {
        PG8_STAGE(PG8_SB(0, 0), cB, voffB); PG8_STAGE(PG8_SA(0, 0), cA, voffA); PG8_STAGE(PG8_SB(0, 1), cB + hstep, voffB); PG8_STAGE(PG8_SA(0, 1), cA + hstep, voffA);
        if (wr == 1) PG8_BAR;
        PG8_WAIT_V(4); PG8_BAR;
        PG8_STAGE(PG8_SB(1, 0), cB + kstep, voffB); PG8_STAGE(PG8_SA(1, 0), cA + kstep, voffA); PG8_STAGE(PG8_SB(1, 1), cB + hstep + kstep, voffB);
        PG8_WAIT_V(6); PG8_BAR;
    }
    for (;;) {
        const bool has_next = S.next(ui + 1, nxt);
        const char* nA = has_next ? (const char*)g.A + (size_t)nxt.pm * tstep : cA; const char* nB = has_next ? (const char*)g.Bt + (size_t)nxt.pn * tstep : cB;
        for (int t = 0; t < nt; t += 2) {
            const bool last = (t == nt - 2);
            const char* a1 = cA + (size_t)(t + 1) * kstep;
            const char* a2 = last ? nA : cA + (size_t)(t + 2) * kstep; const char* b2 = last ? nB : cB + (size_t)(t + 2) * kstep;
            const char* a3 = a2 + kstep; const char* b3 = b2 + kstep;
            if (last && has_next) S.a_ready(nxt);
            if constexpr (SP2) {
            PG8_LDB(B0, 0, 0); PG8_LDB(B1, 0, 1); PG8_SCHED; PG8_LDA(At, 0, 0); PG8_STAGE(PG8_SA(1, 1), a1 + hstep, voffA);
            PG8_WAIT_V(8); PG8_WAIT_L(0); PG8_BAR; PG8_MMA(0, 0, At, B0); PG8_MMA(0, 1, At, B1); PG8_BAR; PG8_SCHED;
            PG8_LDA(At, 0, 1); PG8_STAGE(PG8_SB(0, 0), b2, voffB); PG8_STAGE(PG8_SB(0, 1), b2 + hstep, voffB); PG8_STAGE(PG8_SA(0, 0), a2, voffA);
            PG8_WAIT_V(8); PG8_WAIT_L(0); PG8_BAR; PG8_MMA(1, 0, At, B0); PG8_MMA(1, 1, At, B1); PG8_BAR; PG8_SCHED;
            PG8_LDB(B0, 1, 0); PG8_LDB(B1, 1, 1); PG8_SCHED; PG8_LDA(At, 1, 0); PG8_STAGE(PG8_SA(0, 1), a2 + hstep, voffA);
            PG8_WAIT_V(8); PG8_WAIT_L(0); PG8_BAR; PG8_MMA(0, 0, At, B0); PG8_MMA(0, 1, At, B1); PG8_BAR; PG8_SCHED;
            PG8_LDA(At, 1, 1); PG8_STAGE(PG8_SB(1, 0), b3, voffB); PG8_STAGE(PG8_SB(1, 1), b3 + hstep, voffB); PG8_STAGE(PG8_SA(1, 0), a3, voffA);
            PG8_WAIT_V(8); PG8_WAIT_L(0); PG8_BAR; PG8_MMA(1, 0, At, B0); PG8_MMA(1, 1, At, B1); PG8_BAR; PG8_SCHED;
            } else {
            PG8_LDB(B0, 0, 0); PG8_SCHED; PG8_LDA(At, 0, 0); PG8_STAGE(PG8_SA(1, 1), a1 + hstep, voffA);
            PG8_WAIT_L(8); PG8_BAR; PG8_WAIT_L(0); PG8_MMA(0, 0, At, B0); PG8_BAR; PG8_SCHED;
            PG8_LDB(B1, 0, 1); PG8_STAGE(PG8_SB(0, 0), b2, voffB);
            PG8_BAR; PG8_WAIT_L(0); PG8_MMA(0, 1, At, B1); PG8_BAR;
            PG8_LDA(At, 0, 1); PG8_STAGE(PG8_SA(0, 0), a2, voffA);
            PG8_BAR; PG8_WAIT_L(0); PG8_MMA(1, 0, At, B0); PG8_BAR; PG8_SCHED;
            PG8_STAGE(PG8_SB(0, 1), b2 + hstep, voffB);
            PG8_WAIT_V(6); PG8_BAR; PG8_MMA(1, 1, At, B1); PG8_BAR;
            PG8_LDB(B0, 1, 0); PG8_SCHED; PG8_LDA(At, 1, 0); PG8_STAGE(PG8_SA(0, 1), a2 + hstep, voffA);
            PG8_WAIT_L(8); PG8_BAR; PG8_WAIT_L(0); PG8_MMA(0, 0, At, B0); PG8_BAR; PG8_SCHED;
            PG8_LDB(B1, 1, 1); PG8_STAGE(PG8_SB(1, 0), b3, voffB);
            PG8_BAR; PG8_WAIT_L(0); PG8_MMA(0, 1, At, B1); PG8_BAR;
            PG8_LDA(At, 1, 1); PG8_STAGE(PG8_SA(1, 0), a3, voffA);
            PG8_BAR; PG8_WAIT_L(0); PG8_MMA(1, 0, At, B0); PG8_BAR; PG8_SCHED;
            PG8_STAGE(PG8_SB(1, 1), b3 + hstep, voffB);
            PG8_WAIT_V(6); PG8_BAR; PG8_MMA(1, 1, At, B1); PG8_BAR;
            }
        }
        if constexpr (ALIGN_EPI) { if (wr == 0) PG8_BAR; }
        if constexpr (!Epi::AFTER_DRAIN) { E(acc, cur, wr, wc, fr, fq); S.done(cur); }
        if (!has_next) break;
#pragma unroll
        for (int a = 0; a < 2; ++a)
#pragma unroll
            for (int b = 0; b < 2; ++b)
#pragma unroll
                for (int m = 0; m < 4; ++m)
#pragma unroll
                    for (int n = 0; n < 2; ++n) acc[a][b][m][n] = (f32x4){0.f, 0.f, 0.f, 0.f};
        cur = nxt; cA = nA; cB = nB; ++ui;
        if constexpr (ALIGN_EPI) { if (wr == 1) PG8_BAR; }
    }
    PG8_WAIT_V(0);
    if constexpr (!ALIGN_EPI) { if (wr == 0) PG8_BAR; }
    PG8_BAR;
    if constexpr (Epi::AFTER_DRAIN) { E.fused(acc, cur, wr, wc, fr, fq, lds, wid, lane); S.done(cur); }
#undef PG8_SA
#undef PG8_SB
#undef PG8_STAGE
#undef PG8_LDA
#undef PG8_LDB
#undef PG8_MMA
#undef PG8_WAIT_V
#undef PG8_WAIT_L
#undef PG8_BAR
#undef PG8_SCHED
}
}
#define GAS __attribute__((address_space(1)))
#define LAS __attribute__((address_space(3)))
typedef unsigned short bf16;
typedef unsigned v4u __attribute__((ext_vector_type(4)));
typedef float f32x4 __attribute__((ext_vector_type(4)));
typedef short bf16x8 __attribute__((ext_vector_type(8)));
typedef GAS unsigned gu32;
typedef GAS unsigned long long gu64;
#define RLX_AGENT __ATOMIC_RELAXED, __HIP_MEMORY_SCOPE_AGENT
#define LDS_WAIT() asm volatile("s_waitcnt lgkmcnt(0)" ::: "memory")
#define VM_WAIT() asm volatile("s_waitcnt vmcnt(0)" ::: "memory")
__device__ __forceinline__ unsigned long long rt() { return __builtin_amdgcn_s_memrealtime(); }
__device__ __forceinline__ unsigned f2bf(float f) { unsigned u = __builtin_bit_cast(unsigned, f); return (u + 0x7fffu + ((u >> 16) & 1u)) >> 16; }
__device__ __forceinline__ unsigned pk2(float lo, float hi) { return f2bf(lo) | (f2bf(hi) << 16); }
#define XB_TMO      128
#define XB_XCNT(j)  (256  + 64 * (j))
#define XB_XSUB(j)  (1280 + 64 * (j))
#define XB_XGEN(j)  (2304 + 64 * (j))
#define XB_TOP      3328
#define XB_TOPGEN   3392
#define XCD_BAR_WORDS 3456
#define XB_SPIN_CAP (1u << 18)

__device__ __forceinline__ unsigned xb_ld(unsigned* p)              { return __hip_atomic_load(p, __ATOMIC_RELAXED, __HIP_MEMORY_SCOPE_AGENT); }
__device__ __forceinline__ unsigned xb_add(unsigned* p, unsigned v) { return __hip_atomic_fetch_add(p, v, __ATOMIC_RELAXED, __HIP_MEMORY_SCOPE_AGENT); }
__device__ __forceinline__ unsigned xb_xcc_id() { return (unsigned)__builtin_amdgcn_s_getreg((3 << 11) | 20) & 0xFu; }
#define XB_SPIN(cond, bar) do { unsigned _sp = 0; while (cond) { __builtin_amdgcn_s_sleep(1); \
    if ((++_sp & 255u) == 0u) { if (xb_ld(&(bar)[XB_TMO])) break; if (_sp > XB_SPIN_CAP) { atomicAdd(&(bar)[XB_TMO], 1u); break; } } } } while (0)

struct XcdBarrier {
    unsigned* bar; unsigned x;
    volatile LAS unsigned* st;
};

__device__ __forceinline__ XcdBarrier xcd_barrier_post(unsigned* bar, volatile LAS unsigned* st) {
    XcdBarrier b; b.bar = bar; b.x = xb_xcc_id(); b.st = st;
    if (threadIdx.x == 0) (void)xb_add(&bar[XB_XCNT(b.x)], 1u);
    return b;
}
__device__ __forceinline__ void xcd_barrier_complete(unsigned* bar, unsigned x, unsigned& nloc, unsigned& nx) {
    const unsigned G = gridDim.x * gridDim.y * gridDim.z;
    unsigned sum, cnt, mine, sp = 0u;
    for (;;) {
        sum = 0u; cnt = 0u; mine = 0u;
#pragma unroll
        for (unsigned j = 0; j < 16; ++j) { const unsigned c = xb_ld(&bar[XB_XCNT(j)]); sum += c; cnt += (c > 0u) ? 1u : 0u; mine = (j == x) ? c : mine; }
        if (sum == G) break;
        __builtin_amdgcn_s_sleep(1);
        if ((++sp & 255u) == 0u) { if (xb_ld(&bar[XB_TMO])) break; if (sp > XB_SPIN_CAP) { atomicAdd(&bar[XB_TMO], 1u); break; } }
    }
    nloc = mine > 0u ? mine : 1u; nx = cnt > 0u ? cnt : 1u;
}

__device__ __forceinline__ void xcd_barrier(const XcdBarrier& b) {
    asm volatile("s_waitcnt vmcnt(0)" ::: "memory");
    __syncthreads();
    if (threadIdx.x == 0) {
        unsigned* bar = b.bar;
        __builtin_amdgcn_s_waitcnt(0);
        unsigned nloc = b.st[0], nx = b.st[1];
        if (nloc == 0u) { xcd_barrier_complete(bar, b.x, nloc, nx); b.st[0] = nloc; b.st[1] = nx; }
        const unsigned old = xb_add(&bar[XB_XSUB(b.x)], 1u);
        const unsigned gen = old / nloc;
        if (old + 1u == (gen + 1u) * nloc) {
            __builtin_amdgcn_fence(__ATOMIC_RELEASE, "agent");
            asm volatile("s_waitcnt vmcnt(0)" ::: "memory");
            const unsigned og = xb_add(&bar[XB_TOP], 1u);
            const unsigned tg = og / nx;
            if (og + 1u == (tg + 1u) * nx) xb_add(&bar[XB_TOPGEN], 1u);
            else XB_SPIN(xb_ld(&bar[XB_TOPGEN]) == tg, bar);
            __builtin_amdgcn_fence(__ATOMIC_ACQUIRE, "agent");
            xb_add(&bar[XB_XGEN(b.x)], 1u);
            asm volatile("s_waitcnt vmcnt(0)" ::: "memory");
        } else {
            XB_SPIN(xb_ld(&bar[XB_XGEN(b.x)]) == gen, bar);
            __builtin_amdgcn_fence(__ATOMIC_ACQUIRE, "agent");
            asm volatile("s_waitcnt vmcnt(0)" ::: "memory");
        }
    }
    __syncthreads();
}

constexpr int NWAVES = 8;
constexpr int BATCH = 4, SEQ = 8192, D = 2048, DEPTH = 4, HEADS = 8, FF = 5632, INCOLS = 16384, NCHUNK = SEQ / 128;
constexpr int M = BATCH * SEQ;
constexpr float EPS = 1e-6f;
constexpr size_t MiB = 1u << 20;
constexpr size_t WS_CTL = 0, CTL_ZERO_BYTES = 1 * MiB;
constexpr size_t WS_CS = 1 * MiB;
constexpr size_t WS_WMASK = 33 * MiB;
constexpr size_t WS_WGU1 = 34 * MiB, WS_WD1 = 78 * MiB, WS_WIN = 100 * MiB, WS_WBR = 164 * MiB, WS_WBS = 172 * MiB, WS_WOUT = 180 * MiB, WS_WGU2 = 188 * MiB, WS_WD2 = 232 * MiB;
constexpr size_t WS_H = 256 * MiB;
constexpr size_t WS_BIG = 384 * MiB;
constexpr size_t WS_RT = 1408 * MiB;
constexpr size_t WS_END = 1664 * MiB;
constexpr size_t TSTRIDE = (size_t)M * 2048;
constexpr int CW_BAR = 4096;
constexpr int RING_BYTES = 131072;
constexpr int LDSCTL_OFF = RING_BYTES, MISC_OFF = LDSCTL_OFF + 320;
constexpr int LDS_BYTES = 147456;

typedef short s16x4 __attribute__((ext_vector_type(4)));
typedef short v4i16_t __attribute__((ext_vector_type(4)));
typedef unsigned u32x2 __attribute__((ext_vector_type(2)));
typedef float f32x2v __attribute__((ext_vector_type(2)));

__device__ __forceinline__ float wave_sum(float v) {
#pragma unroll
    for (int o = 1; o < 64; o <<= 1) v += __shfl_xor(v, o);
    return v;
}
__device__ __forceinline__ unsigned cvtpk(float lo, float hi) { unsigned r; asm volatile("v_cvt_pk_bf16_f32 %0, %1, %2" : "=v"(r) : "v"(lo), "v"(hi)); return r; }
__device__ __forceinline__ float bflo(unsigned u) { return __uint_as_float(u << 16); }
__device__ __forceinline__ float bfhi(unsigned u) { return __uint_as_float(u & 0xffff0000u); }
__device__ __forceinline__ s16x4 vtr(const LAS unsigned char* p) { return __builtin_bit_cast(s16x4, __builtin_amdgcn_ds_read_tr16_b64_v4i16((LAS v4i16_t*)p)); }
__device__ __forceinline__ bf16x8 lds_tr_frag(const LAS unsigned char* tile, int strideB, int k0, int c0, int lane) {
    const int g = lane >> 4, q = (lane & 15) >> 2, p = lane & 3;
    const LAS unsigned char* a = tile + (k0 + 8 * g + q) * strideB + (c0 + 4 * p) * 2;
    const s16x4 lo = vtr(a), hi = vtr(a + 4 * strideB);
    return __builtin_shufflevector(lo, hi, 0, 1, 2, 3, 4, 5, 6, 7);
}
#define MFMA16(a, b, c) __builtin_amdgcn_mfma_f32_16x16x32_bf16((a), (b), (c), 0, 0, 0)
__device__ __forceinline__ float log2_gamma(int h) {
    const float x = __builtin_amdgcn_exp2f(-5.0f - (float)h);
    const float l = -x * (1.0f + x * (0.5f + x * (0.33333334f + x * (0.25f + x * (0.2f + x * 0.16666667f)))));
    return l * 1.44269504f;
}

__device__ __forceinline__ void conv_item(const float* W, int K, int N, bf16* WT, int mode, LAS float* scr, int item, int lane) {
    const int nblk = N / 32, kb = item / nblk, nb = item % nblk, k0 = 64 * kb, n0 = 32 * nb;
#pragma unroll 8
    for (int i = 0; i < 32; ++i) { const int kk = 2 * i + (lane >> 5); scr[kk * 33 + (lane & 31)] = W[(size_t)(k0 + kk) * N + n0 + (lane & 31)]; }
    LDS_WAIT(); asm volatile("" ::: "memory");
    int r0 = n0;
    if (mode == 1) { const int isg = n0 >= FF, j0 = isg ? n0 - FF : n0; r0 = 256 * (j0 >> 7) + (j0 & 127) + (isg ? 128 : 0); }
    const int c = lane & 7;
#pragma unroll
    for (int j = 0; j < 4; ++j) { const int n = (lane >> 3) + 8 * j; const LAS float* s = scr + (8 * c) * 33 + n;
        v4u o; o.x = pk2(s[0 * 33], s[1 * 33]); o.y = pk2(s[2 * 33], s[3 * 33]); o.z = pk2(s[4 * 33], s[5 * 33]); o.w = pk2(s[6 * 33], s[7 * 33]);
        *(GAS v4u*)(WT + (size_t)(r0 + n) * K + k0 + 8 * c) = o; }
    LDS_WAIT(); asm volatile("" ::: "memory");
}
struct ConvSrc { const float *gu1, *d1, *win, *br, *bs, *wo, *gu2, *d2, *sw; };
__device__ __forceinline__ void phase_conv(LAS unsigned char* lds, unsigned char* ws, const ConvSrc& s, int gw, int NGW, int wave, int lane) {
    asm volatile("" : "+v"(lane));
    LAS float* scr = (LAS float*)(lds + wave * 16384);
    constexpr int I_GU = (D / 64) * (2 * FF / 32), I_D = (FF / 64) * (D / 32), I_IN = (D / 64) * (INCOLS / 32), I_SQ = (D / 64) * (D / 32);
    constexpr int NITEMS = 2 * I_GU + 2 * I_D + I_IN + 3 * I_SQ;
    for (int it = gw; it < NITEMS; it += NGW) {
        int r = it;
        if (r < I_GU) { conv_item(s.gu1, D, 2 * FF, (bf16*)(ws + WS_WGU1), 1, scr, r, lane); continue; } r -= I_GU;
        if (r < I_GU) { conv_item(s.gu2, D, 2 * FF, (bf16*)(ws + WS_WGU2), 1, scr, r, lane); continue; } r -= I_GU;
        if (r < I_D) { conv_item(s.d1, FF, D, (bf16*)(ws + WS_WD1), 0, scr, r, lane); continue; } r -= I_D;
        if (r < I_D) { conv_item(s.d2, FF, D, (bf16*)(ws + WS_WD2), 0, scr, r, lane); continue; } r -= I_D;
        if (r < I_IN) { conv_item(s.win, D, INCOLS, (bf16*)(ws + WS_WIN), 0, scr, r, lane); continue; } r -= I_IN;
        if (r < I_SQ) { conv_item(s.br, D, D, (bf16*)(ws + WS_WBR), 0, scr, r, lane); continue; } r -= I_SQ;
        if (r < I_SQ) { conv_item(s.bs, D, D, (bf16*)(ws + WS_WBS), 0, scr, r, lane); continue; } r -= I_SQ;
        conv_item(s.wo, D, D, (bf16*)(ws + WS_WOUT), 0, scr, r, lane);
    }
    bf16* wm = (bf16*)(ws + WS_WMASK);
    for (int e = gw * 64 + lane; e < 8 * 128 * 128; e += NGW * 64) { const int j = e & 127, i = (e >> 7) & 127; wm[e] = (bf16)((j <= i) ? f2bf(s.sw[e]) : 0u); }
}
__device__ __forceinline__ void phase_rms(const float* X, const float* gain, bf16* Ho, int gw, int NGW, int lane) {
    asm volatile("" : "+v"(lane));
    f32x4 gv[8];
#pragma unroll
    for (int j = 0; j < 8; ++j) gv[j] = ((const f32x4*)gain)[lane + 64 * j];
    for (int m = gw; m < M; m += NGW) {
        const f32x4* xr = (const f32x4*)(X + (size_t)m * D) + lane;
        f32x4 v[8]; float s = 0.f;
#pragma unroll
        for (int j = 0; j < 8; ++j) { v[j] = xr[64 * j]; s += (v[j][0] * v[j][0] + v[j][1] * v[j][1]) + (v[j][2] * v[j][2] + v[j][3] * v[j][3]); }
        const float rs = 1.0f / sqrtf(wave_sum(s) * (1.0f / D) + EPS);
        u32x2* o8 = (u32x2*)(Ho + (size_t)m * D) + lane;
#pragma unroll
        for (int j = 0; j < 8; ++j) { const f32x4 y = v[j] * rs * gv[j]; u32x2 w; w.x = cvtpk(y[0], y[1]); w.y = cvtpk(y[2], y[3]); o8[64 * j] = w; }
    }
}
__device__ __forceinline__ void phase_final(float* X, const float* gain, int gw, int NGW, int lane) {
    asm volatile("" : "+v"(lane));
    f32x4 gv[8];
#pragma unroll
    for (int j = 0; j < 8; ++j) gv[j] = ((const f32x4*)gain)[lane + 64 * j];
    for (int m = gw; m < M; m += NGW) {
        f32x4* xr = (f32x4*)(X + (size_t)m * D) + lane;
        f32x4 v[8]; float s = 0.f;
#pragma unroll
        for (int j = 0; j < 8; ++j) { v[j] = xr[64 * j]; s += (v[j][0] * v[j][0] + v[j][1] * v[j][1]) + (v[j][2] * v[j][2] + v[j][3] * v[j][3]); }
        const float rs = 1.0f / sqrtf(wave_sum(s) * (1.0f / D) + EPS);
#pragma unroll
        for (int j = 0; j < 8; ++j) xr[64 * j] = v[j] * rs * gv[j];
    }
}
__device__ __forceinline__ void phase_sguln(bf16* VS, const float* gain, int gw, int NGW, int lane) {
    asm volatile("" : "+v"(lane));
    for (int m = gw; m < M; m += NGW) {
        v4u* vr = (v4u*)(VS + (size_t)m * 2048) + lane;
        float x[4][8]; float s = 0.f;
#pragma unroll
        for (int j = 0; j < 4; ++j) { const v4u w = vr[64 * j];
            x[j][0] = bflo(w.x); x[j][1] = bfhi(w.x); x[j][2] = bflo(w.y); x[j][3] = bfhi(w.y); x[j][4] = bflo(w.z); x[j][5] = bfhi(w.z); x[j][6] = bflo(w.w); x[j][7] = bfhi(w.w);
#pragma unroll
            for (int e = 0; e < 8; ++e) s += x[j][e]; }
        const float mean = wave_sum(s) * (1.0f / 2048.0f); float q = 0.f;
#pragma unroll
        for (int j = 0; j < 4; ++j)
#pragma unroll
            for (int e = 0; e < 8; ++e) { x[j][e] -= mean; q += x[j][e] * x[j][e]; }
        const float rstd = 1.0f / sqrtf(wave_sum(q) * (1.0f / 2048.0f) + EPS);
#pragma unroll
        for (int j = 0; j < 4; ++j) { const f32x4 g0 = *(const f32x4*)(gain + (lane + 64 * j) * 8), g1 = *(const f32x4*)(gain + (lane + 64 * j) * 8 + 4);
            v4u w; w.x = cvtpk(x[j][0] * rstd * g0[0], x[j][1] * rstd * g0[1]); w.y = cvtpk(x[j][2] * rstd * g0[2], x[j][3] * rstd * g0[3]);
            w.z = cvtpk(x[j][4] * rstd * g1[0], x[j][5] * rstd * g1[1]); w.w = cvtpk(x[j][6] * rstd * g1[2], x[j][7] * rstd * g1[3]);
            vr[64 * j] = w; }
    }
}
__device__ __forceinline__ void phase_sgumix(LAS unsigned char* lds, const bf16* WM, const bf16* VS, bf16* U, const float* sb, int vcu, int G, int tid) {
    asm volatile("" : "+v"(tid));
    const int lane = tid & 63, w = __builtin_amdgcn_readfirstlane(tid >> 6), i16 = lane & 15, g4 = lane >> 4;
    LAS unsigned char* W_t = lds;
    LAS unsigned char* V_t = lds + 34816;
    for (int u = vcu; u < BATCH * NCHUNK * 8; u += G) {
        const int g = u & 7; const size_t t0 = (size_t)(u >> 3) * 128; const int c0 = g * 256;
#pragma unroll
        for (int k = 0; k < 4; ++k) { const int c = tid + 512 * k, row = c >> 4, part = c & 15;
            *(LAS v4u*)(W_t + row * 272 + part * 16) = *(const v4u*)(WM + (size_t)g * 16384 + row * 128 + part * 8); }
#pragma unroll
        for (int k = 0; k < 8; ++k) { const int c = tid + 512 * k, row = c >> 5, part = c & 31;
            *(LAS v4u*)(V_t + row * 528 + part * 16) = *(const v4u*)(VS + (t0 + row) * 2048 + c0 + part * 8); }
        __syncthreads();
        f32x4 acc[2][8];
#pragma unroll
        for (int a = 0; a < 2; ++a)
#pragma unroll
            for (int b = 0; b < 8; ++b) acc[a][b] = (f32x4){0.f, 0.f, 0.f, 0.f};
#pragma unroll
        for (int ks = 0; ks < 4; ++ks) {
            const bf16x8 vf0 = lds_tr_frag(V_t, 528, 32 * ks, 32 * w, lane), vf1 = lds_tr_frag(V_t, 528, 32 * ks, 32 * w + 16, lane);
#pragma unroll
            for (int ib = 0; ib < 8; ++ib) if (2 * ks <= ib) {
                const bf16x8 wf = *(const LAS bf16x8*)(W_t + (16 * ib + i16) * 272 + (32 * ks + 8 * g4) * 2);
                acc[0][ib] = MFMA16(vf0, wf, acc[0][ib]); acc[1][ib] = MFMA16(vf1, wf, acc[1][ib]); }
        }
#pragma unroll
        for (int ib = 0; ib < 8; ++ib) { const int i = 16 * ib + i16; const float bias = sb[g * 128 + i];
#pragma unroll
            for (int cb = 0; cb < 2; ++cb) { u32x2* up = (u32x2*)(U + (t0 + i) * 2048 + c0 + 32 * w + 16 * cb + 4 * g4);
                const u32x2 uw = *up; const f32x4 a = acc[cb][ib];
                u32x2 o; o.x = cvtpk(bflo(uw.x) * (a[0] + bias), bfhi(uw.x) * (a[1] + bias)); o.y = cvtpk(bflo(uw.y) * (a[2] + bias), bfhi(uw.y) * (a[3] + bias));
                *up = o; } }
        __syncthreads();
    }
}
__device__ __forceinline__ void phase_retstate(LAS unsigned char* lds, const bf16* Kb, const bf16* V, bf16* RT, int vcu, int G, int tid) {
    asm volatile("" : "+v"(tid));
    const int lane = tid & 63, w = __builtin_amdgcn_readfirstlane(tid >> 6), i16 = lane & 15, g4 = lane >> 4;
    LAS unsigned char* K_t = lds;
    LAS unsigned char* V_t = lds + 67584;
    for (int u = vcu; u < BATCH * HEADS * 8; u += G) {
        const int es = u & 7, h = (u >> 3) & 7, b = u >> 6, hc = h * 256;
        const float lg2 = log2_gamma(h), gamma_c = __builtin_amdgcn_exp2f(128.0f * lg2);
        f32x4 r[2][2];
#pragma unroll
        for (int a = 0; a < 2; ++a)
#pragma unroll
            for (int c = 0; c < 2; ++c) r[a][c] = (f32x4){0.f, 0.f, 0.f, 0.f};
        for (int n = 0; n < NCHUNK; ++n) {
            const int bn = b * NCHUNK + n; const size_t t0 = (size_t)bn * 128;
            bf16* rt = RT + (size_t)(bn * 8 + h) * 65536;
#pragma unroll
            for (int db = 0; db < 2; ++db)
#pragma unroll
                for (int eb = 0; eb < 2; ++eb) { u32x2 o; o.x = cvtpk(r[db][eb][0], r[db][eb][1]); o.y = cvtpk(r[db][eb][2], r[db][eb][3]);
                    *(u32x2*)(rt + (size_t)(32 * es + 16 * eb + i16) * 256 + 32 * w + 16 * db + 4 * g4) = o; }
            if (n == NCHUNK - 1) break;
#pragma unroll
            for (int k = 0; k < 8; ++k) { const int c = tid + 512 * k, row = c >> 5, part = c & 31;
                *(LAS v4u*)(K_t + row * 528 + part * 16) = *(const v4u*)(Kb + (t0 + row) * 2048 + hc + part * 8); }
            { const int row = tid >> 2, part = tid & 3; const v4u vw = *(const v4u*)(V + (t0 + row) * 2048 + hc + 32 * es + part * 8);
              const float z = __builtin_amdgcn_exp2f((float)(127 - row) * lg2);
              v4u o; o.x = cvtpk(bflo(vw.x) * z, bfhi(vw.x) * z); o.y = cvtpk(bflo(vw.y) * z, bfhi(vw.y) * z); o.z = cvtpk(bflo(vw.z) * z, bfhi(vw.z) * z); o.w = cvtpk(bflo(vw.w) * z, bfhi(vw.w) * z);
              *(LAS v4u*)(V_t + row * 80 + part * 16) = o; }
            __syncthreads();
#pragma unroll
            for (int a = 0; a < 2; ++a)
#pragma unroll
                for (int c = 0; c < 2; ++c) r[a][c] = r[a][c] * gamma_c;
#pragma unroll
            for (int ks = 0; ks < 4; ++ks) {
                const bf16x8 kf0 = lds_tr_frag(K_t, 528, 32 * ks, 32 * w, lane), kf1 = lds_tr_frag(K_t, 528, 32 * ks, 32 * w + 16, lane);
                const bf16x8 vf0 = lds_tr_frag(V_t, 80, 32 * ks, 0, lane), vf1 = lds_tr_frag(V_t, 80, 32 * ks, 16, lane);
                r[0][0] = MFMA16(kf0, vf0, r[0][0]); r[0][1] = MFMA16(kf0, vf1, r[0][1]); r[1][0] = MFMA16(kf1, vf0, r[1][0]); r[1][1] = MFMA16(kf1, vf1, r[1][1]);
            }
            __syncthreads();
        }
    }
}
__device__ __forceinline__ void phase_retout(LAS unsigned char* lds, const bf16* Q, const bf16* Kb, const bf16* V, bf16* Gt, const bf16* RT, const float* gn, int vcu, int G, int tid) {
    asm volatile("" : "+v"(tid));
    const int lane = tid & 63, w = __builtin_amdgcn_readfirstlane(tid >> 6), i16 = lane & 15, g4 = lane >> 4;
    LAS unsigned char* S_t = lds;
    LAS unsigned char* V_t = lds + 34816 + w * 10240;
    LAS float* red = (LAS float*)(lds + 34816 + 81920);
    LAS float* mr = red + 2048;
    for (int u = vcu; u < BATCH * NCHUNK * HEADS; u += G) {
        const int h = u & 7, hc = h * 256; const size_t t0 = (size_t)(u >> 3) * 128;
        const float lg2 = log2_gamma(h);
        {
            f32x4 sacc[8];
#pragma unroll
            for (int jb = 0; jb < 8; ++jb) sacc[jb] = (f32x4){0.f, 0.f, 0.f, 0.f};
            const bf16* qrow = Q + (t0 + 16 * w + i16) * 2048 + hc + 8 * g4;
            const bf16* krow = Kb + (t0 + i16) * 2048 + hc + 8 * g4;
#pragma unroll
            for (int ks = 0; ks < 8; ++ks) {
                const bf16x8 qf = *(const bf16x8*)(qrow + 32 * ks);
#pragma unroll
                for (int jb = 0; jb < 8; ++jb) if (jb <= w) { const bf16x8 kf = *(const bf16x8*)(krow + (size_t)jb * 16 * 2048 + 32 * ks); sacc[jb] = MFMA16(kf, qf, sacc[jb]); }
            }
            const int i = 16 * w + i16;
#pragma unroll
            for (int jb = 0; jb < 8; ++jb) { float o[4];
#pragma unroll
                for (int r = 0; r < 4; ++r) { const int j = 16 * jb + 4 * g4 + r; o[r] = (jb <= w && j <= i) ? sacc[jb][r] * __builtin_amdgcn_exp2f((float)(i - j) * lg2) : 0.f; }
                u32x2 p; p.x = cvtpk(o[0], o[1]); p.y = cvtpk(o[2], o[3]);
                *(LAS u32x2*)(S_t + i * 272 + (16 * jb + 4 * g4) * 2) = p; }
#pragma unroll
            for (int k = 0; k < 8; ++k) { const int c = lane + 64 * k, row = c >> 2, part = c & 3;
                *(LAS v4u*)(V_t + row * 80 + part * 16) = *(const v4u*)(V + (t0 + row) * 2048 + hc + 32 * w + part * 8); }
        }
        __syncthreads();
        f32x4 o[2][8];
#pragma unroll
        for (int a = 0; a < 2; ++a)
#pragma unroll
            for (int b = 0; b < 8; ++b) o[a][b] = (f32x4){0.f, 0.f, 0.f, 0.f};
        {
            const bf16* rtrow = RT + (size_t)u * 65536 + (size_t)(32 * w + i16) * 256 + 8 * g4;
            const bf16* qrow = Q + (t0 + i16) * 2048 + hc + 8 * g4;
#pragma unroll
            for (int ks = 0; ks < 8; ++ks) {
                const bf16x8 rf0 = *(const bf16x8*)(rtrow + 32 * ks), rf1 = *(const bf16x8*)(rtrow + 16 * 256 + 32 * ks);
#pragma unroll
                for (int ib = 0; ib < 8; ++ib) { const bf16x8 qf = *(const bf16x8*)(qrow + (size_t)ib * 16 * 2048 + 32 * ks); o[0][ib] = MFMA16(rf0, qf, o[0][ib]); o[1][ib] = MFMA16(rf1, qf, o[1][ib]); }
            }
        }
#pragma unroll
        for (int ib = 0; ib < 8; ++ib) { const float xi = __builtin_amdgcn_exp2f((float)(16 * ib + i16 + 1) * lg2); o[0][ib] = o[0][ib] * xi; o[1][ib] = o[1][ib] * xi; }
#pragma unroll
        for (int ks = 0; ks < 4; ++ks) {
            const bf16x8 vf0 = lds_tr_frag(V_t, 80, 32 * ks, 0, lane), vf1 = lds_tr_frag(V_t, 80, 32 * ks, 16, lane);
#pragma unroll
            for (int ib = 0; ib < 8; ++ib) if (2 * ks <= ib) {
                const bf16x8 sf = *(const LAS bf16x8*)(S_t + (16 * ib + i16) * 272 + (32 * ks + 8 * g4) * 2);
                o[0][ib] = MFMA16(vf0, sf, o[0][ib]); o[1][ib] = MFMA16(vf1, sf, o[1][ib]); }
        }
#pragma unroll
        for (int ib = 0; ib < 8; ++ib) { float s = 0.f, q = 0.f;
#pragma unroll
            for (int eb = 0; eb < 2; ++eb)
#pragma unroll
                for (int r = 0; r < 4; ++r) { const float x = o[eb][ib][r]; s += x; q += x * x; }
            s += __shfl_xor(s, 16); q += __shfl_xor(q, 16); s += __shfl_xor(s, 32); q += __shfl_xor(q, 32);
            if (g4 == 0) { red[((16 * ib + i16) * 8 + w) * 2] = s; red[((16 * ib + i16) * 8 + w) * 2 + 1] = q; } }
        __syncthreads();
        if (tid < 128) { float s = 0.f, q = 0.f;
#pragma unroll
            for (int k = 0; k < 8; ++k) { s += red[(tid * 8 + k) * 2]; q += red[(tid * 8 + k) * 2 + 1]; }
            const float mean = s * (1.0f / 256.0f), var = q * (1.0f / 256.0f) - mean * mean;
            mr[tid * 2] = mean; mr[tid * 2 + 1] = 1.0f / sqrtf(fmaxf(var, 0.f) + EPS); }
        __syncthreads();
#pragma unroll
        for (int eb = 0; eb < 2; ++eb) { const int e = 32 * w + 16 * eb + 4 * g4; const f32x4 gg = *(const f32x4*)(gn + hc + e);
#pragma unroll
            for (int ib = 0; ib < 8; ++ib) { const int i = 16 * ib + i16; const float mean = mr[i * 2], rstd = mr[i * 2 + 1];
                u32x2* gp = (u32x2*)(Gt + (t0 + i) * 2048 + hc + e); const u32x2 gw = *gp; const f32x4 x = o[eb][ib];
                u32x2 p; p.x = cvtpk((x[0] - mean) * rstd * gg[0] * bflo(gw.x), (x[1] - mean) * rstd * gg[1] * bfhi(gw.x));
                p.y = cvtpk((x[2] - mean) * rstd * gg[2] * bflo(gw.y), (x[3] - mean) * rstd * gg[3] * bfhi(gw.y));
                *gp = p; } }
        __syncthreads();
    }
}

struct Args { const void* in[19]; float* out; unsigned char* ws; };
__global__ void __launch_bounds__(NWAVES * 64, 2) fwd(Args args) {
    extern __shared__ __attribute__((aligned(16))) unsigned char lds_raw[];
    LAS unsigned char* lds = (LAS unsigned char*)lds_raw;
    volatile LAS unsigned* MISC = (volatile LAS unsigned*)(lds + MISC_OFF);
    const int tid = threadIdx.x, lane = tid & 63, wave = __builtin_amdgcn_readfirstlane(tid >> 6);
    const int G = gridDim.x; const int bx = blockIdx.x; const int vcu = (G % 8 == 0) ? (bx % 8) * (G / 8) + bx / 8 : bx;
    const int gw = vcu * NWAVES + wave, NGW = G * NWAVES;
    unsigned char* ws = args.ws; float* X = args.out;
    for (int u = tid; u < (LDS_BYTES - LDSCTL_OFF) / 4; u += NWAVES * 64) ((LAS unsigned*)(lds + LDSCTL_OFF))[u] = 0u;
    __syncthreads();
    XcdBarrier bar = xcd_barrier_post((unsigned*)(ws + WS_CTL) + CW_BAR, MISC + 8);

    bf16* Hb = (bf16*)(ws + WS_H);
    bf16* BIG = (bf16*)(ws + WS_BIG);
    bf16 *tQ = BIG, *tK = BIG + TSTRIDE, *tV = BIG + 2 * TSTRIDE, *tG = BIG + 3 * TSTRIDE, *tU = BIG + 4 * TSTRIDE, *tVS = BIG + 5 * TSTRIDE, *tGA = BIG + 6 * TSTRIDE, *tGB = BIG + 7 * TSTRIDE;
    float* CS = (float*)(ws + WS_CS);
    bf16* RT = (bf16*)(ws + WS_RT);

    {
        const f32x4* xs = (const f32x4*)args.in[0]; f32x4* xd = (f32x4*)X;
        const size_t n4 = (size_t)M * D / 4, gt = (size_t)bx * (NWAVES * 64) + tid, gs = (size_t)G * (NWAVES * 64);
        for (size_t i = gt; i < n4; i += gs) xd[i] = xs[i];
        const int* pos = (const int*)args.in[1];
        for (size_t i = gt; i < (size_t)M * 128; i += gs) { const int tkn = (int)(i >> 7), j = (int)(i & 127);
            double inv = 0.15915494309189535;
            inv *= (j & 1) ? 0.930572040929699 : 1.0; inv *= (j & 2) ? 0.8659643233600653 : 1.0; inv *= (j & 4) ? 0.7498942093324559 : 1.0; inv *= (j & 8) ? 0.5623413251903491 : 1.0;
            inv *= (j & 16) ? 0.31622776601683794 : 1.0; inv *= (j & 32) ? 0.1 : 1.0; inv *= (j & 64) ? 0.01 : 1.0;
            double t = (double)pos[tkn] * inv; t -= floor(t); const float tf = (float)t;
            CS[2 * i] = __builtin_amdgcn_cosf(tf); CS[2 * i + 1] = __builtin_amdgcn_sinf(tf); }
    }
    xcd_barrier(bar);

    for (int it = 0; it < 2 * DEPTH; ++it) {
        const int l = it >> 1, second = it & 1;
        if (!second) {
            ConvSrc cs;
            cs.gu1 = (const float*)args.in[3] + (size_t)l * D * 2 * FF; cs.d1 = (const float*)args.in[4] + (size_t)l * FF * D; cs.win = (const float*)args.in[6] + (size_t)l * D * INCOLS;
            cs.br = (const float*)args.in[12] + (size_t)l * D * D; cs.bs = (const float*)args.in[13] + (size_t)l * D * D; cs.wo = (const float*)args.in[14] + (size_t)l * D * D;
            cs.gu2 = (const float*)args.in[16] + (size_t)l * D * 2 * FF; cs.d2 = (const float*)args.in[17] + (size_t)l * FF * D; cs.sw = (const float*)args.in[10] + (size_t)l * 8 * 128 * 128;

#ifndef SKIP_CONV
            phase_conv(lds, ws, cs, gw, NGW, wave, lane);
#endif

        }
        phase_rms(X, (const float*)args.in[second ? 15 : 2] + (size_t)l * D, Hb, gw, NGW, lane);
        xcd_barrier(bar);
        {
            pg8::Gemm g{Hb, (const bf16*)(ws + (second ? WS_WGU2 : WS_WGU1)), M, 2 * FF, D}; pg8::StaticOrder S; S.init(M, 2 * FF, G, bx);
            pg8::EpiSwiglu E{BIG, FF};

#ifndef SKIP_GU
            pg8::gemm_phase<pg8::EpiSwiglu, pg8::StaticOrder, true, true>(lds, g, S, E);
#endif

        }
        xcd_barrier(bar);
        {
            pg8::Gemm g{BIG, (const bf16*)(ws + (second ? WS_WD2 : WS_WD1)), M, D, FF}; pg8::StaticOrder S; S.init(M, D, G, bx);
            pg8::EpiResid E{X, D, 0.5f};

#ifndef SKIP_DOWN
            pg8::gemm_phase<pg8::EpiResid, pg8::StaticOrder, true, true>(lds, g, S, E);
#endif

        }
        xcd_barrier(bar);
        if (!second) {
            phase_rms(X, (const float*)args.in[5] + (size_t)l * D, Hb, gw, NGW, lane);
            xcd_barrier(bar);
            {
                pg8::Gemm g{Hb, (const bf16*)(ws + WS_WIN), M, INCOLS, D}; pg8::StaticOrder S; S.init(M, INCOLS, G, bx);
                pg8::EpiIn E{BIG, TSTRIDE, CS, (const float*)args.in[7] + (size_t)l * 2 * D};

#ifndef SKIP_IN
                pg8::gemm_phase<pg8::EpiIn, pg8::StaticOrder, true, true>(lds, g, S, E);
#endif

            }
            xcd_barrier(bar);

#ifndef SKIP_SGULN
            phase_sguln(tVS, (const float*)args.in[9] + (size_t)l * 2048, gw, NGW, lane);
#endif


#ifndef SKIP_RETSTATE
            phase_retstate(lds, tK, tV, RT, vcu, G, tid);
#endif

            xcd_barrier(bar);

#ifndef SKIP_SGUMIX
            phase_sgumix(lds, (const bf16*)(ws + WS_WMASK), tVS, tU, (const float*)args.in[11] + (size_t)l * 8 * 128, vcu, G, tid);
#endif


#ifndef SKIP_RETOUT
            phase_retout(lds, tQ, tK, tV, tG, RT, (const float*)args.in[8] + (size_t)l * 2048, vcu, G, tid);
#endif

            xcd_barrier(bar);
            {
                pg8::Gemm g{tG, (const bf16*)(ws + WS_WBR), M, D, D}; pg8::StaticOrder S; S.init(M, D, G, bx);
                pg8::EpiBr<0> E{tQ, tGA};

#ifndef SKIP_BR0
                pg8::gemm_phase<pg8::EpiBr<0>, pg8::StaticOrder, true, true>(lds, g, S, E);
#endif

            }
            xcd_barrier(bar);
            {
                pg8::Gemm g{tU, (const bf16*)(ws + WS_WBS), M, D, D}; pg8::StaticOrder S; S.init(M, D, G, bx);
                pg8::EpiBr<1> E{tQ, tGB};

#ifndef SKIP_BR1
                pg8::gemm_phase<pg8::EpiBr<1>, pg8::StaticOrder, true, true>(lds, g, S, E);
#endif

            }
            xcd_barrier(bar);
            {
                pg8::Gemm g{tQ, (const bf16*)(ws + WS_WOUT), M, D, D}; pg8::StaticOrder S; S.init(M, D, G, bx);
                pg8::EpiResid E{X, D, 1.0f};

#ifndef SKIP_OUT
                pg8::gemm_phase<pg8::EpiResid, pg8::StaticOrder, true, true>(lds, g, S, E);
#endif

            }
            xcd_barrier(bar);
        }
    }
    phase_final(X, (const float*)args.in[18], gw, NGW, lane);
}

extern "C" void kernel_launch(void* const* d_in, const int* in_sizes, int n_in, void* d_out, int out_size, void* d_ws, size_t ws_size, hipStream_t stream) {
    static int grid = 0;
    if (grid == 0) {
        if (n_in != 19 || in_sizes[0] != M * D || out_size != M * D || ws_size < WS_END) { fprintf(stderr, "kernel_launch: unexpected shapes / workspace (n_in %d, in0 %d, out %d, ws %zu, need %zu); nothing launched\n", n_in, n_in > 0 ? in_sizes[0] : -1, out_size, ws_size, (size_t)WS_END); grid = -1; return; }
        int dev = 0, cus = 0, per_cu = 0;
        if (hipGetDevice(&dev) != hipSuccess || hipDeviceGetAttribute(&cus, hipDeviceAttributeMultiprocessorCount, dev) != hipSuccess) { fprintf(stderr, "kernel_launch: device query failed\n"); grid = -1; return; }
        if (hipFuncSetAttribute((const void*)fwd, hipFuncAttributeMaxDynamicSharedMemorySize, LDS_BYTES) != hipSuccess) { fprintf(stderr, "kernel_launch: hipFuncSetAttribute failed\n"); grid = -1; return; }
        if (hipOccupancyMaxActiveBlocksPerMultiprocessor(&per_cu, (const void*)fwd, NWAVES * 64, LDS_BYTES) != hipSuccess || per_cu < 1) fprintf(stderr, "kernel_launch: note: occupancy query reports %d workgroups per CU\n", per_cu);
        (void)hipGetLastError();
        grid = cus;
    }
    if (grid < 0) return;
    if (hipMemsetAsync((char*)d_ws + WS_CTL, 0, CTL_ZERO_BYTES, stream) != hipSuccess) { fprintf(stderr, "kernel_launch: memset failed\n"); return; }
    Args a{};
    for (int i = 0; i < 19; ++i) a.in[i] = d_in[i];
    a.out = (float*)d_out; a.ws = (unsigned char*)d_ws;
    hipLaunchKernelGGL(fwd, dim3(grid), dim3(NWAVES * 64), LDS_BYTES, stream, a);
    const hipError_t le = hipPeekAtLastError();
    if (le != hipSuccess) fprintf(stderr, "kernel_launch: launch failed: %s\n", hipGetErrorName(le));
}
```

```cpp
#include <hip/hip_runtime.h>
#include <cstdio>
#include <cstdint>
#include <cmath>
namespace pg8 {
#define PG8_LAS __attribute__((address_space(3)))
typedef unsigned short bf16_t;
typedef short bf16x8 __attribute__((ext_vector_type(8)));
typedef float f32x4 __attribute__((ext_vector_type(4)));
typedef unsigned u32x4 __attribute__((ext_vector_type(4)));
constexpr int LDT = 2048 + 64;
constexpr int BM = 256, BK = 64, HALF = 128, HTB = HALF * BK * 2  , STAGE_BYTES = 8 * HTB, NXCD = 8, WGM = 8;

__host__ __device__ __forceinline__ int lds_byte(int r, int c) { const int st = (r >> 4) * 2 + (c >> 5), rr = r & 15, cc = c & 31, ob = rr * 64 + cc * 2; return st * 1024 + (ob ^ (((ob >> 9) & 1) << 5)); }
__host__ __device__ __forceinline__ void stage_rc(int b, int& R, int& C) { const int st = b / 1024, sb = b % 1024, swz = sb ^ (((sb >> 9) & 1) << 5); R = (st >> 1) * 16 + swz / 64; C = (st & 1) * 32 + (swz % 64) / 2; }
__host__ __device__ __forceinline__ int perm32(int rho) { const int n = rho >> 4, i = rho & 15; return 8 * (i >> 2) + 4 * n + (i & 3); }

struct Unit { int pm, pn, z; };
struct Gemm { const bf16_t* A; const bf16_t* Bt; int M, N, K; int lda, ldb; };

struct StaticOrder {
    int nM, nN, nwg, G, c;
    __host__ __device__ void init(int M, int N, int G_, int c_) { nM = M / BM; nN = N / BM; nwg = nM * nN; G = G_; c = c_; }
    __host__ __device__ bool next(int i, Unit& u) const {
        const long L = (long)i * G + c; if (L >= nwg) return false;
        int wgid = (int)L; { const int q = nwg / NXCD, r = nwg % NXCD, xcd = wgid % NXCD, off = wgid / NXCD; wgid = (xcd < r ? xcd * (q + 1) : r * (q + 1) + (xcd - r) * q) + off; }
        const int nig = WGM * nN, gid = wgid / nig, fm = gid * WGM, gsz = (nM - fm) < WGM ? (nM - fm) : WGM;
        u.pm = fm + ((wgid % nig) % gsz); u.pn = (wgid % nig) / gsz; u.z = 0; return true;
    }
    __device__ __forceinline__ void a_ready(const Unit&) const {}
    __device__ __forceinline__ void done(const Unit&) const {}
    __device__ __forceinline__ const bf16_t* opA(const Gemm& g, const Unit&) const { return g.A; }
    __device__ __forceinline__ const bf16_t* opB(const Gemm& g, const Unit&) const { return g.Bt; }
};
struct ReverseOrder : StaticOrder {
    __device__ bool next(int i, Unit& u) const { const int rounds = nwg / G; if (i >= rounds) return false; return StaticOrder::next(rounds - 1 - i, u); }
};
struct DualOrder : StaticOrder {
    const bf16_t* A2; const bf16_t* B2;
    __device__ bool next(int i, Unit& u) const { const int rounds = nwg / G; if (i >= 2 * rounds) return false; const bool ok = StaticOrder::next(i >= rounds ? i - rounds : i, u); u.z = (i >= rounds) ? 1 : 0; return ok; }
    __device__ __forceinline__ const bf16_t* opA(const Gemm& g, const Unit& u) const { return u.z ? A2 : g.A; }
    __device__ __forceinline__ const bf16_t* opB(const Gemm& g, const Unit& u) const { return u.z ? B2 : g.Bt; }
};
typedef float f32x2_c __attribute__((ext_vector_type(2))); typedef __bf16 bf16x2_c __attribute__((ext_vector_type(2)));
__device__ __forceinline__ unsigned cvt_pk_bf16(float lo, float hi) { f32x2_c v = {lo, hi}; bf16x2_c b = __builtin_convertvector(v, bf16x2_c); return __builtin_bit_cast(unsigned, b); }
typedef float f32x2 __attribute__((ext_vector_type(2)));
__device__ __forceinline__ f32x2 gelu_pk(f32x2 v) {
    const f32x2 av = __builtin_elementwise_abs(v), d = av * 0.2316418882f + 1.0f;
    f32x2 t; t.x = __builtin_amdgcn_rcpf(d.x); t.y = __builtin_amdgcn_rcpf(d.y);
    f32x2 q = t * 0.5307027145f + (-0.7265760135f); q = q * t + 0.7107068705f; q = q * t + (-0.142248368f); q = q * t + 0.127414796f; q = q * t;
    const f32x2 s = (v * v) * (-0.72134752044f);
    f32x2 e; e.x = __builtin_amdgcn_exp2f(s.x); e.y = __builtin_amdgcn_exp2f(s.y);
    const f32x2 m = v * (q * e), r = v - m;
    f32x2 o; o.x = v.x < 0.f ? m.x : r.x; o.y = v.y < 0.f ? m.y : r.y; return o;
}

__device__ __forceinline__ float bf_lo(unsigned u) { return __uint_as_float(u << 16); }
__device__ __forceinline__ float bf_hi(unsigned u) { return __uint_as_float(u & 0xffff0000u); }
__device__ __forceinline__ float silu_f(float g) { return g * __builtin_amdgcn_rcpf(1.0f + __builtin_amdgcn_exp2f(-1.44269504f * g)); }
__device__ __forceinline__ float sigmoid_f(float g) { return __builtin_amdgcn_rcpf(1.0f + __builtin_amdgcn_exp2f(-1.44269504f * g)); }

__device__ __forceinline__ float row_rs(const float* ssq, int row, int fq) {
    const float* pp = ssq + (size_t)row * 32 + 8 * fq; const f32x4 p0 = *(const f32x4*)pp, p1 = *(const f32x4*)(pp + 4);
    float s = ((p0[0] + p0[1]) + (p0[2] + p0[3])) + ((p1[0] + p1[1]) + (p1[2] + p1[3]));
    s += __shfl_xor(s, 16); s += __shfl_xor(s, 32);
    return __builtin_amdgcn_rsqf(s * (1.0f / 2048.0f) + 1e-6f);
}
struct EpiSwiglu {
    static constexpr bool PERM = true, AFTER_DRAIN = false; static constexpr int NST = 8;
    bf16_t* O; int ldc; const float* ssq;
    PG8_LAS float* rsl; mutable int cpm;
    __device__ __forceinline__ void operator()(const f32x4 (&acc)[2][2][4][2], const Unit& u, int wr, int wc, int fr, int fq) const {
        const int row0 = u.pm * BM + wr * 64 + fr, col0 = u.pn * HALF + wc * 32 + 8 * fq;
        PG8_LAS float* my = rsl + (wr * 4 + wc) * 128 + fr;
        if (u.pm != cpm) { cpm = u.pm;
#pragma unroll
            for (int ai = 0; ai < 2; ++ai)
#pragma unroll
                for (int m = 0; m < 4; ++m) { const float r = row_rs(ssq, row0 + ai * HALF + m * 16, fq); if (fq == 0) my[(ai * 4 + m) * 16] = r; } }
#pragma unroll
        for (int ai = 0; ai < 2; ++ai)
#pragma unroll
            for (int m = 0; m < 4; ++m) { bf16_t* rowp = O + (size_t)(row0 + ai * HALF + m * 16) * ldc + col0;
                const float rs = my[(ai * 4 + m) * 16];
                const f32x4 a0 = acc[ai][0][m][0] * rs, a1 = acc[ai][0][m][1] * rs, g0 = acc[ai][1][m][0] * rs, g1 = acc[ai][1][m][1] * rs;
                u32x4 w; w.x = cvt_pk_bf16(a0[0] * silu_f(g0[0]), a0[1] * silu_f(g0[1])); w.y = cvt_pk_bf16(a0[2] * silu_f(g0[2]), a0[3] * silu_f(g0[3]));
                w.z = cvt_pk_bf16(a1[0] * silu_f(g1[0]), a1[1] * silu_f(g1[1])); w.w = cvt_pk_bf16(a1[2] * silu_f(g1[2]), a1[3] * silu_f(g1[3]));
                *(u32x4*)rowp = w; }
    }
};
struct EpiResid {
    static constexpr bool PERM = true, AFTER_DRAIN = false; static constexpr int NST = 8;
    float scale; bf16_t* Hx; float* ssq;
    __device__ __forceinline__ void operator()(const f32x4 (&acc)[2][2][4][2], const Unit& u, int wr, int wc, int fr, int fq) const {
        const int row0 = u.pm * BM + wr * 64 + fr, col0 = u.pn * BM + wc * 32 + 8 * fq;
#pragma unroll
        for (int ai = 0; ai < 2; ++ai) {
            u32x4 xv[4][2];
#pragma unroll
            for (int m = 0; m < 4; ++m)
#pragma unroll
                for (int bj = 0; bj < 2; ++bj) xv[m][bj] = *(const u32x4*)(Hx + (size_t)(row0 + ai * HALF + m * 16) * LDT + col0 + bj * HALF);
#pragma unroll
            for (int m = 0; m < 4; ++m) { const int row = row0 + ai * HALF + m * 16; bf16_t* hp = Hx + (size_t)row * LDT + col0;
                float ss = 0.f;
#pragma unroll
                for (int bj = 0; bj < 2; ++bj) { const u32x4 x = xv[m][bj]; const f32x4 a0 = acc[ai][bj][m][0], a1 = acc[ai][bj][m][1];
                    const float y0 = bf_lo(x.x) + a0[0] * scale, y1 = bf_hi(x.x) + a0[1] * scale, y2 = bf_lo(x.y) + a0[2] * scale, y3 = bf_hi(x.y) + a0[3] * scale;
                    const float y4 = bf_lo(x.z) + a1[0] * scale, y5 = bf_hi(x.z) + a1[1] * scale, y6 = bf_lo(x.w) + a1[2] * scale, y7 = bf_hi(x.w) + a1[3] * scale;
                    ss += ((y0 * y0 + y1 * y1) + (y2 * y2 + y3 * y3)) + ((y4 * y4 + y5 * y5) + (y6 * y6 + y7 * y7));
                    u32x4 w; w.x = cvt_pk_bf16(y0, y1); w.y = cvt_pk_bf16(y2, y3); w.z = cvt_pk_bf16(y4, y5); w.w = cvt_pk_bf16(y6, y7);
                    *(u32x4*)(hp + bj * HALF) = w; }
                ss += __shfl_xor(ss, 16); ss += __shfl_xor(ss, 32);
                if (fq == 0) ssq[(size_t)row * 32 + u.pn * 4 + wc] = ss; }
            asm volatile("" ::: "memory"); }
    }
};
__device__ __forceinline__ float lg2_gamma_h(int h) {
    const float x = __builtin_amdgcn_exp2f(-5.0f - (float)h);
    const float l = -x * (1.0f + x * (0.5f + x * (0.33333334f + x * (0.25f + x * (0.2f + x * 0.16666667f)))));
    return l * 1.44269504f;
}
struct EpiIn {
    static constexpr bool PERM = true, AFTER_DRAIN = false; static constexpr int NST = 8;
    bf16_t* O; size_t tstride; const float* cs; const float* bgate; const float* ssq; PG8_LAS float* rsl; mutable int cpm; float* sgst;
    __device__ __forceinline__ void operator()(const f32x4 (&acc)[2][2][4][2], const Unit& u, int wr, int wc, int fr, int fq) const {
        const int t = ((u.pn >> 3) + 3) & 7, hh = u.pn & 7;
        bf16_t* base = O + (size_t)t * tstride;
        const int row0 = u.pm * BM + wr * 64 + fr, cw = wc * 32 + 8 * fq, col0 = hh * BM + cw;
        PG8_LAS float* my = rsl + (wr * 4 + wc) * 128 + fr;
        if (u.pm != cpm) { cpm = u.pm;
#pragma unroll
            for (int ai = 0; ai < 2; ++ai)
#pragma unroll
                for (int m = 0; m < 4; ++m) { const float r = row_rs(ssq, row0 + ai * HALF + m * 16, fq); if (fq == 0) my[(ai * 4 + m) * 16] = r; } }
        if (t <= 1) {
            const float sc = (t == 1) ? 0.0625f : 1.0f, lgs = (t == 1) ? -lg2_gamma_h(hh) : lg2_gamma_h(hh);
#pragma unroll
            for (int ai = 0; ai < 2; ++ai) {
                f32x4 cv[4][4];
#pragma unroll
                for (int m = 0; m < 4; ++m) { const f32x4* cp = (const f32x4*)(cs + ((size_t)(row0 + ai * HALF + m * 16) * 128 + cw) * 2);
#pragma unroll
                    for (int q = 0; q < 4; ++q) cv[m][q] = cp[q]; }
#pragma unroll
                for (int m = 0; m < 4; ++m) { const int row = row0 + ai * HALF + m * 16;
                    const f32x4 c0 = cv[m][0], c1 = cv[m][1], c2 = cv[m][2], c3 = cv[m][3];
                    const float rs = my[(ai * 4 + m) * 16] * sc * __builtin_amdgcn_exp2f((float)((row & 127) + 1) * lgs);
                    const f32x4 xa0 = acc[ai][0][m][0] * rs, xa1 = acc[ai][0][m][1] * rs, xb0 = acc[ai][1][m][0] * rs, xb1 = acc[ai][1][m][1] * rs;
                    const float co[8] = {c0[0], c0[2], c1[0], c1[2], c2[0], c2[2], c3[0], c3[2]};
                    const float si[8] = {c0[1], c0[3], c1[1], c1[3], c2[1], c2[3], c3[1], c3[3]};
                    const float x1[8] = {xa0[0], xa0[1], xa0[2], xa0[3], xa1[0], xa1[1], xa1[2], xa1[3]};
                    const float x2[8] = {xb0[0], xb0[1], xb0[2], xb0[3], xb1[0], xb1[1], xb1[2], xb1[3]};
                    float o1[8], o2[8];
#pragma unroll
                    for (int j = 0; j < 8; ++j) { o1[j] = x1[j] * co[j] - x2[j] * si[j]; o2[j] = x1[j] * si[j] + x2[j] * co[j]; }
                    u32x4 w1, w2;
                    w1.x = cvt_pk_bf16(o1[0], o1[1]); w1.y = cvt_pk_bf16(o1[2], o1[3]); w1.z = cvt_pk_bf16(o1[4], o1[5]); w1.w = cvt_pk_bf16(o1[6], o1[7]);
                    w2.x = cvt_pk_bf16(o2[0], o2[1]); w2.y = cvt_pk_bf16(o2[2], o2[3]); w2.z = cvt_pk_bf16(o2[4], o2[5]); w2.w = cvt_pk_bf16(o2[6], o2[7]);
                    bf16_t* rowp = base + (size_t)row * LDT + col0;
                    *(u32x4*)rowp = w1; *(u32x4*)(rowp + HALF) = w2; }
                asm volatile("" ::: "memory"); }
        } else if (t == 2) other<2>(acc, base, row0, col0, my, t, hh, wc, fq);
        else if (t == 3) other<2>(acc, base, row0, col0, my, t, hh, wc, fq);
        else if (t == 4) other<4>(acc, base, row0, col0, my, t, hh, wc, fq);
        else if (t == 5) other<5>(acc, base, row0, col0, my, t, hh, wc, fq);
        else other<6>(acc, base, row0, col0, my, t, hh, wc, fq);
    }
    template <int TT> __device__ __forceinline__ void other(const f32x4 (&acc)[2][2][4][2], bf16_t* base, int row0, int col0, PG8_LAS float* my, int t, int hh, int wc, int fq) const {
        f32x4 bv[2][2];
#pragma unroll
        for (int bj = 0; bj < 2; ++bj)
#pragma unroll
            for (int n = 0; n < 2; ++n) bv[bj][n] = (TT >= 6) ? *(const f32x4*)(bgate + (t - 6) * 2048 + col0 + bj * HALF + 4 * n) : (f32x4){0.f, 0.f, 0.f, 0.f};
#pragma unroll
        for (int ai = 0; ai < 2; ++ai)
#pragma unroll
            for (int m = 0; m < 4; ++m) { bf16_t* rowp = base + (size_t)(row0 + ai * HALF + m * 16) * LDT + col0;
                const float rs = my[(ai * 4 + m) * 16]; float ps = 0.f, pq = 0.f;
#pragma unroll
                for (int bj = 0; bj < 2; ++bj) { f32x4 v0 = acc[ai][bj][m][0] * rs + bv[bj][0], v1 = acc[ai][bj][m][1] * rs + bv[bj][1];
                    if (TT == 3) {
#pragma unroll
                        for (int j = 0; j < 4; ++j) { v0[j] = silu_f(v0[j]); v1[j] = silu_f(v1[j]); } }
                    else if (TT == 4 || TT == 5) { f32x2 a = gelu_pk((f32x2){v0[0], v0[1]}), b = gelu_pk((f32x2){v0[2], v0[3]}), c = gelu_pk((f32x2){v1[0], v1[1]}), d = gelu_pk((f32x2){v1[2], v1[3]});
                        v0 = (f32x4){a.x, a.y, b.x, b.y}; v1 = (f32x4){c.x, c.y, d.x, d.y};
                        if (TT == 5) { ps += ((v0[0] + v0[1]) + (v0[2] + v0[3])) + ((v1[0] + v1[1]) + (v1[2] + v1[3]));
                            pq += ((v0[0] * v0[0] + v0[1] * v0[1]) + (v0[2] * v0[2] + v0[3] * v0[3])) + ((v1[0] * v1[0] + v1[1] * v1[1]) + (v1[2] * v1[2] + v1[3] * v1[3])); } }
                    else if (TT >= 6) {
#pragma unroll
                        for (int j = 0; j < 4; ++j) { v0[j] = sigmoid_f(v0[j]); v1[j] = sigmoid_f(v1[j]); } }
                    u32x4 w; w.x = cvt_pk_bf16(v0[0], v0[1]); w.y = cvt_pk_bf16(v0[2], v0[3]); w.z = cvt_pk_bf16(v1[0], v1[1]); w.w = cvt_pk_bf16(v1[2], v1[3]);
                    *(u32x4*)(rowp + bj * HALF) = w; }
                if (TT == 5) { ps += __shfl_xor(ps, 16); pq += __shfl_xor(pq, 16); ps += __shfl_xor(ps, 32); pq += __shfl_xor(pq, 32);
                    if (fq == 0) *(f32x2*)(sgst + ((size_t)((row0 + ai * HALF + m * 16) * 8 + hh) * 4 + wc) * 2) = (f32x2){ps, pq}; } }
    }
};
template <int MODE> struct EpiBr {
    static constexpr bool PERM = true, AFTER_DRAIN = false; static constexpr int NST = 0;
    bf16_t* T; const bf16_t* gate; const bf16_t* gate2;
    __device__ __forceinline__ void operator()(const f32x4 (&acc)[2][2][4][2], const Unit& u, int wr, int wc, int fr, int fq) const {
        const int row0 = u.pm * BM + wr * 64 + fr, col0 = u.pn * BM + wc * 32 + 8 * fq;
        const bool addp = (MODE == 1) || (MODE == 2 && u.z != 0); const bf16_t* const gt = (MODE == 2 && u.z != 0) ? gate2 : gate;
#pragma unroll
        for (int ai = 0; ai < 2; ++ai) {
            u32x4 gv[4][2], pv[4][2];
#pragma unroll
            for (int m = 0; m < 4; ++m)
#pragma unroll
                for (int bj = 0; bj < 2; ++bj) { const size_t off = (size_t)(row0 + ai * HALF + m * 16) * LDT + col0 + bj * HALF;
                    gv[m][bj] = *(const u32x4*)(gt + off); pv[m][bj] = addp ? *(const u32x4*)(T + off) : (u32x4){0u, 0u, 0u, 0u}; }
#pragma unroll
            for (int m = 0; m < 4; ++m)
#pragma unroll
                for (int bj = 0; bj < 2; ++bj) { const size_t off = (size_t)(row0 + ai * HALF + m * 16) * LDT + col0 + bj * HALF; const u32x4 gw = gv[m][bj];
                    const f32x4 a0 = acc[ai][bj][m][0], a1 = acc[ai][bj][m][1];
                    float o[8] = {a0[0] * bf_lo(gw.x), a0[1] * bf_hi(gw.x), a0[2] * bf_lo(gw.y), a0[3] * bf_hi(gw.y), a1[0] * bf_lo(gw.z), a1[1] * bf_hi(gw.z), a1[2] * bf_lo(gw.w), a1[3] * bf_hi(gw.w)};
                    { const u32x4 pw = pv[m][bj];
                        o[0] += bf_lo(pw.x); o[1] += bf_hi(pw.x); o[2] += bf_lo(pw.y); o[3] += bf_hi(pw.y); o[4] += bf_lo(pw.z); o[5] += bf_hi(pw.z); o[6] += bf_lo(pw.w); o[7] += bf_hi(pw.w); }
                    u32x4 w; w.x = cvt_pk_bf16(o[0], o[1]); w.y = cvt_pk_bf16(o[2], o[3]); w.z = cvt_pk_bf16(o[4], o[5]); w.w = cvt_pk_bf16(o[6], o[7]);
                    *(u32x4*)(T + off) = w; }
            asm volatile("" ::: "memory"); }
    }
};
template <class Epi, class Sched, bool ALIGN_EPI = false, bool SP2 = false>
__device__ __forceinline__ void gemm_phase(PG8_LAS unsigned char* lds, const Gemm g, const Sched& S, const Epi& E) {
    int tid_l = threadIdx.x; asm volatile("" : "+v"(tid_l));
    const int tid = tid_l, wid = __builtin_amdgcn_readfirstlane(tid >> 6), lane = tid & 63, wr = wid >> 2, wc = wid & 3, fr = lane & 15, fq = lane >> 4;
    const int K = g.K, nt = K / BK;
    unsigned voffA, voffB;
    { int R, C; stage_rc(tid * 16, R, C); const int Rb = Epi::PERM ? ((R & ~31) + perm32(R & 31)) : R;
        voffA = (unsigned)(R * g.lda + C) * 2u; voffB = (unsigned)(Rb * g.ldb + C) * 2u; }
    const size_t voffA_step = (size_t)64 * g.lda * 2, voffB_step = (size_t)64 * g.ldb * 2;
    const size_t kstep = (size_t)(BK * 2);
    const size_t hstepA = (size_t)HALF * g.lda * 2, hstepB = (size_t)HALF * g.ldb * 2;
    const size_t tstepA = 2 * hstepA, tstepB = 2 * hstepB;
    const unsigned ldsw = (unsigned)wid * 1024u;
    const int aoff = lds_byte(wr * 64 + fr, fq * 8), boff = lds_byte(wc * 32 + fr, fq * 8);
#define PG8_SA(b, h) (((b) * 2 + (h)) * HTB)
#define PG8_SB(b, h) ((4 + (b) * 2 + (h)) * HTB)
#define PG8_STAGE(bufoff, gbase, voff) do { _Pragma("unroll") for (int _i = 0; _i < 2; ++_i) \
        __builtin_amdgcn_global_load_lds((const unsigned*)((const char*)(gbase) + _i * voff##_step + (voff)), (PG8_LAS unsigned*)(lds + (bufoff) + ldsw + _i * 8192), 16, 0, 0); } while (0)
#define PG8_LDA(dst, b, h) do { _Pragma("unroll") for (int m = 0; m < 4; ++m) _Pragma("unroll") for (int k = 0; k < 2; ++k) dst[m][k] = *(const PG8_LAS bf16x8*)(lds + PG8_SA(b, h) + aoff + m * 2048 + k * 1024); } while (0)
#define PG8_LDB(dst, b, h) do { _Pragma("unroll") for (int n = 0; n < 2; ++n) _Pragma("unroll") for (int k = 0; k < 2; ++k) dst[n][k] = *(const PG8_LAS bf16x8*)(lds + PG8_SB(b, h) + boff + n * 2048 + k * 1024); } while (0)
#define PG8_MMA(ai, bj, At, Bt) do { __builtin_amdgcn_s_setprio(1); _Pragma("unroll") for (int m = 0; m < 4; ++m) _Pragma("unroll") for (int n = 0; n < 2; ++n) _Pragma("unroll") for (int k = 0; k < 2; ++k) \
        acc[ai][bj][m][n] = __builtin_amdgcn_mfma_f32_16x16x32_bf16(Bt[n][k], At[m][k], acc[ai][bj][m][n], 0, 0, 0); __builtin_amdgcn_s_setprio(0); } while (0)
#define PG8_MMAZ(ai, bj, At, Bt) do { __builtin_amdgcn_s_setprio(1); _Pragma("unroll") for (int m = 0; m < 4; ++m) _Pragma("unroll") for (int n = 0; n < 2; ++n) { \
        acc[ai][bj][m][n] = __builtin_amdgcn_mfma_f32_16x16x32_bf16(Bt[n][0], At[m][0], (f32x4){0.f, 0.f, 0.f, 0.f}, 0, 0, 0); \
        acc[ai][bj][m][n] = __builtin_amdgcn_mfma_f32_16x16x32_bf16(Bt[n][1], At[m][1], acc[ai][bj][m][n], 0, 0, 0); } __builtin_amdgcn_s_setprio(0); } while (0)
#define PG8_WAIT_V(n) asm volatile("s_waitcnt vmcnt(" #n ")" ::: "memory")
#define PG8_WAIT_L(n) asm volatile("s_waitcnt lgkmcnt(" #n ")" ::: "memory")
#define PG8_BAR __builtin_amdgcn_s_barrier()
#define PG8_SCHED __builtin_amdgcn_sched_barrier(0)
    Unit cur, nxt; int ui = 0;
    if (!S.next(0, cur)) return;
    f32x4 acc[2][2][4][2];
    if constexpr (!SP2) {
#pragma unroll
    for (int a = 0; a < 2; ++a)
#pragma unroll
        for (int b = 0; b < 2; ++b)
#pragma unroll
            for (int m = 0; m < 4; ++m)
#pragma unroll
                for (int n = 0; n < 2; ++n) acc[a][b][m][n] = (f32x4){0.f, 0.f, 0.f, 0.f};
    }
    bf16x8 At[4][2], B0[2][2], B1[2][2];
    const char* cA = (const char*)S.opA(g, cur) + (size_t)cur.pm * tstepA; const char* cB = (const char*)S.opB(g, cur) + (size_t)cur.pn * tstepB;
    S.a_ready(cur);
    if constexpr (SP2) {
        PG8_STAGE(PG8_SB(0, 0), cB, voffB); PG8_STAGE(PG8_SB(0, 1), cB + hstepB, voffB); PG8_STAGE(PG8_SA(0, 0), cA, voffA); PG8_STAGE(PG8_SA(0, 1), cA + hstepA, voffA);
        if (wr == 1) PG8_BAR;
        PG8_WAIT_V(2); PG8_BAR;
        PG8_STAGE(PG8_SB(1, 0), cB + kstep, voffB); PG8_STAGE(PG8_SA(1, 0), cA + kstep, voffA); PG8_STAGE(PG8_SB(1, 1), cB + hstepB + kstep, voffB);
        if (Epi::NST > 0) PG8_WAIT_V(0); else PG8_WAIT_V(6);
        PG8_BAR;
    } else {
        PG8_STAGE(PG8_SB(0, 0), cB, voffB); PG8_STAGE(PG8_SA(0, 0), cA, voffA); PG8_STAGE(PG8_SB(0, 1), cB + hstepB, voffB); PG8_STAGE(PG8_SA(0, 1), cA + hstepA, voffA);
        if (wr == 1) PG8_BAR;
        PG8_WAIT_V(4); PG8_BAR;
        PG8_STAGE(PG8_SB(1, 0), cB + kstep, voffB); PG8_STAGE(PG8_SA(1, 0), cA + kstep, voffA); PG8_STAGE(PG8_SB(1, 1), cB + hstepB + kstep, voffB);
        PG8_WAIT_V(6); PG8_BAR;
    }
    for (;;) {
        const bool has_next = S.next(ui + 1, nxt);
        const char* nA = has_next ? (const char*)S.opA(g, nxt) + (size_t)nxt.pm * tstepA : cA; const char* nB = has_next ? (const char*)S.opB(g, nxt) + (size_t)nxt.pn * tstepB : cB;
#define PG8_TRIP_HEAD(T) const int t = (T); const bool last = (t == nt - 2); \
            const char* a1 = cA + (size_t)(t + 1) * kstep; \
            const char* a2 = last ? nA : cA + (size_t)(t + 2) * kstep; const char* b2 = last ? nB : cB + (size_t)(t + 2) * kstep; \
            const char* a3 = a2 + kstep; const char* b3 = b2 + kstep; \
            if (last && has_next) S.a_ready(nxt);
#define PG8_TRIP_SP2(W12, MM0) \
            PG8_LDB(B0, 0, 0); PG8_LDB(B1, 0, 1); PG8_SCHED; PG8_LDA(At, 0, 0); PG8_STAGE(PG8_SA(1, 1), a1 + hstepA, voffA); \
            W12; PG8_WAIT_L(0); PG8_BAR; MM0(0, 0, At, B0); MM0(0, 1, At, B1); PG8_BAR; PG8_SCHED; \
            PG8_LDA(At, 0, 1); PG8_STAGE(PG8_SB(0, 0), b2, voffB); PG8_STAGE(PG8_SB(0, 1), b2 + hstepB, voffB); PG8_STAGE(PG8_SA(0, 0), a2, voffA); \
            W12; PG8_WAIT_L(0); PG8_BAR; MM0(1, 0, At, B0); MM0(1, 1, At, B1); PG8_BAR; PG8_SCHED; \
            PG8_LDB(B0, 1, 0); PG8_LDB(B1, 1, 1); PG8_SCHED; PG8_LDA(At, 1, 0); PG8_STAGE(PG8_SA(0, 1), a2 + hstepA, voffA); \
            PG8_WAIT_V(8); PG8_WAIT_L(0); PG8_BAR; PG8_MMA(0, 0, At, B0); PG8_MMA(0, 1, At, B1); PG8_BAR; PG8_SCHED; \
            PG8_LDA(At, 1, 1); PG8_STAGE(PG8_SB(1, 0), b3, voffB); PG8_STAGE(PG8_SB(1, 1), b3 + hstepB, voffB); PG8_STAGE(PG8_SA(1, 0), a3, voffA); \
            PG8_WAIT_V(8); PG8_WAIT_L(0); PG8_BAR; PG8_MMA(1, 0, At, B0); PG8_MMA(1, 1, At, B1); PG8_BAR; PG8_SCHED;
        if constexpr (SP2) {
            { PG8_TRIP_HEAD(0) PG8_TRIP_SP2(asm volatile("s_waitcnt vmcnt(%0)" :: "n"(8 + Epi::NST) : "memory"), PG8_MMAZ) }
            for (int tt = 2; tt < nt; tt += 2) { PG8_TRIP_HEAD(tt) PG8_TRIP_SP2(PG8_WAIT_V(8), PG8_MMA) }
        } else {
        for (int tt = 0; tt < nt; tt += 2) { PG8_TRIP_HEAD(tt)
            PG8_LDB(B0, 0, 0); PG8_SCHED; PG8_LDA(At, 0, 0); PG8_STAGE(PG8_SA(1, 1), a1 + hstepA, voffA);
            PG8_WAIT_L(8); PG8_BAR; PG8_WAIT_L(0); PG8_MMA(0, 0, At, B0); PG8_BAR; PG8_SCHED;
            PG8_LDB(B1, 0, 1); PG8_STAGE(PG8_SB(0, 0), b2, voffB);
            PG8_BAR; PG8_WAIT_L(0); PG8_MMA(0, 1, At, B1); PG8_BAR;
            PG8_LDA(At, 0, 1); PG8_STAGE(PG8_SA(0, 0), a2, voffA);
            PG8_BAR; PG8_WAIT_L(0); PG8_MMA(1, 0, At, B0); PG8_BAR; PG8_SCHED;
            PG8_STAGE(PG8_SB(0, 1), b2 + hstepB, voffB);
            PG8_WAIT_V(6); PG8_BAR; PG8_MMA(1, 1, At, B1); PG8_BAR;
            PG8_LDB(B0, 1, 0); PG8_SCHED; PG8_LDA(At, 1, 0); PG8_STAGE(PG8_SA(0, 1), a2 + hstepA, voffA);
            PG8_WAIT_L(8); PG8_BAR; PG8_WAIT_L(0); PG8_MMA(0, 0, At, B0); PG8_BAR; PG8_SCHED;
            PG8_LDB(B1, 1, 1); PG8_STAGE(PG8_SB(1, 0), b3, voffB);
            PG8_BAR; PG8_WAIT_L(0); PG8_MMA(0, 1, At, B1); PG8_BAR;
            PG8_LDA(At, 1, 1); PG8_STAGE(PG8_SA(1, 0), a3, voffA);
            PG8_BAR; PG8_WAIT_L(0); PG8_MMA(1, 0, At, B0); PG8_BAR; PG8_SCHED;
            PG8_STAGE(PG8_SB(1, 1), b3 + hstepB, voffB);
            PG8_WAIT_V(6); PG8_BAR; PG8_MMA(1, 1, At, B1); PG8_BAR;
        }
        }
#undef PG8_TRIP_HEAD
#undef PG8_TRIP_SP2
        if constexpr (ALIGN_EPI) { if (wr == 0) PG8_BAR; }
        if constexpr (!Epi::AFTER_DRAIN) { E(acc, cur, wr, wc, fr, fq); S.done(cur); }
        if (!has_next) break;
        if constexpr (!SP2) {
#pragma unroll
        for (int a = 0; a < 2; ++a)
#pragma unroll
            for (int b = 0; b < 2; ++b)
#pragma unroll
                for (int m = 0; m < 4; ++m)
#pragma unroll
                    for (int n = 0; n < 2; ++n) acc[a][b][m][n] = (f32x4){0.f, 0.f, 0.f, 0.f};
        }
        cur = nxt; cA = nA; cB = nB; ++ui;
        if constexpr (ALIGN_EPI) { if (wr == 1) PG8_BAR; }
    }
    PG8_WAIT_V(0);
    if constexpr (!ALIGN_EPI) { if (wr == 0) PG8_BAR; }
    PG8_BAR;
    if constexpr (Epi::AFTER_DRAIN) { E.fused(acc, cur, wr, wc, fr, fq, lds, wid, lane); S.done(cur); }
#undef PG8_SA
#undef PG8_SB
#undef PG8_STAGE
#undef PG8_LDA
#undef PG8_LDB
#undef PG8_MMA
#undef PG8_MMAZ
#undef PG8_WAIT_V
#undef PG8_WAIT_L
#undef PG8_BAR
#undef PG8_SCHED
}
}
#define GAS __attribute__((address_space(1)))
#define LAS __attribute__((address_space(3)))
typedef unsigned short bf16;
typedef unsigned v4u __attribute__((ext_vector_type(4)));
typedef float f32x4 __attribute__((ext_vector_type(4)));
typedef short bf16x8 __attribute__((ext_vector_type(8)));
typedef GAS unsigned gu32;
typedef GAS unsigned long long gu64;
#define RLX_AGENT __ATOMIC_RELAXED, __HIP_MEMORY_SCOPE_AGENT
#define LDS_WAIT() asm volatile("s_waitcnt lgkmcnt(0)" ::: "memory")
#define VM_WAIT() asm volatile("s_waitcnt vmcnt(0)" ::: "memory")
__device__ __forceinline__ unsigned long long rt() { return __builtin_amdgcn_s_memrealtime(); }
__device__ __forceinline__ unsigned f2bf(float f) { unsigned u = __builtin_bit_cast(unsigned, f); return (u + 0x7fffu + ((u >> 16) & 1u)) >> 16; }
__device__ __forceinline__ unsigned pk2(float lo, float hi) { return f2bf(lo) | (f2bf(hi) << 16); }
#define XB_TMO      128
#define XB_XCNT(j)  (256  + 64 * (j))
#define XB_XSUB(j)  (1280 + 64 * (j))
#define XB_XGEN(j)  (2304 + 64 * (j))
#define XB_TOP      3328
#define XB_TOPGEN   3392
#define XCD_BAR_WORDS 3456
#define XB_SPIN_CAP (1u << 18)

__device__ __forceinline__ unsigned xb_ld(unsigned* p)              { return __hip_atomic_load(p, __ATOMIC_RELAXED, __HIP_MEMORY_SCOPE_AGENT); }
__device__ __forceinline__ unsigned xb_add(unsigned* p, unsigned v) { return __hip_atomic_fetch_add(p, v, __ATOMIC_RELAXED, __HIP_MEMORY_SCOPE_AGENT); }
__device__ __forceinline__ unsigned xb_xcc_id() { return (unsigned)__builtin_amdgcn_s_getreg((3 << 11) | 20) & 0xFu; }
#define XB_SPIN(cond, bar) do { unsigned _sp = 0; while (cond) { __builtin_amdgcn_s_sleep(1); \
    if ((++_sp & 255u) == 0u) { if (xb_ld(&(bar)[XB_TMO])) break; if (_sp > XB_SPIN_CAP) { atomicAdd(&(bar)[XB_TMO], 1u); break; } } } } while (0)

struct XcdBarrier {
    unsigned* bar; unsigned x;
    volatile LAS unsigned* st;
};

__device__ __forceinline__ XcdBarrier xcd_barrier_post(unsigned* bar, volatile LAS unsigned* st) {
    XcdBarrier b; b.bar = bar; b.x = xb_xcc_id(); b.st = st;
    if (threadIdx.x == 0) (void)xb_add(&bar[XB_XCNT(b.x)], 1u);
    return b;
}
__device__ __forceinline__ void xcd_barrier_complete(unsigned* bar, unsigned x, unsigned& nloc, unsigned& nx) {
    const unsigned G = gridDim.x * gridDim.y * gridDim.z;
    unsigned sum, cnt, mine, sp = 0u;
    for (;;) {
        sum = 0u; cnt = 0u; mine = 0u;
#pragma unroll
        for (unsigned j = 0; j < 16; ++j) { const unsigned c = xb_ld(&bar[XB_XCNT(j)]); sum += c; cnt += (c > 0u) ? 1u : 0u; mine = (j == x) ? c : mine; }
        if (sum == G) break;
        __builtin_amdgcn_s_sleep(1);
        if ((++sp & 255u) == 0u) { if (xb_ld(&bar[XB_TMO])) break; if (sp > XB_SPIN_CAP) { atomicAdd(&bar[XB_TMO], 1u); break; } }
    }
    nloc = mine > 0u ? mine : 1u; nx = cnt > 0u ? cnt : 1u;
}

__device__ __forceinline__ void xcd_barrier(const XcdBarrier& b) {
    asm volatile("s_waitcnt vmcnt(0)" ::: "memory");
    __syncthreads();
    if (threadIdx.x == 0) {
        unsigned* bar = b.bar; const unsigned bx_ = xb_xcc_id();
        __builtin_amdgcn_s_waitcnt(0);
        unsigned nloc = b.st[0], nx = b.st[1];
        if (nloc == 0u) { xcd_barrier_complete(bar, bx_, nloc, nx); b.st[0] = nloc; b.st[1] = nx; }
        const unsigned old = xb_add(&bar[XB_XSUB(bx_)], 1u);
        const unsigned gen = old / nloc;
        if (old + 1u == (gen + 1u) * nloc) {
            __builtin_amdgcn_fence(__ATOMIC_RELEASE, "agent");
            asm volatile("s_waitcnt vmcnt(0)" ::: "memory");
            const unsigned og = xb_add(&bar[XB_TOP], 1u);
            const unsigned tg = og / nx;
            if (og + 1u == (tg + 1u) * nx) xb_add(&bar[XB_TOPGEN], 1u);
            else XB_SPIN(xb_ld(&bar[XB_TOPGEN]) == tg, bar);
            __builtin_amdgcn_fence(__ATOMIC_ACQUIRE, "agent");
            xb_add(&bar[XB_XGEN(bx_)], 1u);
            asm volatile("s_waitcnt vmcnt(0)" ::: "memory");
        } else {
            XB_SPIN(xb_ld(&bar[XB_XGEN(bx_)]) == gen, bar);
            __builtin_amdgcn_fence(__ATOMIC_ACQUIRE, "agent");
            asm volatile("s_waitcnt vmcnt(0)" ::: "memory");
        }
    }
    __syncthreads();
}

constexpr int NWAVES = 8;
constexpr int BATCH = 4, SEQ = 8192, D = 2048, DEPTH = 4, HEADS = 8, FF = 5632, INCOLS = 16384, NCHUNK = SEQ / 128;
constexpr int M = BATCH * SEQ;
constexpr float EPS = 1e-6f;
constexpr size_t MiB = 1u << 20;
constexpr size_t WS_CTL = 0, CTL_ZERO_BYTES = 1 * MiB;
constexpr size_t WS_CS = 1 * MiB;
constexpr size_t WS_WMASK = 33 * MiB;
constexpr size_t WS_WGU1 = 34 * MiB, WS_WD1 = 78 * MiB, WS_WIN = 100 * MiB, WS_WBR = 164 * MiB, WS_WBS = 172 * MiB, WS_WOUT = 180 * MiB, WS_WGU2 = 188 * MiB, WS_WD2 = 232 * MiB;
constexpr size_t WS_H = 256 * MiB;
constexpr size_t WS_BIG = 392 * MiB;
constexpr size_t WS_RT = 1452 * MiB;
constexpr size_t WS_SGST = WS_RT + 96 * MiB;
constexpr size_t WS_OPRE = WS_RT + 112 * MiB;
constexpr size_t WS_END = 1708 * MiB;
constexpr int LDT = pg8::LDT;
constexpr size_t TSTRIDE = (size_t)M * LDT;
constexpr int CW_BAR = 4096;
constexpr size_t WS_SSQ = WS_RT + 32 * MiB, SSQ_STRIDE = (size_t)M * 32;
constexpr int RING_BYTES = 131072;
constexpr int LDSCTL_OFF = RING_BYTES, MISC_OFF = LDSCTL_OFF + 320;
constexpr int RS_OFF = RING_BYTES + 1024;
constexpr int LDS_BYTES = 147456;

typedef short s16x4 __attribute__((ext_vector_type(4)));
typedef short v4i16_t __attribute__((ext_vector_type(4)));
typedef unsigned u32x2 __attribute__((ext_vector_type(2)));
typedef float f32x2v __attribute__((ext_vector_type(2)));

__device__ __forceinline__ float wave_sum(float v) {
#pragma unroll
    for (int o = 1; o < 64; o <<= 1) v += __shfl_xor(v, o);
    return v;
}
typedef float f32x2_t __attribute__((ext_vector_type(2))); typedef __bf16 bf16x2_t __attribute__((ext_vector_type(2)));
__device__ __forceinline__ unsigned cvtpk(float lo, float hi) { f32x2_t v = {lo, hi}; bf16x2_t b = __builtin_convertvector(v, bf16x2_t); return __builtin_bit_cast(unsigned, b); }
__device__ __forceinline__ float bflo(unsigned u) { return __uint_as_float(u << 16); }
__device__ __forceinline__ float bfhi(unsigned u) { return __uint_as_float(u & 0xffff0000u); }
__device__ __forceinline__ s16x4 vtr(const LAS unsigned char* p) { return __builtin_bit_cast(s16x4, __builtin_amdgcn_ds_read_tr16_b64_v4i16((LAS v4i16_t*)p)); }
__device__ __forceinline__ bf16x8 lds_tr_frag(const LAS unsigned char* tile, int strideB, int k0, int c0, int lane) {
    const int g = lane >> 4, q = (lane & 15) >> 2, p = lane & 3;
    const LAS unsigned char* a = tile + (k0 + 8 * g + q) * strideB + (c0 + 4 * p) * 2;
    const s16x4 lo = vtr(a), hi = vtr(a + 4 * strideB);
    return __builtin_shufflevector(lo, hi, 0, 1, 2, 3, 4, 5, 6, 7);
}
__device__ __forceinline__ bf16x8 lds_tr_frag_c(const LAS unsigned char* tile, int strideB, int k0, int c0, int lane) {
    const int g = lane >> 4, q = (lane & 15) >> 2, p = lane & 3;
    const LAS unsigned char* a = tile + (k0 + 4 * g + q) * strideB + (c0 + 4 * p) * 2;
    const s16x4 lo = vtr(a), hi = vtr(a + 16 * strideB);
    return __builtin_shufflevector(lo, hi, 0, 1, 2, 3, 4, 5, 6, 7);
}
#define MFMA16(a, b, c) __builtin_amdgcn_mfma_f32_16x16x32_bf16((a), (b), (c), 0, 0, 0)
__device__ __forceinline__ float log2_gamma(int h) {
    const float x = __builtin_amdgcn_exp2f(-5.0f - (float)h);
    const float l = -x * (1.0f + x * (0.5f + x * (0.33333334f + x * (0.25f + x * (0.2f + x * 0.16666667f)))));
    return l * 1.44269504f;
}

__device__ __forceinline__ void conv_item(const float* W, int K, int N, bf16* WT, int mode, const float* gain, LAS float* scr, int item, int lane) {
    const int nblk = N / 32, kb = item / nblk, nb = item % nblk, k0 = 64 * kb, n0 = 32 * nb;
#pragma unroll
    for (int i = 0; i < 8; ++i) { const int kk = 8 * i + (lane >> 3), nn = 4 * (lane & 7);
        const f32x4 v = *(const f32x4*)(W + (size_t)(k0 + kk) * N + n0 + nn);
        LAS float* d = scr + kk * 33 + nn; d[0] = v[0]; d[1] = v[1]; d[2] = v[2]; d[3] = v[3]; }
    LDS_WAIT(); asm volatile("" ::: "memory");
    int r0 = n0;
    if (mode == 3) r0 = ((((n0 >> 11) + 5) & 7) << 11) + (n0 & 2047);
    if (mode == 1) { const int isg = n0 >= FF, j0 = isg ? n0 - FF : n0; r0 = 256 * (j0 >> 7) + (j0 & 127) + (isg ? 128 : 0); }
    const int c = lane & 7;
    f32x4 ga = {1.f, 1.f, 1.f, 1.f}, gb = {1.f, 1.f, 1.f, 1.f};
    if (gain) { ga = *(const f32x4*)(gain + k0 + 8 * c); gb = *(const f32x4*)(gain + k0 + 8 * c + 4); }
#pragma unroll
    for (int j = 0; j < 4; ++j) { const int n = (lane >> 3) + 8 * j; const LAS float* s = scr + (8 * c) * 33 + n;
        v4u o; o.x = pk2(s[0 * 33] * ga[0], s[1 * 33] * ga[1]); o.y = pk2(s[2 * 33] * ga[2], s[3 * 33] * ga[3]); o.z = pk2(s[4 * 33] * gb[0], s[5 * 33] * gb[1]); o.w = pk2(s[6 * 33] * gb[2], s[7 * 33] * gb[3]);
        *(GAS v4u*)(WT + (size_t)(r0 + n) * K + k0 + 8 * c) = o; }
    LDS_WAIT(); asm volatile("" ::: "memory");
}
struct ConvSrc { const float *gu1, *d1, *win, *br, *bs, *wo, *gu2, *d2, *sw, *g1, *gm, *g2; };
__device__ __forceinline__ void phase_conv(LAS unsigned char* lds, unsigned char* ws, const ConvSrc& s, int gw, int NGW, int wave, int lane) {
    asm volatile("" : "+v"(lane));
    LAS float* scr = (LAS float*)(lds + wave * 16384);
    constexpr int I_GU = (D / 64) * (2 * FF / 32), I_D = (FF / 64) * (D / 32), I_IN = (D / 64) * (INCOLS / 32), I_SQ = (D / 64) * (D / 32);
    constexpr int NITEMS = 2 * I_GU + 2 * I_D + I_IN + 3 * I_SQ;
    for (int it = gw; it < NITEMS; it += NGW) {
        int r = it;
        if (r < I_GU) { conv_item(s.gu1, D, 2 * FF, (bf16*)(ws + WS_WGU1), 1, s.g1, scr, r, lane); continue; } r -= I_GU;
        if (r < I_GU) { conv_item(s.gu2, D, 2 * FF, (bf16*)(ws + WS_WGU2), 1, s.g2, scr, r, lane); continue; } r -= I_GU;
        if (r < I_D) { conv_item(s.d1, FF, D, (bf16*)(ws + WS_WD1), 0, nullptr, scr, r, lane); continue; } r -= I_D;
        if (r < I_D) { conv_item(s.d2, FF, D, (bf16*)(ws + WS_WD2), 0, nullptr, scr, r, lane); continue; } r -= I_D;
        if (r < I_IN) { conv_item(s.win, D, INCOLS, (bf16*)(ws + WS_WIN), 3, s.gm, scr, r, lane); continue; } r -= I_IN;
        if (r < I_SQ) { conv_item(s.br, D, D, (bf16*)(ws + WS_WBR), 0, nullptr, scr, r, lane); continue; } r -= I_SQ;
        if (r < I_SQ) { conv_item(s.bs, D, D, (bf16*)(ws + WS_WBS), 0, nullptr, scr, r, lane); continue; } r -= I_SQ;
        conv_item(s.wo, D, D, (bf16*)(ws + WS_WOUT), 0, nullptr, scr, r, lane);
    }
    bf16* wm = (bf16*)(ws + WS_WMASK);
    for (int e = gw * 64 + lane; e < 8 * 128 * 128; e += NGW * 64) { const int j = e & 127, i = (e >> 7) & 127; wm[e] = (bf16)((j <= i) ? f2bf(s.sw[e]) : 0u); }
}
__device__ __forceinline__ void phase_final(const bf16* Xb, float* out, const float* gain, int gw, int NGW, int lane) {
    asm volatile("" : "+v"(lane));
    f32x4 g0[4], g1[4];
#pragma unroll
    for (int j = 0; j < 4; ++j) { g0[j] = *(const f32x4*)(gain + (lane + 64 * j) * 8); g1[j] = *(const f32x4*)(gain + (lane + 64 * j) * 8 + 4); }
    for (int m = gw; m < M; m += NGW) {
        const v4u* xr = (const v4u*)(Xb + (size_t)m * LDT) + lane;
        float x[4][8]; float s = 0.f;
#pragma unroll
        for (int j = 0; j < 4; ++j) { const v4u w = xr[64 * j];
            x[j][0] = bflo(w.x); x[j][1] = bfhi(w.x); x[j][2] = bflo(w.y); x[j][3] = bfhi(w.y); x[j][4] = bflo(w.z); x[j][5] = bfhi(w.z); x[j][6] = bflo(w.w); x[j][7] = bfhi(w.w);
#pragma unroll
            for (int e = 0; e < 8; ++e) s += x[j][e] * x[j][e]; }
        const float rs = 1.0f / sqrtf(wave_sum(s) * (1.0f / D) + EPS);
        float* orow = out + (size_t)m * D;
#pragma unroll
        for (int j = 0; j < 4; ++j) { f32x4 o0, o1;
            o0[0] = x[j][0] * rs * g0[j][0]; o0[1] = x[j][1] * rs * g0[j][1]; o0[2] = x[j][2] * rs * g0[j][2]; o0[3] = x[j][3] * rs * g0[j][3];
            o1[0] = x[j][4] * rs * g1[j][0]; o1[1] = x[j][5] * rs * g1[j][1]; o1[2] = x[j][6] * rs * g1[j][2]; o1[3] = x[j][7] * rs * g1[j][3];
            *(f32x4*)(orow + (lane + 64 * j) * 8) = o0; *(f32x4*)(orow + (lane + 64 * j) * 8 + 4) = o1; }
    }
}
#define LDS_BARRIER() do { asm volatile("s_waitcnt lgkmcnt(0)" ::: "memory"); __builtin_amdgcn_s_barrier(); asm volatile("" ::: "memory"); } while (0)
__device__ __forceinline__ bf16x8 lds_tr_pair(const LAS unsigned char* tile, int strideB, int r0, int r1, int c0, int lane) {
    const int q = (lane & 15) >> 2, p = lane & 3;
    const s16x4 lo = vtr(tile + (r0 + q) * strideB + (c0 + 4 * p) * 2), hi = vtr(tile + (r1 + q) * strideB + (c0 + 4 * p) * 2);
    return __builtin_shufflevector(lo, hi, 0, 1, 2, 3, 4, 5, 6, 7);
}
__device__ __forceinline__ void phase_ret(LAS unsigned char* lds, const bf16* Q, const bf16* Kb, const bf16* V, bf16* Opre, float* stats, int vcu, int G, int tid) {
    asm volatile("" : "+v"(tid));
    const int lane = tid & 63, w = __builtin_amdgcn_readfirstlane(tid >> 6), i16 = lane & 15, g4 = lane >> 4;
    const int ib = (w < 4) ? w : 11 - w;
    LAS unsigned char* K_t = lds;
    LAS unsigned char* V_t = lds + 69632;
    LAS unsigned char* RT_t = lds + 94208;
    for (int u = vcu; u < BATCH * HEADS * 8; u += G) {
        const int es = u & 7, h = (u >> 3) & 7, b = u >> 6, hc = h * 256;
        const float lg2 = log2_gamma(h), gamma_c = __builtin_amdgcn_exp2f(128.0f * lg2);
        const size_t tb = (size_t)b * SEQ;
        f32x4 r[2][2];
#pragma unroll
        for (int a = 0; a < 2; ++a)
#pragma unroll
            for (int c = 0; c < 2; ++c) r[a][c] = (f32x4){0.f, 0.f, 0.f, 0.f};
        { v4u zz = (v4u){0u, 0u, 0u, 0u}; asm volatile("" : "+v"(zz));
          int tz = tid; asm volatile("" : "+v"(tz));
          for (int c = tz; c < 17408 / 16; c += NWAVES * 64) *(LAS v4u*)(RT_t + c * 16) = zz; }
        v4u kpre[8], vpre;
        const bf16* kg = Kb + (tb + (tid >> 5)) * LDT + hc + (tid & 31) * 8;
        const bf16* vg = V + (tb + (tid >> 2)) * LDT + hc + 32 * es + (tid & 3) * 8;
        const bf16* qg = Q + (tb + 16 * ib + i16) * LDT + hc + 8 * g4;
#pragma unroll
        for (int k = 0; k < 8; ++k) kpre[k] = *(const v4u*)(kg + (size_t)k * 16 * LDT);
        vpre = *(const v4u*)vg;
        const int i = 16 * ib + i16;
        bf16x8 qf[8];
#pragma unroll
        for (int ks = 0; ks < 8; ++ks) qf[ks] = *(const bf16x8*)(qg + 32 * ks);
        for (int n = 0; n < NCHUNK; ++n) {
            LDS_BARRIER();
#pragma unroll
            for (int k = 0; k < 8; ++k) *(LAS v4u*)(K_t + ((tid >> 5) + 16 * k) * 544 + (tid & 31) * 16) = kpre[k];
            *(LAS v4u*)(V_t + (tid >> 2) * 96 + (tid & 3) * 16) = vpre;
            {
                const size_t adv = (size_t)((n + 1 < NCHUNK) ? n + 1 : n) * 128 * LDT;
#pragma unroll
                for (int k = 0; k < 8; ++k) kpre[k] = *(const v4u*)(kg + adv + (size_t)k * 16 * LDT);
                vpre = *(const v4u*)(vg + adv);
            }
            LDS_BARRIER();
            const LAS unsigned char* RT_c = RT_t + (n & 1) * 17408; LAS unsigned char* RT_n = RT_t + ((n & 1) ^ 1) * 17408;
#define RET_ST_BLOCK1(S0, AD) do { bf16x8 k0_, k1_, k2_, k3_, k4_, k5_, k6_, k7_; asm volatile( \
                "ds_read_b128 %[k0], %[ad] offset:0\n\t" \
                "ds_read_b128 %[k1], %[ad] offset:64\n\t" \
                "ds_read_b128 %[k2], %[ad] offset:128\n\t" \
                "ds_read_b128 %[k3], %[ad] offset:192\n\t" \
                "ds_read_b128 %[k4], %[ad] offset:256\n\t" \
                "ds_read_b128 %[k5], %[ad] offset:320\n\t" \
                "ds_read_b128 %[k6], %[ad] offset:384\n\t" \
                "ds_read_b128 %[k7], %[ad] offset:448\n\t" \
                "s_waitcnt lgkmcnt(7)\n\t" \
                "v_mfma_f32_16x16x32_bf16 %[s0], %[k0], %[q0], 0\n\t" \
                "s_waitcnt lgkmcnt(6)\n\t" \
                "v_mfma_f32_16x16x32_bf16 %[s0], %[k1], %[q1], %[s0]\n\t" \
                "s_waitcnt lgkmcnt(5)\n\t" \
                "v_mfma_f32_16x16x32_bf16 %[s0], %[k2], %[q2], %[s0]\n\t" \
                "s_waitcnt lgkmcnt(4)\n\t" \
                "v_mfma_f32_16x16x32_bf16 %[s0], %[k3], %[q3], %[s0]\n\t" \
                "s_waitcnt lgkmcnt(3)\n\t" \
                "v_mfma_f32_16x16x32_bf16 %[s0], %[k4], %[q4], %[s0]\n\t" \
                "s_waitcnt lgkmcnt(2)\n\t" \
                "v_mfma_f32_16x16x32_bf16 %[s0], %[k5], %[q5], %[s0]\n\t" \
                "s_waitcnt lgkmcnt(1)\n\t" \
                "v_mfma_f32_16x16x32_bf16 %[s0], %[k6], %[q6], %[s0]\n\t" \
                "s_waitcnt lgkmcnt(0)\n\t" \
                "v_mfma_f32_16x16x32_bf16 %[s0], %[k7], %[q7], %[s0]\n\t" \
                "s_nop 7\n\t" \
                "s_nop 7\n\t" \
                "s_nop 7\n\t" \
                : [s0] "=&v"(S0), [k0] "=&v"(k0_), [k1] "=&v"(k1_), [k2] "=&v"(k2_), [k3] "=&v"(k3_), [k4] "=&v"(k4_), [k5] "=&v"(k5_), [k6] "=&v"(k6_), [k7] "=&v"(k7_) \
                : [ad] "v"(AD), [q0] "v"(qf[0]), [q1] "v"(qf[1]), [q2] "v"(qf[2]), [q3] "v"(qf[3]), [q4] "v"(qf[4]), [q5] "v"(qf[5]), [q6] "v"(qf[6]), [q7] "v"(qf[7]) : "memory"); } while (0)
#define RET_ST_BLOCK2(S0, S1, AD) do { bf16x8 k0_, k1_, k2_, k3_, k4_, k5_, k6_, k7_; asm volatile( \
                "ds_read_b128 %[k0], %[ad] offset:0\n\t" \
                "ds_read_b128 %[k1], %[ad] offset:8704\n\t" \
                "ds_read_b128 %[k2], %[ad] offset:64\n\t" \
                "ds_read_b128 %[k3], %[ad] offset:8768\n\t" \
                "ds_read_b128 %[k4], %[ad] offset:128\n\t" \
                "ds_read_b128 %[k5], %[ad] offset:8832\n\t" \
                "ds_read_b128 %[k6], %[ad] offset:192\n\t" \
                "ds_read_b128 %[k7], %[ad] offset:8896\n\t" \
                "s_waitcnt lgkmcnt(7)\n\t" \
                "v_mfma_f32_16x16x32_bf16 %[s0], %[k0], %[q0], 0\n\t" \
                "ds_read_b128 %[k0], %[ad] offset:256\n\t" \
                "s_waitcnt lgkmcnt(7)\n\t" \
                "v_mfma_f32_16x16x32_bf16 %[s1], %[k1], %[q0], 0\n\t" \
                "ds_read_b128 %[k1], %[ad] offset:8960\n\t" \
                "s_waitcnt lgkmcnt(7)\n\t" \
                "v_mfma_f32_16x16x32_bf16 %[s0], %[k2], %[q1], %[s0]\n\t" \
                "ds_read_b128 %[k2], %[ad] offset:320\n\t" \
                "s_waitcnt lgkmcnt(7)\n\t" \
                "v_mfma_f32_16x16x32_bf16 %[s1], %[k3], %[q1], %[s1]\n\t" \
                "ds_read_b128 %[k3], %[ad] offset:9024\n\t" \
                "s_waitcnt lgkmcnt(7)\n\t" \
                "v_mfma_f32_16x16x32_bf16 %[s0], %[k4], %[q2], %[s0]\n\t" \
                "ds_read_b128 %[k4], %[ad] offset:384\n\t" \
                "s_waitcnt lgkmcnt(7)\n\t" \
                "v_mfma_f32_16x16x32_bf16 %[s1], %[k5], %[q2], %[s1]\n\t" \
                "ds_read_b128 %[k5], %[ad] offset:9088\n\t" \
                "s_waitcnt lgkmcnt(7)\n\t" \
                "v_mfma_f32_16x16x32_bf16 %[s0], %[k6], %[q3], %[s0]\n\t" \
                "ds_read_b128 %[k6], %[ad] offset:448\n\t" \
                "s_waitcnt lgkmcnt(7)\n\t" \
                "v_mfma_f32_16x16x32_bf16 %[s1], %[k7], %[q3], %[s1]\n\t" \
                "ds_read_b128 %[k7], %[ad] offset:9152\n\t" \
                "s_waitcnt lgkmcnt(7)\n\t" \
                "v_mfma_f32_16x16x32_bf16 %[s0], %[k0], %[q4], %[s0]\n\t" \
                "s_waitcnt lgkmcnt(6)\n\t" \
                "v_mfma_f32_16x16x32_bf16 %[s1], %[k1], %[q4], %[s1]\n\t" \
                "s_waitcnt lgkmcnt(5)\n\t" \
                "v_mfma_f32_16x16x32_bf16 %[s0], %[k2], %[q5], %[s0]\n\t" \
                "s_waitcnt lgkmcnt(4)\n\t" \
                "v_mfma_f32_16x16x32_bf16 %[s1], %[k3], %[q5], %[s1]\n\t" \
                "s_waitcnt lgkmcnt(3)\n\t" \
                "v_mfma_f32_16x16x32_bf16 %[s0], %[k4], %[q6], %[s0]\n\t" \
                "s_waitcnt lgkmcnt(2)\n\t" \
                "v_mfma_f32_16x16x32_bf16 %[s1], %[k5], %[q6], %[s1]\n\t" \
                "s_waitcnt lgkmcnt(1)\n\t" \
                "v_mfma_f32_16x16x32_bf16 %[s0], %[k6], %[q7], %[s0]\n\t" \
                "s_waitcnt lgkmcnt(0)\n\t" \
                "v_mfma_f32_16x16x32_bf16 %[s1], %[k7], %[q7], %[s1]\n\t" \
                "s_nop 7\n\t" \
                "s_nop 7\n\t" \
                "s_nop 7\n\t" \
                : [s0] "=&v"(S0), [s1] "=&v"(S1), [k0] "=&v"(k0_), [k1] "=&v"(k1_), [k2] "=&v"(k2_), [k3] "=&v"(k3_), [k4] "=&v"(k4_), [k5] "=&v"(k5_), [k6] "=&v"(k6_), [k7] "=&v"(k7_) \
                : [ad] "v"(AD), [q0] "v"(qf[0]), [q1] "v"(qf[1]), [q2] "v"(qf[2]), [q3] "v"(qf[3]), [q4] "v"(qf[4]), [q5] "v"(qf[5]), [q6] "v"(qf[6]), [q7] "v"(qf[7]) : "memory"); } while (0)
#define RET_ST_BLOCK3(S0, S1, S2, AD) do { bf16x8 k0_, k1_, k2_, k3_, k4_, k5_, k6_, k7_; asm volatile( \
                "ds_read_b128 %[k0], %[ad] offset:0\n\t" \
                "ds_read_b128 %[k1], %[ad] offset:8704\n\t" \
                "ds_read_b128 %[k2], %[ad] offset:17408\n\t" \
                "ds_read_b128 %[k3], %[ad] offset:64\n\t" \
                "ds_read_b128 %[k4], %[ad] offset:8768\n\t" \
                "ds_read_b128 %[k5], %[ad] offset:17472\n\t" \
                "ds_read_b128 %[k6], %[ad] offset:128\n\t" \
                "ds_read_b128 %[k7], %[ad] offset:8832\n\t" \
                "s_waitcnt lgkmcnt(7)\n\t" \
                "v_mfma_f32_16x16x32_bf16 %[s0], %[k0], %[q0], 0\n\t" \
                "ds_read_b128 %[k0], %[ad] offset:17536\n\t" \
                "s_waitcnt lgkmcnt(7)\n\t" \
                "v_mfma_f32_16x16x32_bf16 %[s1], %[k1], %[q0], 0\n\t" \
                "ds_read_b128 %[k1], %[ad] offset:192\n\t" \
                "s_waitcnt lgkmcnt(7)\n\t" \
                "v_mfma_f32_16x16x32_bf16 %[s2], %[k2], %[q0], 0\n\t" \
                "ds_read_b128 %[k2], %[ad] offset:8896\n\t" \
                "s_waitcnt lgkmcnt(7)\n\t" \
                "v_mfma_f32_16x16x32_bf16 %[s0], %[k3], %[q1], %[s0]\n\t" \
                "ds_read_b128 %[k3], %[ad] offset:17600\n\t" \
                "s_waitcnt lgkmcnt(7)\n\t" \
                "v_mfma_f32_16x16x32_bf16 %[s1], %[k4], %[q1], %[s1]\n\t" \
                "ds_read_b128 %[k4], %[ad] offset:256\n\t" \
                "s_waitcnt lgkmcnt(7)\n\t" \
                "v_mfma_f32_16x16x32_bf16 %[s2], %[k5], %[q1], %[s2]\n\t" \
                "ds_read_b128 %[k5], %[ad] offset:8960\n\t" \
                "s_waitcnt lgkmcnt(7)\n\t" \
                "v_mfma_f32_16x16x32_bf16 %[s0], %[k6], %[q2], %[s0]\n\t" \
                "ds_read_b128 %[k6], %[ad] offset:17664\n\t" \
                "s_waitcnt lgkmcnt(7)\n\t" \
                "v_mfma_f32_16x16x32_bf16 %[s1], %[k7], %[q2], %[s1]\n\t" \
                "ds_read_b128 %[k7], %[ad] offset:320\n\t" \
                "s_waitcnt lgkmcnt(7)\n\t" \
                "v_mfma_f32_16x16x32_bf16 %[s2], %[k0], %[q2], %[s2]\n\t" \
                "ds_read_b128 %[k0], %[ad] offset:9024\n\t" \
                "s_waitcnt lgkmcnt(7)\n\t" \
                "v_mfma_f32_16x16x32_bf16 %[s0], %[k1], %[q3], %[s0]\n\t" \
                "ds_read_b128 %[k1], %[ad] offset:17728\n\t" \
                "s_waitcnt lgkmcnt(7)\n\t" \
                "v_mfma_f32_16x16x32_bf16 %[s1], %[k2], %[q3], %[s1]\n\t" \
                "ds_read_b128 %[k2], %[ad] offset:384\n\t" \
                "s_waitcnt lgkmcnt(7)\n\t" \
                "v_mfma_f32_16x16x32_bf16 %[s2], %[k3], %[q3], %[s2]\n\t" \
                "ds_read_b128 %[k3], %[ad] offset:9088\n\t" \
                "s_waitcnt lgkmcnt(7)\n\t" \
                "v_mfma_f32_16x16x32_bf16 %[s0], %[k4], %[q4], %[s0]\n\t" \
                "ds_read_b128 %[k4], %[ad] offset:17792\n\t" \
                "s_waitcnt lgkmcnt(7)\n\t" \
                "v_mfma_f32_16x16x32_bf16 %[s1], %[k5], %[q4], %[s1]\n\t" \
                "ds_read_b128 %[k5], %[ad] offset:448\n\t" \
                "s_waitcnt lgkmcnt(7)\n\t" \
                "v_mfma_f32_16x16x32_bf16 %[s2], %[k6], %[q4], %[s2]\n\t" \
                "ds_read_b128 %[k6], %[ad] offset:9152\n\t" \
                "s_waitcnt lgkmcnt(7)\n\t" \
                "v_mfma_f32_16x16x32_bf16 %[s0], %[k7], %[q5], %[s0]\n\t" \
                "ds_read_b128 %[k7], %[ad] offset:17856\n\t" \
                "s_waitcnt lgkmcnt(7)\n\t" \
                "v_mfma_f32_16x16x32_bf16 %[s1], %[k0], %[q5], %[s1]\n\t" \
                "s_waitcnt lgkmcnt(6)\n\t" \
                "v_mfma_f32_16x16x32_bf16 %[s2], %[k1], %[q5], %[s2]\n\t" \
                "s_waitcnt lgkmcnt(5)\n\t" \
                "v_mfma_f32_16x16x32_bf16 %[s0], %[k2], %[q6], %[s0]\n\t" \
                "s_waitcnt lgkmcnt(4)\n\t" \
                "v_mfma_f32_16x16x32_bf16 %[s1], %[k3], %[q6], %[s1]\n\t" \
                "s_waitcnt lgkmcnt(3)\n\t" \
                "v_mfma_f32_16x16x32_bf16 %[s2], %[k4], %[q6], %[s2]\n\t" \
                "s_waitcnt lgkmcnt(2)\n\t" \
                "v_mfma_f32_16x16x32_bf16 %[s0], %[k5], %[q7], %[s0]\n\t" \
                "s_waitcnt lgkmcnt(1)\n\t" \
                "v_mfma_f32_16x16x32_bf16 %[s1], %[k6], %[q7], %[s1]\n\t" \
                "s_waitcnt lgkmcnt(0)\n\t" \
                "v_mfma_f32_16x16x32_bf16 %[s2], %[k7], %[q7], %[s2]\n\t" \
                "s_nop 7\n\t" \
                "s_nop 7\n\t" \
                "s_nop 7\n\t" \
                : [s0] "=&v"(S0), [s1] "=&v"(S1), [s2] "=&v"(S2), [k0] "=&v"(k0_), [k1] "=&v"(k1_), [k2] "=&v"(k2_), [k3] "=&v"(k3_), [k4] "=&v"(k4_), [k5] "=&v"(k5_), [k6] "=&v"(k6_), [k7] "=&v"(k7_) \
                : [ad] "v"(AD), [q0] "v"(qf[0]), [q1] "v"(qf[1]), [q2] "v"(qf[2]), [q3] "v"(qf[3]), [q4] "v"(qf[4]), [q5] "v"(qf[5]), [q6] "v"(qf[6]), [q7] "v"(qf[7]) : "memory"); } while (0)
#define RET_ST_BLOCK4(S0, S1, S2, S3, AD) do { bf16x8 k0_, k1_, k2_, k3_, k4_, k5_, k6_, k7_; asm volatile( \
                "ds_read_b128 %[k0], %[ad] offset:0\n\t" \
                "ds_read_b128 %[k1], %[ad] offset:8704\n\t" \
                "ds_read_b128 %[k2], %[ad] offset:17408\n\t" \
                "ds_read_b128 %[k3], %[ad] offset:26112\n\t" \
                "ds_read_b128 %[k4], %[ad] offset:64\n\t" \
                "ds_read_b128 %[k5], %[ad] offset:8768\n\t" \
                "ds_read_b128 %[k6], %[ad] offset:17472\n\t" \
                "ds_read_b128 %[k7], %[ad] offset:26176\n\t" \
                "s_waitcnt lgkmcnt(7)\n\t" \
                "v_mfma_f32_16x16x32_bf16 %[s0], %[k0], %[q0], 0\n\t" \
                "ds_read_b128 %[k0], %[ad] offset:128\n\t" \
                "s_waitcnt lgkmcnt(7)\n\t" \
                "v_mfma_f32_16x16x32_bf16 %[s1], %[k1], %[q0], 0\n\t" \
                "ds_read_b128 %[k1], %[ad] offset:8832\n\t" \
                "s_waitcnt lgkmcnt(7)\n\t" \
                "v_mfma_f32_16x16x32_bf16 %[s2], %[k2], %[q0], 0\n\t" \
                "ds_read_b128 %[k2], %[ad] offset:17536\n\t" \
                "s_waitcnt lgkmcnt(7)\n\t" \
                "v_mfma_f32_16x16x32_bf16 %[s3], %[k3], %[q0], 0\n\t" \
                "ds_read_b128 %[k3], %[ad] offset:26240\n\t" \
                "s_waitcnt lgkmcnt(7)\n\t" \
                "v_mfma_f32_16x16x32_bf16 %[s0], %[k4], %[q1], %[s0]\n\t" \
                "ds_read_b128 %[k4], %[ad] offset:192\n\t" \
                "s_waitcnt lgkmcnt(7)\n\t" \
                "v_mfma_f32_16x16x32_bf16 %[s1], %[k5], %[q1], %[s1]\n\t" \
                "ds_read_b128 %[k5], %[ad] offset:8896\n\t" \
                "s_waitcnt lgkmcnt(7)\n\t" \
                "v_mfma_f32_16x16x32_bf16 %[s2], %[k6], %[q1], %[s2]\n\t" \
                "ds_read_b128 %[k6], %[ad] offset:17600\n\t" \
                "s_waitcnt lgkmcnt(7)\n\t" \
                "v_mfma_f32_16x16x32_bf16 %[s3], %[k7], %[q1], %[s3]\n\t" \
                "ds_read_b128 %[k7], %[ad] offset:26304\n\t" \
                "s_waitcnt lgkmcnt(7)\n\t" \
                "v_mfma_f32_16x16x32_bf16 %[s0], %[k0], %[q2], %[s0]\n\t" \
                "ds_read_b128 %[k0], %[ad] offset:256\n\t" \
                "s_waitcnt lgkmcnt(7)\n\t" \
                "v_mfma_f32_16x16x32_bf16 %[s1], %[k1], %[q2], %[s1]\n\t" \
                "ds_read_b128 %[k1], %[ad] offset:8960\n\t" \
                "s_waitcnt lgkmcnt(7)\n\t" \
                "v_mfma_f32_16x16x32_bf16 %[s2], %[k2], %[q2], %[s2]\n\t" \
                "ds_read_b128 %[k2], %[ad] offset:17664\n\t" \
                "s_waitcnt lgkmcnt(7)\n\t" \
                "v_mfma_f32_16x16x32_bf16 %[s3], %[k3], %[q2], %[s3]\n\t" \
                "ds_read_b128 %[k3], %[ad] offset:26368\n\t" \
                "s_waitcnt lgkmcnt(7)\n\t" \
                "v_mfma_f32_16x16x32_bf16 %[s0], %[k4], %[q3], %[s0]\n\t" \
                "ds_read_b128 %[k4], %[ad] offset:320\n\t" \
                "s_waitcnt lgkmcnt(7)\n\t" \
                "v_mfma_f32_16x16x32_bf16 %[s1], %[k5], %[q3], %[s1]\n\t" \
                "ds_read_b128 %[k5], %[ad] offset:9024\n\t" \
                "s_waitcnt lgkmcnt(7)\n\t" \
                "v_mfma_f32_16x16x32_bf16 %[s2], %[k6], %[q3], %[s2]\n\t" \
                "ds_read_b128 %[k6], %[ad] offset:17728\n\t" \
                "s_waitcnt lgkmcnt(7)\n\t" \
                "v_mfma_f32_16x16x32_bf16 %[s3], %[k7], %[q3], %[s3]\n\t" \
                "ds_read_b128 %[k7], %[ad] offset:26432\n\t" \
                "s_waitcnt lgkmcnt(7)\n\t" \
                "v_mfma_f32_16x16x32_bf16 %[s0], %[k0], %[q4], %[s0]\n\t" \
                "ds_read_b128 %[k0], %[ad] offset:384\n\t" \
                "s_waitcnt lgkmcnt(7)\n\t" \
                "v_mfma_f32_16x16x32_bf16 %[s1], %[k1], %[q4], %[s1]\n\t" \
                "ds_read_b128 %[k1], %[ad] offset:9088\n\t" \
                "s_waitcnt lgkmcnt(7)\n\t" \
                "v_mfma_f32_16x16x32_bf16 %[s2], %[k2], %[q4], %[s2]\n\t" \
                "ds_read_b128 %[k2], %[ad] offset:17792\n\t" \
                "s_waitcnt lgkmcnt(7)\n\t" \
                "v_mfma_f32_16x16x32_bf16 %[s3], %[k3], %[q4], %[s3]\n\t" \
                "ds_read_b128 %[k3], %[ad] offset:26496\n\t" \
                "s_waitcnt lgkmcnt(7)\n\t" \
                "v_mfma_f32_16x16x32_bf16 %[s0], %[k4], %[q5], %[s0]\n\t" \
                "ds_read_b128 %[k4], %[ad] offset:448\n\t" \
                "s_waitcnt lgkmcnt(7)\n\t" \
                "v_mfma_f32_16x16x32_bf16 %[s1], %[k5], %[q5], %[s1]\n\t" \
                "ds_read_b128 %[k5], %[ad] offset:9152\n\t" \
                "s_waitcnt lgkmcnt(7)\n\t" \
                "v_mfma_f32_16x16x32_bf16 %[s2], %[k6], %[q5], %[s2]\n\t" \
                "ds_read_b128 %[k6], %[ad] offset:17856\n\t" \
                "s_waitcnt lgkmcnt(7)\n\t" \
                "v_mfma_f32_16x16x32_bf16 %[s3], %[k7], %[q5], %[s3]\n\t" \
                "ds_read_b128 %[k7], %[ad] offset:26560\n\t" \
                "s_waitcnt lgkmcnt(7)\n\t" \
                "v_mfma_f32_16x16x32_bf16 %[s0], %[k0], %[q6], %[s0]\n\t" \
                "s_waitcnt lgkmcnt(6)\n\t" \
                "v_mfma_f32_16x16x32_bf16 %[s1], %[k1], %[q6], %[s1]\n\t" \
                "s_waitcnt lgkmcnt(5)\n\t" \
                "v_mfma_f32_16x16x32_bf16 %[s2], %[k2], %[q6], %[s2]\n\t" \
                "s_waitcnt lgkmcnt(4)\n\t" \
                "v_mfma_f32_16x16x32_bf16 %[s3], %[k3], %[q6], %[s3]\n\t" \
                "s_waitcnt lgkmcnt(3)\n\t" \
                "v_mfma_f32_16x16x32_bf16 %[s0], %[k4], %[q7], %[s0]\n\t" \
                "s_waitcnt lgkmcnt(2)\n\t" \
                "v_mfma_f32_16x16x32_bf16 %[s1], %[k5], %[q7], %[s1]\n\t" \
                "s_waitcnt lgkmcnt(1)\n\t" \
                "v_mfma_f32_16x16x32_bf16 %[s2], %[k6], %[q7], %[s2]\n\t" \
                "s_waitcnt lgkmcnt(0)\n\t" \
                "v_mfma_f32_16x16x32_bf16 %[s3], %[k7], %[q7], %[s3]\n\t" \
                "s_nop 7\n\t" \
                "s_nop 7\n\t" \
                "s_nop 7\n\t" \
                : [s0] "=&v"(S0), [s1] "=&v"(S1), [s2] "=&v"(S2), [s3] "=&v"(S3), [k0] "=&v"(k0_), [k1] "=&v"(k1_), [k2] "=&v"(k2_), [k3] "=&v"(k3_), [k4] "=&v"(k4_), [k5] "=&v"(k5_), [k6] "=&v"(k6_), [k7] "=&v"(k7_) \
                : [ad] "v"(AD), [q0] "v"(qf[0]), [q1] "v"(qf[1]), [q2] "v"(qf[2]), [q3] "v"(qf[3]), [q4] "v"(qf[4]), [q5] "v"(qf[5]), [q6] "v"(qf[6]), [q7] "v"(qf[7]) : "memory"); } while (0)
#define RET_PACK(P0) do { _Pragma("unroll") for (int p_ = 0; p_ < 2; ++p_) { float m[8]; \
                _Pragma("unroll") for (int rr = 0; rr < 4; ++rr) { const int j0 = 32 * (P0 + p_) + 4 * g4 + rr, j1 = j0 + 16; \
                    m[rr] = (j0 <= i) ? sacc[2 * p_][rr] : 0.f; \
                    m[4 + rr] = (j1 <= i) ? sacc[2 * p_ + 1][rr] : 0.f; } \
                v4u sw; sw.x = cvtpk(m[0], m[1]); sw.y = cvtpk(m[2], m[3]); sw.z = cvtpk(m[4], m[5]); sw.w = cvtpk(m[6], m[7]); \
                sf[P0 + p_] = __builtin_bit_cast(bf16x8, sw); } } while (0)
            bf16x8 sf[4];
            { f32x4 sacc[4];
              const unsigned kad = (unsigned)(size_t)(K_t + i16 * 544 + 16 * g4);
#define RET_ST_N(NB_, AD_) do { const f32x4 z4_ = (f32x4){0.f, 0.f, 0.f, 0.f}; \
                if ((NB_) == 4) RET_ST_BLOCK4(sacc[0], sacc[1], sacc[2], sacc[3], AD_); \
                else if ((NB_) == 3) { RET_ST_BLOCK3(sacc[0], sacc[1], sacc[2], AD_); sacc[3] = z4_; } \
                else if ((NB_) == 2) { RET_ST_BLOCK2(sacc[0], sacc[1], AD_); sacc[2] = z4_; sacc[3] = z4_; } \
                else { RET_ST_BLOCK1(sacc[0], AD_); sacc[1] = z4_; sacc[2] = z4_; sacc[3] = z4_; } } while (0)
              const int nb1 = (ib < 3) ? ib + 1 : 4;
              RET_ST_N(nb1, kad);
              RET_PACK(0);
              if (ib >= 4) { const unsigned kad2 = kad + 34816u; const int nb2 = ib - 3; RET_ST_N(nb2, kad2); RET_PACK(2); }
              else { sf[2] = __builtin_bit_cast(bf16x8, (v4u){0u, 0u, 0u, 0u}); sf[3] = sf[2]; } }
#undef RET_ST_N
#undef RET_PACK
#undef RET_ST_BLOCK1
#undef RET_ST_BLOCK2
#undef RET_ST_BLOCK3
#undef RET_ST_BLOCK4
            f32x4 o[2];
            o[0] = (f32x4){0.f, 0.f, 0.f, 0.f}; o[1] = (f32x4){0.f, 0.f, 0.f, 0.f};
#pragma unroll
            for (int k2 = 0; k2 < 8; k2 += 2) {
                bf16x8 rf[2][2];
#pragma unroll
                for (int kk = 0; kk < 2; ++kk)
#pragma unroll
                    for (int eb = 0; eb < 2; ++eb) rf[kk][eb] = *(const LAS bf16x8*)(RT_c + (16 * eb + i16) * 544 + (32 * (k2 + kk) + 8 * g4) * 2);
                asm volatile("" ::: "memory");
#pragma unroll
                for (int kk = 0; kk < 2; ++kk)
#pragma unroll
                    for (int eb = 0; eb < 2; ++eb) o[eb] = MFMA16(rf[kk][eb], qf[k2 + kk], o[eb]);
            }
            bf16x8 vfi[4][2];
#pragma unroll
            for (int p = 0; p < 4; ++p)
#pragma unroll
                for (int eb = 0; eb < 2; ++eb) vfi[p][eb] = lds_tr_pair(V_t, 96, 32 * p + 4 * g4, 32 * p + 16 + 4 * g4, 16 * eb, lane);
            asm volatile("" ::: "memory");
#pragma unroll
            for (int p = 0; p < 4; ++p)
#pragma unroll
                for (int eb = 0; eb < 2; ++eb) o[eb] = MFMA16(vfi[p][eb], sf[p], o[eb]);
            { const size_t advq = (size_t)((n + 1 < NCHUNK) ? n + 1 : n) * 128 * LDT;
#pragma unroll
              for (int ks = 0; ks < 8; ++ks) qf[ks] = *(const bf16x8*)(qg + advq + 32 * ks); }
            { const size_t token = tb + (size_t)n * 128 + i; float s = 0.f, q = 0.f;
#pragma unroll
              for (int eb = 0; eb < 2; ++eb) { u32x2 pk; pk.x = cvtpk(o[eb][0], o[eb][1]); pk.y = cvtpk(o[eb][2], o[eb][3]);
                  *(u32x2*)(Opre + token * LDT + hc + 32 * es + 16 * eb + 4 * g4) = pk;
#pragma unroll
                  for (int rr = 0; rr < 4; ++rr) { s += o[eb][rr]; q += o[eb][rr] * o[eb][rr]; } }
              s += __shfl_xor(s, 16); q += __shfl_xor(q, 16); s += __shfl_xor(s, 32); q += __shfl_xor(q, 32);
              if (g4 == 0) *(f32x2v*)(stats + ((token * 8 + h) * 8 + es) * 2) = (f32x2v){s, q}; }
            if (n + 1 < NCHUNK) {
#pragma unroll
                for (int k2 = 0; k2 < 4; k2 += 2) {
                    bf16x8 kfs[2][2], vfs[2][2];
#pragma unroll
                    for (int kk = 0; kk < 2; ++kk) { kfs[kk][0] = lds_tr_frag_c(K_t, 544, 32 * (k2 + kk), 32 * w, lane); kfs[kk][1] = lds_tr_frag_c(K_t, 544, 32 * (k2 + kk), 32 * w + 16, lane);
                        vfs[kk][0] = lds_tr_frag_c(V_t, 96, 32 * (k2 + kk), 0, lane); vfs[kk][1] = lds_tr_frag_c(V_t, 96, 32 * (k2 + kk), 16, lane); }
                    asm volatile("" ::: "memory");
#pragma unroll
                    for (int kk = 0; kk < 2; ++kk) { r[0][0] = MFMA16(kfs[kk][0], vfs[kk][0], r[0][0]); r[0][1] = MFMA16(kfs[kk][0], vfs[kk][1], r[0][1]);
                        r[1][0] = MFMA16(kfs[kk][1], vfs[kk][0], r[1][0]); r[1][1] = MFMA16(kfs[kk][1], vfs[kk][1], r[1][1]); }
                }
#pragma unroll
                for (int a = 0; a < 2; ++a)
#pragma unroll
                    for (int c = 0; c < 2; ++c) r[a][c] = r[a][c] * gamma_c;
#pragma unroll
                for (int db = 0; db < 2; ++db)
#pragma unroll
                    for (int eb = 0; eb < 2; ++eb) { u32x2 pk; pk.x = cvtpk(r[db][eb][0], r[db][eb][1]); pk.y = cvtpk(r[db][eb][2], r[db][eb][3]);
                        *(LAS u32x2*)(RT_n + (16 * eb + i16) * 544 + (32 * w + 16 * db + 4 * g4) * 2) = pk; }
            }
        }
        LDS_BARRIER();
    }
}
__device__ __forceinline__ void phase_sgumix2(LAS unsigned char* lds, const bf16* WM, const bf16* VS, const float* sgst, const float* lngain, bf16* U, const float* sb, int vcu, int G, int tid) {
    asm volatile("" : "+v"(tid));
    const int lane = tid & 63, w = __builtin_amdgcn_readfirstlane(tid >> 6), i16 = lane & 15, g4 = lane >> 4;
    LAS unsigned char* W_t = lds;
    LAS unsigned char* V_t = lds + 34816;
    LAS float* mr = (LAS float*)(lds + 102400);
    for (int bn = vcu; bn < BATCH * NCHUNK; bn += G) {
        const size_t t0 = (size_t)bn * 128;
        LDS_BARRIER();
        if (tid < 128) { const f32x4* sp = (const f32x4*)(sgst + (t0 + tid) * 64); float s = 0.f, q = 0.f;
#pragma unroll
            for (int k = 0; k < 16; ++k) { const f32x4 v = sp[k]; s += v[0]; q += v[1]; s += v[2]; q += v[3]; }
            const float mean = s * (1.0f / 2048.0f), var = q * (1.0f / 2048.0f) - mean * mean;
            mr[tid * 2] = mean; mr[tid * 2 + 1] = 1.0f / sqrtf(fmaxf(var, 0.f) + EPS); }
        v4u wpre[4], vpre[8]; f32x4 gpre[2];
        const bf16* vg = VS + (t0 + (tid >> 5)) * LDT + (tid & 31) * 8;
        const bf16* wg = WM + (tid >> 4) * 128 + (tid & 15) * 8;
#pragma unroll
        for (int k = 0; k < 4; ++k) wpre[k] = *(const v4u*)(wg + k * 32 * 128);
#pragma unroll
        for (int k = 0; k < 8; ++k) vpre[k] = *(const v4u*)(vg + (size_t)k * 16 * LDT);
        gpre[0] = *(const f32x4*)(lngain + (tid & 31) * 8); gpre[1] = *(const f32x4*)(lngain + (tid & 31) * 8 + 4);
        for (int g = 0; g < 8; ++g) {
            const int c0 = g * 256;
            LDS_BARRIER();
#pragma unroll
            for (int k = 0; k < 4; ++k) *(LAS v4u*)(W_t + ((tid >> 4) + 32 * k) * 272 + (tid & 15) * 16) = wpre[k];
#pragma unroll
            for (int k = 0; k < 8; ++k) { const int row = (tid >> 5) + 16 * k; const float mean = mr[row * 2], rstd = mr[row * 2 + 1]; const v4u x = vpre[k];
                v4u o; o.x = cvtpk((bflo(x.x) - mean) * rstd * gpre[0][0], (bfhi(x.x) - mean) * rstd * gpre[0][1]); o.y = cvtpk((bflo(x.y) - mean) * rstd * gpre[0][2], (bfhi(x.y) - mean) * rstd * gpre[0][3]);
                o.z = cvtpk((bflo(x.z) - mean) * rstd * gpre[1][0], (bfhi(x.z) - mean) * rstd * gpre[1][1]); o.w = cvtpk((bflo(x.w) - mean) * rstd * gpre[1][2], (bfhi(x.w) - mean) * rstd * gpre[1][3]);
                *(LAS v4u*)(V_t + row * 528 + (tid & 31) * 16) = o; }
            { const int gn = (g + 1 < 8) ? g + 1 : g;
#pragma unroll
              for (int k = 0; k < 4; ++k) wpre[k] = *(const v4u*)(wg + (size_t)gn * 16384 + k * 32 * 128);
#pragma unroll
              for (int k = 0; k < 8; ++k) vpre[k] = *(const v4u*)(vg + gn * 256 + (size_t)k * 16 * LDT);
              gpre[0] = *(const f32x4*)(lngain + gn * 256 + (tid & 31) * 8); gpre[1] = *(const f32x4*)(lngain + gn * 256 + (tid & 31) * 8 + 4); }
            LDS_BARRIER();
            u32x2 uw[2][8];
#pragma unroll
            for (int ib = 0; ib < 8; ++ib)
#pragma unroll
                for (int cb = 0; cb < 2; ++cb) uw[cb][ib] = *(const u32x2*)(U + (t0 + 16 * ib + i16) * LDT + c0 + 32 * w + 16 * cb + 4 * g4);
            f32x4 acc[2][8];
#pragma unroll
            for (int a = 0; a < 2; ++a)
#pragma unroll
                for (int b = 0; b < 8; ++b) acc[a][b] = (f32x4){0.f, 0.f, 0.f, 0.f};
#pragma unroll
            for (int ks = 0; ks < 4; ++ks) {
                const bf16x8 vf0 = lds_tr_frag(V_t, 528, 32 * ks, 32 * w, lane), vf1 = lds_tr_frag(V_t, 528, 32 * ks, 32 * w + 16, lane);
#pragma unroll
                for (int ib = 0; ib < 8; ++ib) if (2 * ks <= ib) {
                    const bf16x8 wf = *(const LAS bf16x8*)(W_t + (16 * ib + i16) * 272 + (32 * ks + 8 * g4) * 2);
                    acc[0][ib] = MFMA16(vf0, wf, acc[0][ib]); acc[1][ib] = MFMA16(vf1, wf, acc[1][ib]); }
            }
#pragma unroll
            for (int ib = 0; ib < 8; ++ib) { const int i = 16 * ib + i16; const float bias = sb[g * 128 + i];
#pragma unroll
                for (int cb = 0; cb < 2; ++cb) { const u32x2 x = uw[cb][ib]; const f32x4 a = acc[cb][ib];
                    u32x2 o; o.x = cvtpk(bflo(x.x) * (a[0] + bias), bfhi(x.x) * (a[1] + bias)); o.y = cvtpk(bflo(x.y) * (a[2] + bias), bfhi(x.y) * (a[3] + bias));
                    *(u32x2*)(U + (t0 + i) * LDT + c0 + 32 * w + 16 * cb + 4 * g4) = o; } }
        }
    }
    LDS_BARRIER();
}
__device__ __forceinline__ void phase_retln(const bf16* Opre, const float* stats, const bf16* Gi, bf16* Gt, const float* gn, int gw, int NGW, int lane) {
    asm volatile("" : "+v"(lane));
    f32x4 gv[8];
#pragma unroll
    for (int h = 0; h < 8; ++h) gv[h] = *(const f32x4*)(gn + h * 256 + 4 * lane);
    for (int m = gw; m < M; m += NGW) {
        f32x2v st = *(const f32x2v*)(stats + ((size_t)m * 64 + lane) * 2);
        float s = st.x, q = st.y;
        s += __shfl_xor(s, 1); q += __shfl_xor(q, 1); s += __shfl_xor(s, 2); q += __shfl_xor(q, 2); s += __shfl_xor(s, 4); q += __shfl_xor(q, 4);
        const float mean_l = s * (1.0f / 256.0f), var_l = q * (1.0f / 256.0f) - mean_l * mean_l, rstd_l = 1.0f / sqrtf(fmaxf(var_l, 0.f) + EPS);
        const u32x2* op = (const u32x2*)(Opre + (size_t)m * LDT) + lane; u32x2* gp = (u32x2*)(Gt + (size_t)m * LDT) + lane; const u32x2* gi = (const u32x2*)(Gi + (size_t)m * LDT) + lane;
#pragma unroll
        for (int h = 0; h < 8; ++h) { const float mean = __shfl(mean_l, 8 * h), rstd = __shfl(rstd_l, 8 * h);
            const u32x2 ow = op[64 * h], gw2 = gi[64 * h];
            u32x2 y; y.x = cvtpk((bflo(ow.x) - mean) * rstd * gv[h][0] * pg8::silu_f(bflo(gw2.x)), (bfhi(ow.x) - mean) * rstd * gv[h][1] * pg8::silu_f(bfhi(gw2.x)));
            y.y = cvtpk((bflo(ow.y) - mean) * rstd * gv[h][2] * pg8::silu_f(bflo(gw2.y)), (bfhi(ow.y) - mean) * rstd * gv[h][3] * pg8::silu_f(bfhi(gw2.y)));
            gp[64 * h] = y; }
    }
}

__device__ __forceinline__ int fresh_tid() { int t = threadIdx.x; asm volatile("" : "+v"(t)); return t; }
struct Args { const void* in[19]; float* out; unsigned char* ws; };
__global__ void __launch_bounds__(NWAVES * 64, 2) fwd(Args args) {
    extern __shared__ __attribute__((aligned(16))) unsigned char lds_raw[];
    LAS unsigned char* lds = (LAS unsigned char*)lds_raw;
    volatile LAS unsigned* MISC = (volatile LAS unsigned*)(lds + MISC_OFF);
#define TID fresh_tid()
#define LANE (fresh_tid() & 63)
    const int wave = __builtin_amdgcn_readfirstlane(TID >> 6);
    const int G = gridDim.x; const int bx = blockIdx.x; const int vcu = (G % 8 == 0) ? (bx % 8) * (G / 8) + bx / 8 : bx;
    const int gw = vcu * NWAVES + wave, NGW = G * NWAVES;
    unsigned char* ws = args.ws; float* X = args.out;
    for (int u = TID; u < (LDS_BYTES - LDSCTL_OFF) / 4; u += NWAVES * 64) ((LAS unsigned*)(lds + LDSCTL_OFF))[u] = 0u;
    __syncthreads();
    XcdBarrier bar = xcd_barrier_post((unsigned*)(ws + WS_CTL) + CW_BAR, MISC + 8);

    bf16* Hb = (bf16*)(ws + WS_H);
    bf16* BIG = (bf16*)(ws + WS_BIG);
    bf16 *tQ = BIG, *tK = BIG + TSTRIDE, *tV = BIG + 2 * TSTRIDE, *tG = BIG + 3 * TSTRIDE, *tU = BIG + 4 * TSTRIDE, *tVS = BIG + 5 * TSTRIDE, *tGA = BIG + 6 * TSTRIDE, *tGB = BIG + 7 * TSTRIDE;
    float* CS = (float*)(ws + WS_CS);
    bf16* RT = (bf16*)(ws + WS_RT);

    float* SSQ = (float*)(ws + WS_SSQ);
    {
        for (int m = gw; m < M; m += NGW) {
            const f32x4* xr = (const f32x4*)((const float*)args.in[0] + (size_t)m * D) + LANE; u32x2* ho = (u32x2*)(Hb + (size_t)m * LDT) + LANE;
            float sq = 0.f;
#pragma unroll
            for (int j = 0; j < 8; ++j) { const f32x4 v = xr[64 * j]; u32x2 w; w.x = cvtpk(v[0], v[1]); w.y = cvtpk(v[2], v[3]); ho[64 * j] = w; sq += (v[0] * v[0] + v[1] * v[1]) + (v[2] * v[2] + v[3] * v[3]); }
            sq = wave_sum(sq);
            if (LANE < 32) SSQ[(size_t)m * 32 + LANE] = (LANE == 0) ? sq : 0.0f;
        }
        const size_t gt = (size_t)bx * (NWAVES * 64) + TID, gs = (size_t)G * (NWAVES * 64);
        const int* pos = (const int*)args.in[1];
        for (size_t i = gt; i < (size_t)M * 128; i += gs) { const int tkn = (int)(i >> 7), j = (int)(i & 127);
            double inv = 0.15915494309189535;
            inv *= (j & 1) ? 0.930572040929699 : 1.0; inv *= (j & 2) ? 0.8659643233600653 : 1.0; inv *= (j & 4) ? 0.7498942093324559 : 1.0; inv *= (j & 8) ? 0.5623413251903491 : 1.0;
            inv *= (j & 16) ? 0.31622776601683794 : 1.0; inv *= (j & 32) ? 0.1 : 1.0; inv *= (j & 64) ? 0.01 : 1.0;
            double t = (double)pos[tkn] * inv; t -= floor(t); const float tf = (float)t;
            CS[2 * i] = __builtin_amdgcn_cosf(tf); CS[2 * i + 1] = __builtin_amdgcn_sinf(tf); }
    }
    for (int it = 0; it < 2 * DEPTH; ++it) {
        const int l = it >> 1, second = it & 1;
        if (!second) {
            ConvSrc cs;
            cs.gu1 = (const float*)args.in[3] + (size_t)l * D * 2 * FF; cs.d1 = (const float*)args.in[4] + (size_t)l * FF * D; cs.win = (const float*)args.in[6] + (size_t)l * D * INCOLS;
            cs.br = (const float*)args.in[12] + (size_t)l * D * D; cs.bs = (const float*)args.in[13] + (size_t)l * D * D; cs.wo = (const float*)args.in[14] + (size_t)l * D * D;
            cs.gu2 = (const float*)args.in[16] + (size_t)l * D * 2 * FF; cs.d2 = (const float*)args.in[17] + (size_t)l * FF * D; cs.sw = (const float*)args.in[10] + (size_t)l * 8 * 128 * 128;
            cs.g1 = (const float*)args.in[2] + (size_t)l * D; cs.gm = (const float*)args.in[5] + (size_t)l * D; cs.g2 = (const float*)args.in[15] + (size_t)l * D;
            phase_conv(lds, ws, cs, gw, NGW, wave, LANE);
            xcd_barrier(bar);
        }
        {
            const int ci = 3 * l + (second ? 2 : 0);
            pg8::Gemm g{Hb, (const bf16*)(ws + (second ? WS_WGU2 : WS_WGU1)), M, 2 * FF, D, LDT, D}; pg8::StaticOrder S; S.init(M, 2 * FF, G, bx);
            pg8::EpiSwiglu E{BIG, FF, SSQ + (size_t)ci * SSQ_STRIDE, (LAS float*)(lds + RS_OFF), -1};
            pg8::gemm_phase<pg8::EpiSwiglu, pg8::StaticOrder, true, true>(lds, g, S, E);
        }
        xcd_barrier(bar);
        {
            const int pi = 3 * l + (second ? 3 : 1);
            pg8::Gemm g{BIG, (const bf16*)(ws + (second ? WS_WD2 : WS_WD1)), M, D, FF, FF, FF}; pg8::ReverseOrder S; S.init(M, D, G, bx);
            pg8::EpiResid E{0.5f, Hb, SSQ + (size_t)pi * SSQ_STRIDE};
            pg8::gemm_phase<pg8::EpiResid, pg8::ReverseOrder, true, true>(lds, g, S, E);
        }
        xcd_barrier(bar);
        if (!second) {
            {
                const int ci = 3 * l + 1;
                pg8::Gemm g{Hb, (const bf16*)(ws + WS_WIN), M, INCOLS, D, LDT, D}; pg8::StaticOrder S; S.init(M, INCOLS, G, bx);
                pg8::EpiIn E{BIG, TSTRIDE, CS, (const float*)args.in[7] + (size_t)l * 2 * D, SSQ + (size_t)ci * SSQ_STRIDE, (LAS float*)(lds + RS_OFF), -1, (float*)(ws + WS_SGST)};
                pg8::gemm_phase<pg8::EpiIn, pg8::StaticOrder, true, true>(lds, g, S, E);
            }
            xcd_barrier(bar);
            phase_ret(lds, tQ, tK, tV, (bf16*)(ws + WS_OPRE), (float*)(ws + WS_RT), vcu, G, TID);
            xcd_barrier(bar);
            phase_sgumix2(lds, (const bf16*)(ws + WS_WMASK), tVS, (const float*)(ws + WS_SGST), (const float*)args.in[9] + (size_t)l * 2048, tU, (const float*)args.in[11] + (size_t)l * 8 * 128, vcu, G, TID);
            phase_retln((const bf16*)(ws + WS_OPRE), (const float*)(ws + WS_RT), tG, tG, (const float*)args.in[8] + (size_t)l * 2048, gw, NGW, LANE);
            xcd_barrier(bar);
            {
                pg8::Gemm g{tG, (const bf16*)(ws + WS_WBR), M, D, D, LDT, D}; pg8::DualOrder S; S.init(M, D, G, bx); S.A2 = tU; S.B2 = (const bf16*)(ws + WS_WBS);
                pg8::EpiBr<2> E{tQ, tGA, tGB};
                pg8::gemm_phase<pg8::EpiBr<2>, pg8::DualOrder, true, true>(lds, g, S, E);
            }
            xcd_barrier(bar);
            {
                const int pi = 3 * l + 2;
                pg8::Gemm g{tQ, (const bf16*)(ws + WS_WOUT), M, D, D, LDT, D}; pg8::StaticOrder S; S.init(M, D, G, bx);
                pg8::EpiResid E{1.0f, Hb, SSQ + (size_t)pi * SSQ_STRIDE};
                pg8::gemm_phase<pg8::EpiResid, pg8::StaticOrder, true, true>(lds, g, S, E);
            }
            xcd_barrier(bar);
        }
    }
    phase_final(Hb, X, (const float*)args.in[18], gw, NGW, LANE);
}

extern "C" void kernel_launch(void* const* d_in, const int* in_sizes, int n_in, void* d_out, int out_size, void* d_ws, size_t ws_size, hipStream_t stream) {
    static int grid = 0;
    if (grid == 0) {
        if (n_in != 19 || in_sizes[0] != M * D || out_size != M * D || ws_size < WS_END) { fprintf(stderr, "kernel_launch: unexpected shapes / workspace (n_in %d, in0 %d, out %d, ws %zu, need %zu); nothing launched\n", n_in, n_in > 0 ? in_sizes[0] : -1, out_size, ws_size, (size_t)WS_END); grid = -1; return; }
        int dev = 0, cus = 0, per_cu = 0;
        if (hipGetDevice(&dev) != hipSuccess || hipDeviceGetAttribute(&cus, hipDeviceAttributeMultiprocessorCount, dev) != hipSuccess) { fprintf(stderr, "kernel_launch: device query failed\n"); grid = -1; return; }
        if (hipFuncSetAttribute((const void*)fwd, hipFuncAttributeMaxDynamicSharedMemorySize, LDS_BYTES) != hipSuccess) { fprintf(stderr, "kernel_launch: hipFuncSetAttribute failed\n"); grid = -1; return; }
        if (hipOccupancyMaxActiveBlocksPerMultiprocessor(&per_cu, (const void*)fwd, NWAVES * 64, LDS_BYTES) != hipSuccess || per_cu < 1) fprintf(stderr, "kernel_launch: note: occupancy query reports %d workgroups per CU\n", per_cu);
        (void)hipGetLastError();
        grid = cus;
    }
    if (grid < 0) return;
    if (hipMemsetAsync((char*)d_ws + WS_CTL, 0, CTL_ZERO_BYTES, stream) != hipSuccess) { fprintf(stderr, "kernel_launch: memset failed\n"); return; }
    Args a{};
    for (int i = 0; i < 19; ++i) a.in[i] = d_in[i];
    a.out = (float*)d_out; a.ws = (unsigned char*)d_ws;
    hipLaunchKernelGGL(fwd, dim3(grid), dim3(NWAVES * 64), LDS_BYTES, stream, a);
    const hipError_t le = hipPeekAtLastError();
    if (le != hipSuccess) fprintf(stderr, "kernel_launch: launch failed: %s\n", hipGetErrorName(le));
}
```

```cpp
#include <hip/hip_runtime.h>
#include <cstdio>
#include <cstdint>
#include <cmath>
namespace pg8 {
#define PG8_LAS __attribute__((address_space(3)))
typedef unsigned short bf16_t;
typedef short bf16x8 __attribute__((ext_vector_type(8)));
typedef float f32x4 __attribute__((ext_vector_type(4)));
typedef unsigned u32x4 __attribute__((ext_vector_type(4)));
constexpr int LDT = 2048 + 64;
constexpr int BM = 256, BK = 64, HALF = 128, HTB = HALF * BK * 2  , STAGE_BYTES = 8 * HTB, NXCD = 8, WGM = 8;

__host__ __device__ __forceinline__ int lds_byte(int r, int c) { const int st = (r >> 4) * 2 + (c >> 5), rr = r & 15, cc = c & 31, ob = rr * 64 + cc * 2; return st * 1024 + (ob ^ (((ob >> 9) & 1) << 5)); }
__host__ __device__ __forceinline__ void stage_rc(int b, int& R, int& C) { const int st = b / 1024, sb = b % 1024, swz = sb ^ (((sb >> 9) & 1) << 5); R = (st >> 1) * 16 + swz / 64; C = (st & 1) * 32 + (swz % 64) / 2; }
__host__ __device__ __forceinline__ int perm32(int rho) { const int n = rho >> 4, i = rho & 15; return 8 * (i >> 2) + 4 * n + (i & 3); }

struct Unit { int pm, pn, z; };
struct Gemm { const bf16_t* A; const bf16_t* Bt; int M, N, K; int lda, ldb; };

struct StaticOrder {
    int nM, nN, nwg, G, c;
    __host__ __device__ void init(int M, int N, int G_, int c_) { nM = M / BM; nN = N / BM; nwg = nM * nN; G = G_; c = c_; }
    __host__ __device__ bool next(int i, Unit& u) const {
        const long L = (long)i * G + c; if (L >= nwg) return false;
        int wgid = (int)L; { const int q = nwg / NXCD, r = nwg % NXCD, xcd = wgid % NXCD, off = wgid / NXCD; wgid = (xcd < r ? xcd * (q + 1) : r * (q + 1) + (xcd - r) * q) + off; }
        const int nig = WGM * nN, gid = wgid / nig, fm = gid * WGM, gsz = (nM - fm) < WGM ? (nM - fm) : WGM;
        u.pm = fm + ((wgid % nig) % gsz); u.pn = (wgid % nig) / gsz; u.z = 0; return true;
    }
    __device__ __forceinline__ void a_ready(const Unit&) const {}
    __device__ __forceinline__ void done(const Unit&) const {}
    __device__ __forceinline__ const bf16_t* opA(const Gemm& g, const Unit&) const { return g.A; }
    __device__ __forceinline__ const bf16_t* opB(const Gemm& g, const Unit&) const { return g.Bt; }
};
struct ReverseOrder : StaticOrder {
    __device__ bool next(int i, Unit& u) const { const int rounds = nwg / G; if (i >= rounds) return false; return StaticOrder::next(rounds - 1 - i, u); }
};
struct DualOrder : StaticOrder {
    const bf16_t* A2; const bf16_t* B2;
    __device__ bool next(int i, Unit& u) const { const int rounds = nwg / G; if (i >= 2 * rounds) return false; const bool ok = StaticOrder::next(i >= rounds ? i - rounds : i, u); u.z = (i >= rounds) ? 1 : 0; return ok; }
    __device__ __forceinline__ const bf16_t* opA(const Gemm& g, const Unit& u) const { return u.z ? A2 : g.A; }
    __device__ __forceinline__ const bf16_t* opB(const Gemm& g, const Unit& u) const { return u.z ? B2 : g.Bt; }
};
typedef float f32x2_c __attribute__((ext_vector_type(2))); typedef __bf16 bf16x2_c __attribute__((ext_vector_type(2)));
__device__ __forceinline__ unsigned cvt_pk_bf16(float lo, float hi) { f32x2_c v = {lo, hi}; bf16x2_c b = __builtin_convertvector(v, bf16x2_c); return __builtin_bit_cast(unsigned, b); }
typedef float f32x2 __attribute__((ext_vector_type(2)));
__device__ __forceinline__ f32x2 gelu_pk(f32x2 v) {
    const f32x2 av = __builtin_elementwise_abs(v), d = av * 0.2316418882f + 1.0f;
    f32x2 t; t.x = __builtin_amdgcn_rcpf(d.x); t.y = __builtin_amdgcn_rcpf(d.y);
    f32x2 q = t * 0.5307027145f + (-0.7265760135f); q = q * t + 0.7107068705f; q = q * t + (-0.142248368f); q = q * t + 0.127414796f; q = q * t;
    const f32x2 s = (v * v) * (-0.72134752044f);
    f32x2 e; e.x = __builtin_amdgcn_exp2f(s.x); e.y = __builtin_amdgcn_exp2f(s.y);
    const f32x2 m = v * (q * e), r = v - m;
    f32x2 o; o.x = v.x < 0.f ? m.x : r.x; o.y = v.y < 0.f ? m.y : r.y; return o;
}

__device__ __forceinline__ float bf_lo(unsigned u) { return __uint_as_float(u << 16); }
__device__ __forceinline__ float bf_hi(unsigned u) { return __uint_as_float(u & 0xffff0000u); }
__device__ __forceinline__ float silu_f(float g) { return g * __builtin_amdgcn_rcpf(1.0f + __builtin_amdgcn_exp2f(-1.44269504f * g)); }
__device__ __forceinline__ float sigmoid_f(float g) { return __builtin_amdgcn_rcpf(1.0f + __builtin_amdgcn_exp2f(-1.44269504f * g)); }

__device__ __forceinline__ float row_rs(const float* ssq, int row, int fq) {
    const float* pp = ssq + (size_t)row * 32 + 8 * fq; const f32x4 p0 = *(const f32x4*)pp, p1 = *(const f32x4*)(pp + 4);
    float s = ((p0[0] + p0[1]) + (p0[2] + p0[3])) + ((p1[0] + p1[1]) + (p1[2] + p1[3]));
    s += __shfl_xor(s, 16); s += __shfl_xor(s, 32);
    return __builtin_amdgcn_rsqf(s * (1.0f / 2048.0f) + 1e-6f);
}
struct EpiSwiglu {
    static constexpr bool PERM = true, AFTER_DRAIN = false; static constexpr int NST = 8;
    bf16_t* O; int ldc; const float* ssq;
    PG8_LAS float* rsl; mutable int cpm;
    __device__ __forceinline__ void operator()(const f32x4 (&acc)[2][2][4][2], const Unit& u, int wr, int wc, int fr, int fq) const {
        const int row0 = u.pm * BM + wr * 64 + fr, col0 = u.pn * HALF + wc * 32 + 8 * fq;
        PG8_LAS float* my = rsl + (wr * 4 + wc) * 128 + fr;
        if (u.pm != cpm) { cpm = u.pm;
#pragma unroll
            for (int ai = 0; ai < 2; ++ai)
#pragma unroll
                for (int m = 0; m < 4; ++m) { const float r = row_rs(ssq, row0 + ai * HALF + m * 16, fq); if (fq == 0) my[(ai * 4 + m) * 16] = r; } }
#pragma unroll
        for (int ai = 0; ai < 2; ++ai)
#pragma unroll
            for (int m = 0; m < 4; ++m) { bf16_t* rowp = O + (size_t)(row0 + ai * HALF + m * 16) * ldc + col0;
                const float rs = my[(ai * 4 + m) * 16];
                const f32x4 a0 = acc[ai][0][m][0] * rs, a1 = acc[ai][0][m][1] * rs, g0 = acc[ai][1][m][0] * rs, g1 = acc[ai][1][m][1] * rs;
                u32x4 w; w.x = cvt_pk_bf16(a0[0] * silu_f(g0[0]), a0[1] * silu_f(g0[1])); w.y = cvt_pk_bf16(a0[2] * silu_f(g0[2]), a0[3] * silu_f(g0[3]));
                w.z = cvt_pk_bf16(a1[0] * silu_f(g1[0]), a1[1] * silu_f(g1[1])); w.w = cvt_pk_bf16(a1[2] * silu_f(g1[2]), a1[3] * silu_f(g1[3]));
                *(u32x4*)rowp = w; }
    }
};
struct EpiResid {
    static constexpr bool PERM = true, AFTER_DRAIN = false; static constexpr int NST = 8;
    float scale; bf16_t* Hx; float* ssq;
    __device__ __forceinline__ void operator()(const f32x4 (&acc)[2][2][4][2], const Unit& u, int wr, int wc, int fr, int fq) const {
        const int row0 = u.pm * BM + wr * 64 + fr, col0 = u.pn * BM + wc * 32 + 8 * fq;
#pragma unroll
        for (int ai = 0; ai < 2; ++ai) {
            u32x4 xv[4][2];
#pragma unroll
            for (int m = 0; m < 4; ++m)
#pragma unroll
                for (int bj = 0; bj < 2; ++bj) xv[m][bj] = *(const u32x4*)(Hx + (size_t)(row0 + ai * HALF + m * 16) * LDT + col0 + bj * HALF);
#pragma unroll
            for (int m = 0; m < 4; ++m) { const int row = row0 + ai * HALF + m * 16; bf16_t* hp = Hx + (size_t)row * LDT + col0;
                float ss = 0.f;
#pragma unroll
                for (int bj = 0; bj < 2; ++bj) { const u32x4 x = xv[m][bj]; const f32x4 a0 = acc[ai][bj][m][0], a1 = acc[ai][bj][m][1];
                    const float y0 = bf_lo(x.x) + a0[0] * scale, y1 = bf_hi(x.x) + a0[1] * scale, y2 = bf_lo(x.y) + a0[2] * scale, y3 = bf_hi(x.y) + a0[3] * scale;
                    const float y4 = bf_lo(x.z) + a1[0] * scale, y5 = bf_hi(x.z) + a1[1] * scale, y6 = bf_lo(x.w) + a1[2] * scale, y7 = bf_hi(x.w) + a1[3] * scale;
                    ss += ((y0 * y0 + y1 * y1) + (y2 * y2 + y3 * y3)) + ((y4 * y4 + y5 * y5) + (y6 * y6 + y7 * y7));
                    u32x4 w; w.x = cvt_pk_bf16(y0, y1); w.y = cvt_pk_bf16(y2, y3); w.z = cvt_pk_bf16(y4, y5); w.w = cvt_pk_bf16(y6, y7);
                    *(u32x4*)(hp + bj * HALF) = w; }
                ss += __shfl_xor(ss, 16); ss += __shfl_xor(ss, 32);
                if (fq == 0) ssq[(size_t)row * 32 + u.pn * 4 + wc] = ss; }
            asm volatile("" ::: "memory"); }
    }
};
__device__ __forceinline__ float lg2_gamma_h(int h) {
    const float x = __builtin_amdgcn_exp2f(-5.0f - (float)h);
    const float l = -x * (1.0f + x * (0.5f + x * (0.33333334f + x * (0.25f + x * (0.2f + x * 0.16666667f)))));
    return l * 1.44269504f;
}
constexpr int GATE_PITCH = 2112;
struct EpiIn {
    static constexpr bool PERM = true, AFTER_DRAIN = false; static constexpr int NST = 8;
    bf16_t* O; size_t tstride; const float* cs; const float* bgate; const float* ssq; PG8_LAS float* rsl; mutable int cpm; float* sgst;
    __device__ __forceinline__ void operator()(const f32x4 (&acc)[2][2][4][2], const Unit& u, int wr, int wc, int fr, int fq) const {
        const int t = ((u.pn >> 3) + 3) & 7, hh = u.pn & 7;
        bf16_t* base = O + (size_t)t * tstride;
        const int row0 = u.pm * BM + wr * 64 + fr, cw = wc * 32 + 8 * fq, col0 = hh * BM + cw;
        PG8_LAS float* my = rsl + (wr * 4 + wc) * 128 + fr;
        if (u.pm != cpm) { cpm = u.pm;
#pragma unroll
            for (int ai = 0; ai < 2; ++ai)
#pragma unroll
                for (int m = 0; m < 4; ++m) { const float r = row_rs(ssq, row0 + ai * HALF + m * 16, fq); if (fq == 0) my[(ai * 4 + m) * 16] = r; } }
        if (t <= 1) {
            const float sc = (t == 1) ? 0.0625f : 1.0f, lgs = (t == 1) ? -lg2_gamma_h(hh) : lg2_gamma_h(hh);
#pragma unroll
            for (int ai = 0; ai < 2; ++ai) {
                f32x4 cv[4][4];
#pragma unroll
                for (int m = 0; m < 4; ++m) { const f32x4* cp = (const f32x4*)(cs + ((size_t)(row0 + ai * HALF + m * 16) * 128 + cw) * 2);
#pragma unroll
                    for (int q = 0; q < 4; ++q) cv[m][q] = cp[q]; }
#pragma unroll
                for (int m = 0; m < 4; ++m) { const int row = row0 + ai * HALF + m * 16;
                    const f32x4 c0 = cv[m][0], c1 = cv[m][1], c2 = cv[m][2], c3 = cv[m][3];
                    int rl = row; asm volatile("" : "+v"(rl));
                    const float rs = my[(ai * 4 + m) * 16] * sc * __builtin_amdgcn_exp2f((float)((rl & 127) + 1) * lgs);
                    const f32x4 xa0 = acc[ai][0][m][0] * rs, xa1 = acc[ai][0][m][1] * rs, xb0 = acc[ai][1][m][0] * rs, xb1 = acc[ai][1][m][1] * rs;
                    const float co[8] = {c0[0], c0[2], c1[0], c1[2], c2[0], c2[2], c3[0], c3[2]};
                    const float si[8] = {c0[1], c0[3], c1[1], c1[3], c2[1], c2[3], c3[1], c3[3]};
                    const float x1[8] = {xa0[0], xa0[1], xa0[2], xa0[3], xa1[0], xa1[1], xa1[2], xa1[3]};
                    const float x2[8] = {xb0[0], xb0[1], xb0[2], xb0[3], xb1[0], xb1[1], xb1[2], xb1[3]};
                    float o1[8], o2[8];
#pragma unroll
                    for (int j = 0; j < 8; ++j) { o1[j] = x1[j] * co[j] - x2[j] * si[j]; o2[j] = x1[j] * si[j] + x2[j] * co[j]; }
                    u32x4 w1, w2;
                    w1.x = cvt_pk_bf16(o1[0], o1[1]); w1.y = cvt_pk_bf16(o1[2], o1[3]); w1.z = cvt_pk_bf16(o1[4], o1[5]); w1.w = cvt_pk_bf16(o1[6], o1[7]);
                    w2.x = cvt_pk_bf16(o2[0], o2[1]); w2.y = cvt_pk_bf16(o2[2], o2[3]); w2.z = cvt_pk_bf16(o2[4], o2[5]); w2.w = cvt_pk_bf16(o2[6], o2[7]);
                    bf16_t* rowp = base + (size_t)row * LDT + col0;
                    *(u32x4*)rowp = w1; *(u32x4*)(rowp + HALF) = w2; }
                asm volatile("" ::: "memory"); }
        } else if (t == 2) other<2>(acc, base, row0, col0, my, t, hh, wc, fq);
        else if (t == 3) other<3>(acc, base, row0, col0, my, t, hh, wc, fq);
        else if (t == 4) other<4>(acc, base, row0, col0, my, t, hh, wc, fq);
        else if (t == 5) other<5>(acc, base, row0, col0, my, t, hh, wc, fq);
        else other<6>(acc, base, row0, col0, my, t, hh, wc, fq);
    }
    template <int TT> __device__ __forceinline__ void other(const f32x4 (&acc)[2][2][4][2], bf16_t* base, int row0, int col0, PG8_LAS float* my, int t, int hh, int wc, int fq) const {
        asm volatile("" : "+v"(row0), "+v"(col0), "+v"(fq));
        f32x4 bv[2][2];
#pragma unroll
        for (int bj = 0; bj < 2; ++bj)
#pragma unroll
            for (int n = 0; n < 2; ++n) bv[bj][n] = (TT >= 6) ? *(const f32x4*)(bgate + (t - 6) * 2048 + col0 + bj * HALF + 4 * n) : (f32x4){0.f, 0.f, 0.f, 0.f};
#pragma unroll
        for (int ai = 0; ai < 2; ++ai)
#pragma unroll
            for (int m = 0; m < 4; ++m) { bf16_t* rowp = base + (size_t)(row0 + ai * HALF + m * 16) * LDT + col0;
                const float rs = my[(ai * 4 + m) * 16]; float ps = 0.f, pq = 0.f; u32x4 gq = {0u, 0u, 0u, 0u};
#pragma unroll
                for (int bj = 0; bj < 2; ++bj) { f32x4 v0 = acc[ai][bj][m][0] * rs + bv[bj][0], v1 = acc[ai][bj][m][1] * rs + bv[bj][1];
                    if (TT == 3) {
#pragma unroll
                        for (int j = 0; j < 4; ++j) { v0[j] = silu_f(v0[j]); v1[j] = silu_f(v1[j]); } }
                    else if (TT == 4 || TT == 5) { f32x2 a = gelu_pk((f32x2){v0[0], v0[1]}), b = gelu_pk((f32x2){v0[2], v0[3]}), c = gelu_pk((f32x2){v1[0], v1[1]}), d = gelu_pk((f32x2){v1[2], v1[3]});
                        v0 = (f32x4){a.x, a.y, b.x, b.y}; v1 = (f32x4){c.x, c.y, d.x, d.y};
                        if (TT == 5) { ps += ((v0[0] + v0[1]) + (v0[2] + v0[3])) + ((v1[0] + v1[1]) + (v1[2] + v1[3]));
                            pq += ((v0[0] * v0[0] + v0[1] * v0[1]) + (v0[2] * v0[2] + v0[3] * v0[3])) + ((v1[0] * v1[0] + v1[1] * v1[1]) + (v1[2] * v1[2] + v1[3] * v1[3])); } }
                    else if (TT >= 6) {
#pragma unroll
                        for (int j = 0; j < 4; ++j) { v0[j] = sigmoid_f(v0[j]); v1[j] = sigmoid_f(v1[j]); } }
                    if (TT >= 6) { unsigned b0 = 0u, b1 = 0u;
#pragma unroll
                        for (int j = 0; j < 4; ++j) { b0 = __builtin_amdgcn_cvt_pk_u8_f32(__builtin_rintf(v0[j] * 255.0f), j, b0); b1 = __builtin_amdgcn_cvt_pk_u8_f32(__builtin_rintf(v1[j] * 255.0f), j, b1); }
                        if (bj == 0) { gq.x = b0; gq.y = b1; } else { gq.z = b0; gq.w = b1; } }
                    else { u32x4 w; w.x = cvt_pk_bf16(v0[0], v0[1]); w.y = cvt_pk_bf16(v0[2], v0[3]); w.z = cvt_pk_bf16(v1[0], v1[1]); w.w = cvt_pk_bf16(v1[2], v1[3]);
                        *(u32x4*)(rowp + bj * HALF) = w; } }
                if (TT >= 6) *(u32x4*)((unsigned char*)base + (size_t)(row0 + ai * HALF + m * 16) * GATE_PITCH + hh * 256 + (wc * 4 + fq) * 16) = gq;
                if (TT == 5) { ps += __shfl_xor(ps, 16); pq += __shfl_xor(pq, 16); ps += __shfl_xor(ps, 32); pq += __shfl_xor(pq, 32);
                    if (fq == 0) *(f32x2*)(sgst + ((size_t)((row0 + ai * HALF + m * 16) * 8 + hh) * 4 + wc) * 2) = (f32x2){ps, pq}; } }
    }
};
template <int MODE> struct EpiBr {
    static constexpr bool PERM = true, AFTER_DRAIN = false; static constexpr int NST = 0;
    bf16_t* T; const bf16_t* gate; const bf16_t* gate2;
    __device__ __forceinline__ void operator()(const f32x4 (&acc)[2][2][4][2], const Unit& u, int wr, int wc, int fr, int fq) const {
        const int row0 = u.pm * BM + wr * 64 + fr, col0 = u.pn * BM + wc * 32 + 8 * fq;
        const bool addp = (MODE == 1) || (MODE == 2 && u.z != 0); const bf16_t* const gt = (MODE == 2 && u.z != 0) ? gate2 : gate;
#pragma unroll
        for (int ai = 0; ai < 2; ++ai) {
            u32x4 gv[4], pv[4][2];
#pragma unroll
            for (int m = 0; m < 4; ++m) { gv[m] = *(const u32x4*)((const unsigned char*)gt + (size_t)(row0 + ai * HALF + m * 16) * GATE_PITCH + u.pn * 256 + (wc * 4 + fq) * 16);
#pragma unroll
                for (int bj = 0; bj < 2; ++bj) { const size_t off = (size_t)(row0 + ai * HALF + m * 16) * LDT + col0 + bj * HALF;
                    pv[m][bj] = addp ? *(const u32x4*)(T + off) : (u32x4){0u, 0u, 0u, 0u}; } }
#pragma unroll
            for (int m = 0; m < 4; ++m)
#pragma unroll
                for (int bj = 0; bj < 2; ++bj) { const size_t off = (size_t)(row0 + ai * HALF + m * 16) * LDT + col0 + bj * HALF; const unsigned g0 = bj ? gv[m].z : gv[m].x, g1 = bj ? gv[m].w : gv[m].y;
                    const f32x4 a0 = acc[ai][bj][m][0] * (1.0f / 255.0f), a1 = acc[ai][bj][m][1] * (1.0f / 255.0f);
                    float o[8] = {a0[0] * (float)(g0 & 255u), a0[1] * (float)((g0 >> 8) & 255u), a0[2] * (float)((g0 >> 16) & 255u), a0[3] * (float)(g0 >> 24), a1[0] * (float)(g1 & 255u), a1[1] * (float)((g1 >> 8) & 255u), a1[2] * (float)((g1 >> 16) & 255u), a1[3] * (float)(g1 >> 24)};
                    { const u32x4 pw = pv[m][bj];
                        o[0] += bf_lo(pw.x); o[1] += bf_hi(pw.x); o[2] += bf_lo(pw.y); o[3] += bf_hi(pw.y); o[4] += bf_lo(pw.z); o[5] += bf_hi(pw.z); o[6] += bf_lo(pw.w); o[7] += bf_hi(pw.w); }
                    u32x4 w; w.x = cvt_pk_bf16(o[0], o[1]); w.y = cvt_pk_bf16(o[2], o[3]); w.z = cvt_pk_bf16(o[4], o[5]); w.w = cvt_pk_bf16(o[6], o[7]);
                    *(u32x4*)(T + off) = w; }
            asm volatile("" ::: "memory"); }
    }
};
template <class Epi, class Sched, bool ALIGN_EPI = false, bool SP2 = false>
__device__ __forceinline__ void gemm_phase(PG8_LAS unsigned char* lds, const Gemm g, const Sched& S, const Epi& E) {
    int tid_l = threadIdx.x; asm volatile("" : "+v"(tid_l));
    const int tid = tid_l, wid = __builtin_amdgcn_readfirstlane(tid >> 6), lane = tid & 63, wr = wid >> 2, wc = wid & 3, fr = lane & 15, fq = lane >> 4;
    const int K = g.K, nt = K / BK;
    unsigned voffA, voffB;
    { int R, C; stage_rc(tid * 16, R, C); const int Rb = Epi::PERM ? ((R & ~31) + perm32(R & 31)) : R;
        voffA = (unsigned)(R * g.lda + C) * 2u; voffB = (unsigned)(Rb * g.ldb + C) * 2u; }
    const size_t voffA_step = (size_t)64 * g.lda * 2, voffB_step = (size_t)64 * g.ldb * 2;
    const size_t kstep = (size_t)(BK * 2);
    const size_t hstepA = (size_t)HALF * g.lda * 2, hstepB = (size_t)HALF * g.ldb * 2;
    const size_t tstepA = 2 * hstepA, tstepB = 2 * hstepB;
    const unsigned ldsw = (unsigned)wid * 1024u;
    const int aoff = lds_byte(wr * 64 + fr, fq * 8), boff = lds_byte(wc * 32 + fr, fq * 8);
#define PG8_SA(b, h) (((b) * 2 + (h)) * HTB)
#define PG8_SB(b, h) ((4 + (b) * 2 + (h)) * HTB)
#define PG8_STAGE(bufoff, gbase, voff) do { _Pragma("unroll") for (int _i = 0; _i < 2; ++_i) \
        __builtin_amdgcn_global_load_lds((const unsigned*)((const char*)(gbase) + _i * voff##_step + (voff)), (PG8_LAS unsigned*)(lds + (bufoff) + ldsw + _i * 8192), 16, 0, 0); } while (0)
#define PG8_LDA(dst, b, h) do { _Pragma("unroll") for (int m = 0; m < 4; ++m) _Pragma("unroll") for (int k = 0; k < 2; ++k) dst[m][k] = *(const PG8_LAS bf16x8*)(lds + PG8_SA(b, h) + aoff + m * 2048 + k * 1024); } while (0)
#define PG8_LDB(dst, b, h) do { _Pragma("unroll") for (int n = 0; n < 2; ++n) _Pragma("unroll") for (int k = 0; k < 2; ++k) dst[n][k] = *(const PG8_LAS bf16x8*)(lds + PG8_SB(b, h) + boff + n * 2048 + k * 1024); } while (0)
#define PG8_MMA(ai, bj, At, Bt) do { __builtin_amdgcn_s_setprio(1); _Pragma("unroll") for (int m = 0; m < 4; ++m) _Pragma("unroll") for (int n = 0; n < 2; ++n) _Pragma("unroll") for (int k = 0; k < 2; ++k) \
        acc[ai][bj][m][n] = __builtin_amdgcn_mfma_f32_16x16x32_bf16(Bt[n][k], At[m][k], acc[ai][bj][m][n], 0, 0, 0); __builtin_amdgcn_s_setprio(0); } while (0)
#define PG8_MMAZ(ai, bj, At, Bt) do { __builtin_amdgcn_s_setprio(1); _Pragma("unroll") for (int m = 0; m < 4; ++m) _Pragma("unroll") for (int n = 0; n < 2; ++n) { \
        acc[ai][bj][m][n] = __builtin_amdgcn_mfma_f32_16x16x32_bf16(Bt[n][0], At[m][0], (f32x4){0.f, 0.f, 0.f, 0.f}, 0, 0, 0); \
        acc[ai][bj][m][n] = __builtin_amdgcn_mfma_f32_16x16x32_bf16(Bt[n][1], At[m][1], acc[ai][bj][m][n], 0, 0, 0); } __builtin_amdgcn_s_setprio(0); } while (0)
#define PG8_WAIT_V(n) asm volatile("s_waitcnt vmcnt(" #n ")" ::: "memory")
#define PG8_WAIT_L(n) asm volatile("s_waitcnt lgkmcnt(" #n ")" ::: "memory")
#define PG8_BAR __builtin_amdgcn_s_barrier()
#define PG8_SCHED __builtin_amdgcn_sched_barrier(0)
    Unit cur, nxt; int ui = 0;
    if (!S.next(0, cur)) return;
    f32x4 acc[2][2][4][2];
    if constexpr (!SP2) {
#pragma unroll
    for (int a = 0; a < 2; ++a)
#pragma unroll
        for (int b = 0; b < 2; ++b)
#pragma unroll
            for (int m = 0; m < 4; ++m)
#pragma unroll
                for (int n = 0; n < 2; ++n) acc[a][b][m][n] = (f32x4){0.f, 0.f, 0.f, 0.f};
    }
    bf16x8 At[4][2], B0[2][2], B1[2][2];
    const char* cA = (const char*)S.opA(g, cur) + (size_t)cur.pm * tstepA; const char* cB = (const char*)S.opB(g, cur) + (size_t)cur.pn * tstepB;
    S.a_ready(cur);
    if constexpr (SP2) {
        PG8_STAGE(PG8_SB(0, 0), cB, voffB); PG8_STAGE(PG8_SB(0, 1), cB + hstepB, voffB); PG8_STAGE(PG8_SA(0, 0), cA, voffA); PG8_STAGE(PG8_SA(0, 1), cA + hstepA, voffA);
        if (wr == 1) PG8_BAR;
        PG8_WAIT_V(2); PG8_BAR;
        PG8_STAGE(PG8_SB(1, 0), cB + kstep, voffB); PG8_STAGE(PG8_SA(1, 0), cA + kstep, voffA); PG8_STAGE(PG8_SB(1, 1), cB + hstepB + kstep, voffB);
        if (Epi::NST > 0) PG8_WAIT_V(0); else PG8_WAIT_V(6);
        PG8_BAR;
    } else {
        PG8_STAGE(PG8_SB(0, 0), cB, voffB); PG8_STAGE(PG8_SA(0, 0), cA, voffA); PG8_STAGE(PG8_SB(0, 1), cB + hstepB, voffB); PG8_STAGE(PG8_SA(0, 1), cA + hstepA, voffA);
        if (wr == 1) PG8_BAR;
        PG8_WAIT_V(4); PG8_BAR;
        PG8_STAGE(PG8_SB(1, 0), cB + kstep, voffB); PG8_STAGE(PG8_SA(1, 0), cA + kstep, voffA); PG8_STAGE(PG8_SB(1, 1), cB + hstepB + kstep, voffB);
        PG8_WAIT_V(6); PG8_BAR;
    }
    for (;;) {
        const bool has_next = S.next(ui + 1, nxt);
        const char* nA = has_next ? (const char*)S.opA(g, nxt) + (size_t)nxt.pm * tstepA : cA; const char* nB = has_next ? (const char*)S.opB(g, nxt) + (size_t)nxt.pn * tstepB : cB;
#define PG8_TRIP_HEAD(T) const int t = (T); const bool last = (t == nt - 2); \
            const char* a1 = cA + (size_t)(t + 1) * kstep; \
            const char* a2 = last ? nA : cA + (size_t)(t + 2) * kstep; const char* b2 = last ? nB : cB + (size_t)(t + 2) * kstep; \
            const char* a3 = a2 + kstep; const char* b3 = b2 + kstep; \
            if (last && has_next) S.a_ready(nxt);
#define PG8_TRIP_SP2(W12, MM0) \
            PG8_LDB(B0, 0, 0); PG8_LDB(B1, 0, 1); PG8_SCHED; PG8_LDA(At, 0, 0); PG8_STAGE(PG8_SA(1, 1), a1 + hstepA, voffA); \
            W12; PG8_WAIT_L(0); PG8_BAR; MM0(0, 0, At, B0); MM0(0, 1, At, B1); PG8_BAR; PG8_SCHED; \
            PG8_LDA(At, 0, 1); PG8_STAGE(PG8_SB(0, 0), b2, voffB); PG8_STAGE(PG8_SB(0, 1), b2 + hstepB, voffB); PG8_STAGE(PG8_SA(0, 0), a2, voffA); \
            W12; PG8_WAIT_L(0); PG8_BAR; MM0(1, 0, At, B0); MM0(1, 1, At, B1); PG8_BAR; PG8_SCHED; \
            PG8_LDB(B0, 1, 0); PG8_LDB(B1, 1, 1); PG8_SCHED; PG8_LDA(At, 1, 0); PG8_STAGE(PG8_SA(0, 1), a2 + hstepA, voffA); \
            PG8_WAIT_V(8); PG8_WAIT_L(0); PG8_BAR; PG8_MMA(0, 0, At, B0); PG8_MMA(0, 1, At, B1); PG8_BAR; PG8_SCHED; \
            PG8_LDA(At, 1, 1); PG8_STAGE(PG8_SB(1, 0), b3, voffB); PG8_STAGE(PG8_SB(1, 1), b3 + hstepB, voffB); PG8_STAGE(PG8_SA(1, 0), a3, voffA); \
            PG8_WAIT_V(8); PG8_WAIT_L(0); PG8_BAR; PG8_MMA(1, 0, At, B0); PG8_MMA(1, 1, At, B1); PG8_BAR; PG8_SCHED;
        if constexpr (SP2) {
            { PG8_TRIP_HEAD(0) PG8_TRIP_SP2(asm volatile("s_waitcnt vmcnt(%0)" :: "n"(8 + Epi::NST) : "memory"), PG8_MMAZ) }
            for (int tt = 2; tt < nt; tt += 2) { PG8_TRIP_HEAD(tt) PG8_TRIP_SP2(PG8_WAIT_V(8), PG8_MMA) }
        } else {
        for (int tt = 0; tt < nt; tt += 2) { PG8_TRIP_HEAD(tt)
            PG8_LDB(B0, 0, 0); PG8_SCHED; PG8_LDA(At, 0, 0); PG8_STAGE(PG8_SA(1, 1), a1 + hstepA, voffA);
            PG8_WAIT_L(8); PG8_BAR; PG8_WAIT_L(0); PG8_MMA(0, 0, At, B0); PG8_BAR; PG8_SCHED;
            PG8_LDB(B1, 0, 1); PG8_STAGE(PG8_SB(0, 0), b2, voffB);
            PG8_BAR; PG8_WAIT_L(0); PG8_MMA(0, 1, At, B1); PG8_BAR;
            PG8_LDA(At, 0, 1); PG8_STAGE(PG8_SA(0, 0), a2, voffA);
            PG8_BAR; PG8_WAIT_L(0); PG8_MMA(1, 0, At, B0); PG8_BAR; PG8_SCHED;
            PG8_STAGE(PG8_SB(0, 1), b2 + hstepB, voffB);
            PG8_WAIT_V(6); PG8_BAR; PG8_MMA(1, 1, At, B1); PG8_BAR;
            PG8_LDB(B0, 1, 0); PG8_SCHED; PG8_LDA(At, 1, 0); PG8_STAGE(PG8_SA(0, 1), a2 + hstepA, voffA);
            PG8_WAIT_L(8); PG8_BAR; PG8_WAIT_L(0); PG8_MMA(0, 0, At, B0); PG8_BAR; PG8_SCHED;
            PG8_LDB(B1, 1, 1); PG8_STAGE(PG8_SB(1, 0), b3, voffB);
            PG8_BAR; PG8_WAIT_L(0); PG8_MMA(0, 1, At, B1); PG8_BAR;
            PG8_LDA(At, 1, 1); PG8_STAGE(PG8_SA(1, 0), a3, voffA);
            PG8_BAR; PG8_WAIT_L(0); PG8_MMA(1, 0, At, B0); PG8_BAR; PG8_SCHED;
            PG8_STAGE(PG8_SB(1, 1), b3 + hstepB, voffB);
            PG8_WAIT_V(6); PG8_BAR; PG8_MMA(1, 1, At, B1); PG8_BAR;
        }
        }
#undef PG8_TRIP_HEAD
#undef PG8_TRIP_SP2
        if constexpr (ALIGN_EPI) { if (wr == 0) PG8_BAR; }
        if constexpr (!Epi::AFTER_DRAIN) { E(acc, cur, wr, wc, fr, fq); S.done(cur); }
        if (!has_next) break;
        if constexpr (!SP2) {
#pragma unroll
        for (int a = 0; a < 2; ++a)
#pragma unroll
            for (int b = 0; b < 2; ++b)
#pragma unroll
                for (int m = 0; m < 4; ++m)
#pragma unroll
                    for (int n = 0; n < 2; ++n) acc[a][b][m][n] = (f32x4){0.f, 0.f, 0.f, 0.f};
        }
        cur = nxt; cA = nA; cB = nB; ++ui;
        if constexpr (ALIGN_EPI) { if (wr == 1) PG8_BAR; }
    }
    PG8_WAIT_V(0);
    if constexpr (!ALIGN_EPI) { if (wr == 0) PG8_BAR; }
    PG8_BAR;
    if constexpr (Epi::AFTER_DRAIN) { E.fused(acc, cur, wr, wc, fr, fq, lds, wid, lane); S.done(cur); }
#undef PG8_SA
#undef PG8_SB
#undef PG8_STAGE
#undef PG8_LDA
#undef PG8_LDB
#undef PG8_MMA
#undef PG8_MMAZ
#undef PG8_WAIT_V
#undef PG8_WAIT_L
#undef PG8_BAR
#undef PG8_SCHED
}
}
#define GAS __attribute__((address_space(1)))
#define LAS __attribute__((address_space(3)))
typedef unsigned short bf16;
typedef unsigned v4u __attribute__((ext_vector_type(4)));
typedef float f32x4 __attribute__((ext_vector_type(4)));
typedef short bf16x8 __attribute__((ext_vector_type(8)));
typedef GAS unsigned gu32;
typedef GAS unsigned long long gu64;
#define RLX_AGENT __ATOMIC_RELAXED, __HIP_MEMORY_SCOPE_AGENT
#define LDS_WAIT() asm volatile("s_waitcnt lgkmcnt(0)" ::: "memory")
#define VM_WAIT() asm volatile("s_waitcnt vmcnt(0)" ::: "memory")
__device__ __forceinline__ unsigned long long rt() { return __builtin_amdgcn_s_memrealtime(); }
__device__ __forceinline__ unsigned f2bf(float f) { unsigned u = __builtin_bit_cast(unsigned, f); return (u + 0x7fffu + ((u >> 16) & 1u)) >> 16; }
__device__ __forceinline__ unsigned pk2(float lo, float hi) { return f2bf(lo) | (f2bf(hi) << 16); }
#define XB_TMO      128
#define XB_XCNT(j)  (256  + 64 * (j))
#define XB_XSUB(j)  (1280 + 64 * (j))
#define XB_XGEN(j)  (2304 + 64 * (j))
#define XB_TOP      3328
#define XB_TOPGEN   3392
#define XCD_BAR_WORDS 3456
#define XB_SPIN_CAP (1u << 18)

__device__ __forceinline__ unsigned xb_ld(unsigned* p)              { return __hip_atomic_load(p, __ATOMIC_RELAXED, __HIP_MEMORY_SCOPE_AGENT); }
__device__ __forceinline__ unsigned xb_add(unsigned* p, unsigned v) { return __hip_atomic_fetch_add(p, v, __ATOMIC_RELAXED, __HIP_MEMORY_SCOPE_AGENT); }
__device__ __forceinline__ unsigned xb_xcc_id() { return (unsigned)__builtin_amdgcn_s_getreg((3 << 11) | 20) & 0xFu; }
#define XB_SPIN(cond, bar) do { unsigned _sp = 0; while (cond) { __builtin_amdgcn_s_sleep(1); \
    if ((++_sp & 255u) == 0u) { if (xb_ld(&(bar)[XB_TMO])) break; if (_sp > XB_SPIN_CAP) { atomicAdd(&(bar)[XB_TMO], 1u); break; } } } } while (0)

struct XcdBarrier {
    unsigned* bar; unsigned x;
    volatile LAS unsigned* st;
};

__device__ __forceinline__ XcdBarrier xcd_barrier_post(unsigned* bar, volatile LAS unsigned* st) {
    XcdBarrier b; b.bar = bar; b.x = xb_xcc_id(); b.st = st;
    if (threadIdx.x == 0) (void)xb_add(&bar[XB_XCNT(b.x)], 1u);
    return b;
}
__device__ __forceinline__ void xcd_barrier_complete(unsigned* bar, unsigned x, unsigned& nloc, unsigned& nx) {
    const unsigned G = gridDim.x * gridDim.y * gridDim.z;
    unsigned sum, cnt, mine, sp = 0u;
    for (;;) {
        sum = 0u; cnt = 0u; mine = 0u;
#pragma unroll
        for (unsigned j = 0; j < 16; ++j) { const unsigned c = xb_ld(&bar[XB_XCNT(j)]); sum += c; cnt += (c > 0u) ? 1u : 0u; mine = (j == x) ? c : mine; }
        if (sum == G) break;
        __builtin_amdgcn_s_sleep(1);
        if ((++sp & 255u) == 0u) { if (xb_ld(&bar[XB_TMO])) break; if (sp > XB_SPIN_CAP) { atomicAdd(&bar[XB_TMO], 1u); break; } }
    }
    nloc = mine > 0u ? mine : 1u; nx = cnt > 0u ? cnt : 1u;
}

__device__ __forceinline__ void xcd_barrier(const XcdBarrier& b) {
    asm volatile("s_waitcnt vmcnt(0)" ::: "memory");
    __syncthreads();
    if (threadIdx.x == 0) {
        unsigned* bar = b.bar; const unsigned bx_ = xb_xcc_id();
        __builtin_amdgcn_s_waitcnt(0);
        unsigned nloc = b.st[0], nx = b.st[1];
        if (nloc == 0u) { xcd_barrier_complete(bar, bx_, nloc, nx); b.st[0] = nloc; b.st[1] = nx; }
        const unsigned old = xb_add(&bar[XB_XSUB(bx_)], 1u);
        const unsigned gen = old / nloc;
        if (old + 1u == (gen + 1u) * nloc) {
            __builtin_amdgcn_fence(__ATOMIC_RELEASE, "agent");
            asm volatile("s_waitcnt vmcnt(0)" ::: "memory");
            const unsigned og = xb_add(&bar[XB_TOP], 1u);
            const unsigned tg = og / nx;
            if (og + 1u == (tg + 1u) * nx) xb_add(&bar[XB_TOPGEN], 1u);
            else XB_SPIN(xb_ld(&bar[XB_TOPGEN]) == tg, bar);
            __builtin_amdgcn_fence(__ATOMIC_ACQUIRE, "agent");
            xb_add(&bar[XB_XGEN(bx_)], 1u);
            asm volatile("s_waitcnt vmcnt(0)" ::: "memory");
        } else {
            XB_SPIN(xb_ld(&bar[XB_XGEN(bx_)]) == gen, bar);
            __builtin_amdgcn_fence(__ATOMIC_ACQUIRE, "agent");
            asm volatile("s_waitcnt vmcnt(0)" ::: "memory");
        }
    }
    __syncthreads();
}

constexpr int NWAVES = 8;
constexpr int BATCH = 4, SEQ = 8192, D = 2048, DEPTH = 4, HEADS = 8, FF = 5632, INCOLS = 16384, NCHUNK = SEQ / 128;
constexpr int M = BATCH * SEQ;
constexpr float EPS = 1e-6f;
constexpr size_t MiB = 1u << 20;
constexpr size_t WS_CTL = 0, CTL_ZERO_BYTES = 1 * MiB;
constexpr size_t WS_CS = 1 * MiB;
constexpr size_t WS_WMASK = 33 * MiB;
constexpr size_t WS_WGU1 = 34 * MiB, WS_WD1 = 78 * MiB, WS_WIN = 100 * MiB, WS_WBR = 164 * MiB, WS_WBS = 172 * MiB, WS_WOUT = 180 * MiB, WS_WGU2 = 188 * MiB, WS_WD2 = 232 * MiB;
constexpr size_t WS_H = 256 * MiB;
constexpr size_t WS_BIG = 392 * MiB;
constexpr size_t WS_RT = 1452 * MiB;
constexpr size_t WS_SGST = WS_RT + 96 * MiB;
constexpr size_t WS_OPRE = WS_RT + 112 * MiB;
constexpr size_t WS_END = 1708 * MiB;
constexpr int LDT = pg8::LDT;
constexpr size_t TSTRIDE = (size_t)M * LDT;
constexpr int CW_BAR = 4096;
constexpr size_t WS_SSQ = WS_RT + 32 * MiB, SSQ_STRIDE = (size_t)M * 32;
constexpr int RING_BYTES = 131072;
constexpr int LDSCTL_OFF = RING_BYTES, MISC_OFF = LDSCTL_OFF + 320;
constexpr int RS_OFF = RING_BYTES + 1024;
constexpr int LDS_BYTES = 147456;

typedef short s16x4 __attribute__((ext_vector_type(4)));
typedef short v4i16_t __attribute__((ext_vector_type(4)));
typedef unsigned u32x2 __attribute__((ext_vector_type(2)));
typedef float f32x2v __attribute__((ext_vector_type(2)));

__device__ __forceinline__ float wave_sum(float v) {
#pragma unroll
    for (int o = 1; o < 64; o <<= 1) v += __shfl_xor(v, o);
    return v;
}
typedef float f32x2_t __attribute__((ext_vector_type(2))); typedef __bf16 bf16x2_t __attribute__((ext_vector_type(2)));
__device__ __forceinline__ unsigned cvtpk(float lo, float hi) { f32x2_t v = {lo, hi}; bf16x2_t b = __builtin_convertvector(v, bf16x2_t); return __builtin_bit_cast(unsigned, b); }
__device__ __forceinline__ float bflo(unsigned u) { return __uint_as_float(u << 16); }
__device__ __forceinline__ float bfhi(unsigned u) { return __uint_as_float(u & 0xffff0000u); }
__device__ __forceinline__ s16x4 vtr(const LAS unsigned char* p) { return __builtin_bit_cast(s16x4, __builtin_amdgcn_ds_read_tr16_b64_v4i16((LAS v4i16_t*)p)); }
__device__ __forceinline__ bf16x8 lds_tr_frag(const LAS unsigned char* tile, int strideB, int k0, int c0, int lane) {
    const int g = lane >> 4, q = (lane & 15) >> 2, p = lane & 3;
    const LAS unsigned char* a = tile + (k0 + 8 * g + q) * strideB + (c0 + 4 * p) * 2;
    const s16x4 lo = vtr(a), hi = vtr(a + 4 * strideB);
    return __builtin_shufflevector(lo, hi, 0, 1, 2, 3, 4, 5, 6, 7);
}
__device__ __forceinline__ bf16x8 lds_tr_frag_c(const LAS unsigned char* tile, int strideB, int k0, int c0, int lane) {
    const int g = lane >> 4, q = (lane & 15) >> 2, p = lane & 3;
    const LAS unsigned char* a = tile + (k0 + 4 * g + q) * strideB + (c0 + 4 * p) * 2;
    const s16x4 lo = vtr(a), hi = vtr(a + 16 * strideB);
    return __builtin_shufflevector(lo, hi, 0, 1, 2, 3, 4, 5, 6, 7);
}
#define MFMA16(a, b, c) __builtin_amdgcn_mfma_f32_16x16x32_bf16((a), (b), (c), 0, 0, 0)
__device__ __forceinline__ float log2_gamma(int h) {
    const float x = __builtin_amdgcn_exp2f(-5.0f - (float)h);
    const float l = -x * (1.0f + x * (0.5f + x * (0.33333334f + x * (0.25f + x * (0.2f + x * 0.16666667f)))));
    return l * 1.44269504f;
}

__device__ __forceinline__ void conv_item(const float* W, int K, int N, bf16* WT, int mode, const float* gain, LAS float* scr, int item, int lane) {
    const int nblk = N / 32, kb = item / nblk, nb = item % nblk, k0 = 64 * kb, n0 = 32 * nb;
#pragma unroll
    for (int i = 0; i < 8; ++i) { const int kk = 8 * i + (lane >> 3), nn = 4 * (lane & 7);
        const f32x4 v = *(const f32x4*)(W + (size_t)(k0 + kk) * N + n0 + nn);
        LAS float* d = scr + kk * 33 + nn; d[0] = v[0]; d[1] = v[1]; d[2] = v[2]; d[3] = v[3]; }
    LDS_WAIT(); asm volatile("" ::: "memory");
    int r0 = n0;
    if (mode == 3) r0 = ((((n0 >> 11) + 5) & 7) << 11) + (n0 & 2047);
    if (mode == 1) { const int isg = n0 >= FF, j0 = isg ? n0 - FF : n0; r0 = 256 * (j0 >> 7) + (j0 & 127) + (isg ? 128 : 0); }
    const int c = lane & 7;
    f32x4 ga = {1.f, 1.f, 1.f, 1.f}, gb = {1.f, 1.f, 1.f, 1.f};
    if (gain) { ga = *(const f32x4*)(gain + k0 + 8 * c); gb = *(const f32x4*)(gain + k0 + 8 * c + 4); }
#pragma unroll
    for (int j = 0; j < 4; ++j) { const int n = (lane >> 3) + 8 * j; const LAS float* s = scr + (8 * c) * 33 + n;
        v4u o; o.x = pk2(s[0 * 33] * ga[0], s[1 * 33] * ga[1]); o.y = pk2(s[2 * 33] * ga[2], s[3 * 33] * ga[3]); o.z = pk2(s[4 * 33] * gb[0], s[5 * 33] * gb[1]); o.w = pk2(s[6 * 33] * gb[2], s[7 * 33] * gb[3]);
        *(GAS v4u*)(WT + (size_t)(r0 + n) * K + k0 + 8 * c) = o; }
    LDS_WAIT(); asm volatile("" ::: "memory");
}
struct ConvSrc { const float *gu1, *d1, *win, *br, *bs, *wo, *gu2, *d2, *sw, *g1, *gm, *g2; };
__device__ __forceinline__ void phase_conv(LAS unsigned char* lds, unsigned char* ws, const ConvSrc& s, int gw, int NGW, int wave, int lane) {
    asm volatile("" : "+v"(lane));
    LAS float* scr = (LAS float*)(lds + wave * 16384);
    constexpr int I_GU = (D / 64) * (2 * FF / 32), I_D = (FF / 64) * (D / 32), I_IN = (D / 64) * (INCOLS / 32), I_SQ = (D / 64) * (D / 32);
    constexpr int NITEMS = 2 * I_GU + 2 * I_D + I_IN + 3 * I_SQ;
    for (int it = gw; it < NITEMS; it += NGW) {
        int r = it;
        if (r < I_GU) { conv_item(s.gu1, D, 2 * FF, (bf16*)(ws + WS_WGU1), 1, s.g1, scr, r, lane); continue; } r -= I_GU;
        if (r < I_GU) { conv_item(s.gu2, D, 2 * FF, (bf16*)(ws + WS_WGU2), 1, s.g2, scr, r, lane); continue; } r -= I_GU;
        if (r < I_D) { conv_item(s.d1, FF, D, (bf16*)(ws + WS_WD1), 0, nullptr, scr, r, lane); continue; } r -= I_D;
        if (r < I_D) { conv_item(s.d2, FF, D, (bf16*)(ws + WS_WD2), 0, nullptr, scr, r, lane); continue; } r -= I_D;
        if (r < I_IN) { conv_item(s.win, D, INCOLS, (bf16*)(ws + WS_WIN), 3, s.gm, scr, r, lane); continue; } r -= I_IN;
        if (r < I_SQ) { conv_item(s.br, D, D, (bf16*)(ws + WS_WBR), 0, nullptr, scr, r, lane); continue; } r -= I_SQ;
        if (r < I_SQ) { conv_item(s.bs, D, D, (bf16*)(ws + WS_WBS), 0, nullptr, scr, r, lane); continue; } r -= I_SQ;
        conv_item(s.wo, D, D, (bf16*)(ws + WS_WOUT), 0, nullptr, scr, r, lane);
    }
    bf16* wm = (bf16*)(ws + WS_WMASK);
    for (int e = gw * 64 + lane; e < 8 * 128 * 128; e += NGW * 64) { const int j = e & 127, i = (e >> 7) & 127; wm[e] = (bf16)((j <= i) ? f2bf(s.sw[e]) : 0u); }
}
__device__ __forceinline__ void phase_final(const bf16* Xb, float* out, const float* gain, int gw, int NGW, int lane) {
    asm volatile("" : "+v"(lane));
    f32x4 g0[4], g1[4];
#pragma unroll
    for (int j = 0; j < 4; ++j) { g0[j] = *(const f32x4*)(gain + (lane + 64 * j) * 8); g1[j] = *(const f32x4*)(gain + (lane + 64 * j) * 8 + 4); }
    for (int m = gw; m < M; m += NGW) {
        const v4u* xr = (const v4u*)(Xb + (size_t)m * LDT) + lane;
        float x[4][8]; float s = 0.f;
#pragma unroll
        for (int j = 0; j < 4; ++j) { const v4u w = xr[64 * j];
            x[j][0] = bflo(w.x); x[j][1] = bfhi(w.x); x[j][2] = bflo(w.y); x[j][3] = bfhi(w.y); x[j][4] = bflo(w.z); x[j][5] = bfhi(w.z); x[j][6] = bflo(w.w); x[j][7] = bfhi(w.w);
#pragma unroll
            for (int e = 0; e < 8; ++e) s += x[j][e] * x[j][e]; }
        const float rs = 1.0f / sqrtf(wave_sum(s) * (1.0f / D) + EPS);
        float* orow = out + (size_t)m * D;
#pragma unroll
        for (int j = 0; j < 4; ++j) { f32x4 o0, o1;
            o0[0] = x[j][0] * rs * g0[j][0]; o0[1] = x[j][1] * rs * g0[j][1]; o0[2] = x[j][2] * rs * g0[j][2]; o0[3] = x[j][3] * rs * g0[j][3];
            o1[0] = x[j][4] * rs * g1[j][0]; o1[1] = x[j][5] * rs * g1[j][1]; o1[2] = x[j][6] * rs * g1[j][2]; o1[3] = x[j][7] * rs * g1[j][3];
            *(f32x4*)(orow + (lane + 64 * j) * 8) = o0; *(f32x4*)(orow + (lane + 64 * j) * 8 + 4) = o1; }
    }
}
#define LDS_BARRIER() do { asm volatile("s_waitcnt lgkmcnt(0)" ::: "memory"); __builtin_amdgcn_s_barrier(); asm volatile("" ::: "memory"); } while (0)
__device__ __forceinline__ bf16x8 lds_tr_pair(const LAS unsigned char* tile, int strideB, int r0, int r1, int c0, int lane) {
    const int q = (lane & 15) >> 2, p = lane & 3;
    const s16x4 lo = vtr(tile + (r0 + q) * strideB + (c0 + 4 * p) * 2), hi = vtr(tile + (r1 + q) * strideB + (c0 + 4 * p) * 2);
    return __builtin_shufflevector(lo, hi, 0, 1, 2, 3, 4, 5, 6, 7);
}
__device__ __forceinline__ void phase_ret(LAS unsigned char* lds, const bf16* Q, const bf16* Kb, const bf16* V, bf16* Opre, float* stats, int vcu, int G, int tid) {
    asm volatile("" : "+v"(tid));
    const int lane = tid & 63, w = __builtin_amdgcn_readfirstlane(tid >> 6), i16 = lane & 15, g4 = lane >> 4;
    const int ib = (w < 4) ? w : 11 - w;
    LAS unsigned char* K_t = lds;
    LAS unsigned char* V_t = lds + 69632;
    LAS unsigned char* RT_t = lds + 94208;
    for (int u = vcu; u < BATCH * HEADS * 8; u += G) {
        const int es = u & 7, h = (u >> 3) & 7, b = u >> 6, hc = h * 256;
        const float lg2 = log2_gamma(h), gamma_c = __builtin_amdgcn_exp2f(128.0f * lg2);
        const size_t tb = (size_t)b * SEQ;
        f32x4 r[2][2];
#pragma unroll
        for (int a = 0; a < 2; ++a)
#pragma unroll
            for (int c = 0; c < 2; ++c) r[a][c] = (f32x4){0.f, 0.f, 0.f, 0.f};
        { v4u zz = (v4u){0u, 0u, 0u, 0u}; asm volatile("" : "+v"(zz));
          int tz = tid; asm volatile("" : "+v"(tz));
          for (int c = tz; c < 17408 / 16; c += NWAVES * 64) *(LAS v4u*)(RT_t + c * 16) = zz; }
        v4u kpre[8], vpre;
        const bf16* kg = Kb + (tb + (tid >> 5)) * LDT + hc + (tid & 31) * 8;
        const bf16* vg = V + (tb + (tid >> 2)) * LDT + hc + 32 * es + (tid & 3) * 8;
        const bf16* qg = Q + (tb + 16 * ib + i16) * LDT + hc + 8 * g4;
#pragma unroll
        for (int k = 0; k < 8; ++k) kpre[k] = *(const v4u*)(kg + (size_t)k * 16 * LDT);
        vpre = *(const v4u*)vg;
        const int i = 16 * ib + i16;
        bf16x8 qf[8];
#pragma unroll
        for (int ks = 0; ks < 8; ++ks) qf[ks] = *(const bf16x8*)(qg + 32 * ks);
        for (int n = 0; n < NCHUNK; ++n) {
            LDS_BARRIER();
#pragma unroll
            for (int k = 0; k < 8; ++k) *(LAS v4u*)(K_t + ((tid >> 5) + 16 * k) * 544 + (tid & 31) * 16) = kpre[k];
            *(LAS v4u*)(V_t + (tid >> 2) * 96 + (tid & 3) * 16) = vpre;
            {
                const size_t adv = (size_t)((n + 1 < NCHUNK) ? n + 1 : n) * 128 * LDT;
#pragma unroll
                for (int k = 0; k < 8; ++k) kpre[k] = *(const v4u*)(kg + adv + (size_t)k * 16 * LDT);
                vpre = *(const v4u*)(vg + adv);
            }
            LDS_BARRIER();
            const LAS unsigned char* RT_c = RT_t + (n & 1) * 17408; LAS unsigned char* RT_n = RT_t + ((n & 1) ^ 1) * 17408;
#define RET_ST_BLOCK1(S0, AD) do { bf16x8 k0_, k1_, k2_, k3_, k4_, k5_, k6_, k7_; asm volatile( \
                "ds_read_b128 %[k0], %[ad] offset:0\n\t" \
                "ds_read_b128 %[k1], %[ad] offset:64\n\t" \
                "ds_read_b128 %[k2], %[ad] offset:128\n\t" \
                "ds_read_b128 %[k3], %[ad] offset:192\n\t" \
                "ds_read_b128 %[k4], %[ad] offset:256\n\t" \
                "ds_read_b128 %[k5], %[ad] offset:320\n\t" \
                "ds_read_b128 %[k6], %[ad] offset:384\n\t" \
                "ds_read_b128 %[k7], %[ad] offset:448\n\t" \
                "s_waitcnt lgkmcnt(7)\n\t" \
                "v_mfma_f32_16x16x32_bf16 %[s0], %[k0], %[q0], 0\n\t" \
                "s_waitcnt lgkmcnt(6)\n\t" \
                "v_mfma_f32_16x16x32_bf16 %[s0], %[k1], %[q1], %[s0]\n\t" \
                "s_waitcnt lgkmcnt(5)\n\t" \
                "v_mfma_f32_16x16x32_bf16 %[s0], %[k2], %[q2], %[s0]\n\t" \
                "s_waitcnt lgkmcnt(4)\n\t" \
                "v_mfma_f32_16x16x32_bf16 %[s0], %[k3], %[q3], %[s0]\n\t" \
                "s_waitcnt lgkmcnt(3)\n\t" \
                "v_mfma_f32_16x16x32_bf16 %[s0], %[k4], %[q4], %[s0]\n\t" \
                "s_waitcnt lgkmcnt(2)\n\t" \
                "v_mfma_f32_16x16x32_bf16 %[s0], %[k5], %[q5], %[s0]\n\t" \
                "s_waitcnt lgkmcnt(1)\n\t" \
                "v_mfma_f32_16x16x32_bf16 %[s0], %[k6], %[q6], %[s0]\n\t" \
                "s_waitcnt lgkmcnt(0)\n\t" \
                "v_mfma_f32_16x16x32_bf16 %[s0], %[k7], %[q7], %[s0]\n\t" \
                "s_nop 7\n\t" \
                "s_nop 7\n\t" \
                "s_nop 7\n\t" \
                : [s0] "=&v"(S0), [k0] "=&v"(k0_), [k1] "=&v"(k1_), [k2] "=&v"(k2_), [k3] "=&v"(k3_), [k4] "=&v"(k4_), [k5] "=&v"(k5_), [k6] "=&v"(k6_), [k7] "=&v"(k7_) \
                : [ad] "v"(AD), [q0] "v"(qf[0]), [q1] "v"(qf[1]), [q2] "v"(qf[2]), [q3] "v"(qf[3]), [q4] "v"(qf[4]), [q5] "v"(qf[5]), [q6] "v"(qf[6]), [q7] "v"(qf[7]) : "memory"); } while (0)
#define RET_ST_BLOCK2(S0, S1, AD) do { bf16x8 k0_, k1_, k2_, k3_, k4_, k5_, k6_, k7_; asm volatile( \
                "ds_read_b128 %[k0], %[ad] offset:0\n\t" \
                "ds_read_b128 %[k1], %[ad] offset:8704\n\t" \
                "ds_read_b128 %[k2], %[ad] offset:64\n\t" \
                "ds_read_b128 %[k3], %[ad] offset:8768\n\t" \
                "ds_read_b128 %[k4], %[ad] offset:128\n\t" \
                "ds_read_b128 %[k5], %[ad] offset:8832\n\t" \
                "ds_read_b128 %[k6], %[ad] offset:192\n\t" \
                "ds_read_b128 %[k7], %[ad] offset:8896\n\t" \
                "s_waitcnt lgkmcnt(7)\n\t" \
                "v_mfma_f32_16x16x32_bf16 %[s0], %[k0], %[q0], 0\n\t" \
                "ds_read_b128 %[k0], %[ad] offset:256\n\t" \
                "s_waitcnt lgkmcnt(7)\n\t" \
                "v_mfma_f32_16x16x32_bf16 %[s1], %[k1], %[q0], 0\n\t" \
                "ds_read_b128 %[k1], %[ad] offset:8960\n\t" \
                "s_waitcnt lgkmcnt(7)\n\t" \
                "v_mfma_f32_16x16x32_bf16 %[s0], %[k2], %[q1], %[s0]\n\t" \
                "ds_read_b128 %[k2], %[ad] offset:320\n\t" \
                "s_waitcnt lgkmcnt(7)\n\t" \
                "v_mfma_f32_16x16x32_bf16 %[s1], %[k3], %[q1], %[s1]\n\t" \
                "ds_read_b128 %[k3], %[ad] offset:9024\n\t" \
                "s_waitcnt lgkmcnt(7)\n\t" \
                "v_mfma_f32_16x16x32_bf16 %[s0], %[k4], %[q2], %[s0]\n\t" \
                "ds_read_b128 %[k4], %[ad] offset:384\n\t" \
                "s_waitcnt lgkmcnt(7)\n\t" \
                "v_mfma_f32_16x16x32_bf16 %[s1], %[k5], %[q2], %[s1]\n\t" \
                "ds_read_b128 %[k5], %[ad] offset:9088\n\t" \
                "s_waitcnt lgkmcnt(7)\n\t" \
                "v_mfma_f32_16x16x32_bf16 %[s0], %[k6], %[q3], %[s0]\n\t" \
                "ds_read_b128 %[k6], %[ad] offset:448\n\t" \
                "s_waitcnt lgkmcnt(7)\n\t" \
                "v_mfma_f32_16x16x32_bf16 %[s1], %[k7], %[q3], %[s1]\n\t" \
                "ds_read_b128 %[k7], %[ad] offset:9152\n\t" \
                "s_waitcnt lgkmcnt(7)\n\t" \
                "v_mfma_f32_16x16x32_bf16 %[s0], %[k0], %[q4], %[s0]\n\t" \
                "s_waitcnt lgkmcnt(6)\n\t" \
                "v_mfma_f32_16x16x32_bf16 %[s1], %[k1], %[q4], %[s1]\n\t" \
                "s_waitcnt lgkmcnt(5)\n\t" \
                "v_mfma_f32_16x16x32_bf16 %[s0], %[k2], %[q5], %[s0]\n\t" \
                "s_waitcnt lgkmcnt(4)\n\t" \
                "v_mfma_f32_16x16x32_bf16 %[s1], %[k3], %[q5], %[s1]\n\t" \
                "s_waitcnt lgkmcnt(3)\n\t" \
                "v_mfma_f32_16x16x32_bf16 %[s0], %[k4], %[q6], %[s0]\n\t" \
                "s_waitcnt lgkmcnt(2)\n\t" \
                "v_mfma_f32_16x16x32_bf16 %[s1], %[k5], %[q6], %[s1]\n\t" \
                "s_waitcnt lgkmcnt(1)\n\t" \
                "v_mfma_f32_16x16x32_bf16 %[s0], %[k6], %[q7], %[s0]\n\t" \
                "s_waitcnt lgkmcnt(0)\n\t" \
                "v_mfma_f32_16x16x32_bf16 %[s1], %[k7], %[q7], %[s1]\n\t" \
                "s_nop 7\n\t" \
                "s_nop 7\n\t" \
                "s_nop 7\n\t" \
                : [s0] "=&v"(S0), [s1] "=&v"(S1), [k0] "=&v"(k0_), [k1] "=&v"(k1_), [k2] "=&v"(k2_), [k3] "=&v"(k3_), [k4] "=&v"(k4_), [k5] "=&v"(k5_), [k6] "=&v"(k6_), [k7] "=&v"(k7_) \
                : [ad] "v"(AD), [q0] "v"(qf[0]), [q1] "v"(qf[1]), [q2] "v"(qf[2]), [q3] "v"(qf[3]), [q4] "v"(qf[4]), [q5] "v"(qf[5]), [q6] "v"(qf[6]), [q7] "v"(qf[7]) : "memory"); } while (0)
#define RET_ST_BLOCK3(S0, S1, S2, AD) do { bf16x8 k0_, k1_, k2_, k3_, k4_, k5_, k6_, k7_; asm volatile( \
                "ds_read_b128 %[k0], %[ad] offset:0\n\t" \
                "ds_read_b128 %[k1], %[ad] offset:8704\n\t" \
                "ds_read_b128 %[k2], %[ad] offset:17408\n\t" \
                "ds_read_b128 %[k3], %[ad] offset:64\n\t" \
                "ds_read_b128 %[k4], %[ad] offset:8768\n\t" \
                "ds_read_b128 %[k5], %[ad] offset:17472\n\t" \
                "ds_read_b128 %[k6], %[ad] offset:128\n\t" \
                "ds_read_b128 %[k7], %[ad] offset:8832\n\t" \
                "s_waitcnt lgkmcnt(7)\n\t" \
                "v_mfma_f32_16x16x32_bf16 %[s0], %[k0], %[q0], 0\n\t" \
                "ds_read_b128 %[k0], %[ad] offset:17536\n\t" \
                "s_waitcnt lgkmcnt(7)\n\t" \
                "v_mfma_f32_16x16x32_bf16 %[s1], %[k1], %[q0], 0\n\t" \
                "ds_read_b128 %[k1], %[ad] offset:192\n\t" \
                "s_waitcnt lgkmcnt(7)\n\t" \
                "v_mfma_f32_16x16x32_bf16 %[s2], %[k2], %[q0], 0\n\t" \
                "ds_read_b128 %[k2], %[ad] offset:8896\n\t" \
                "s_waitcnt lgkmcnt(7)\n\t" \
                "v_mfma_f32_16x16x32_bf16 %[s0], %[k3], %[q1], %[s0]\n\t" \
                "ds_read_b128 %[k3], %[ad] offset:17600\n\t" \
                "s_waitcnt lgkmcnt(7)\n\t" \
                "v_mfma_f32_16x16x32_bf16 %[s1], %[k4], %[q1], %[s1]\n\t" \
                "ds_read_b128 %[k4], %[ad] offset:256\n\t" \
                "s_waitcnt lgkmcnt(7)\n\t" \
                "v_mfma_f32_16x16x32_bf16 %[s2], %[k5], %[q1], %[s2]\n\t" \
                "ds_read_b128 %[k5], %[ad] offset:8960\n\t" \
                "s_waitcnt lgkmcnt(7)\n\t" \
                "v_mfma_f32_16x16x32_bf16 %[s0], %[k6], %[q2], %[s0]\n\t" \
                "ds_read_b128 %[k6], %[ad] offset:17664\n\t" \
                "s_waitcnt lgkmcnt(7)\n\t" \
                "v_mfma_f32_16x16x32_bf16 %[s1], %[k7], %[q2], %[s1]\n\t" \
                "ds_read_b128 %[k7], %[ad] offset:320\n\t" \
                "s_waitcnt lgkmcnt(7)\n\t" \
                "v_mfma_f32_16x16x32_bf16 %[s2], %[k0], %[q2], %[s2]\n\t" \
                "ds_read_b128 %[k0], %[ad] offset:9024\n\t" \
                "s_waitcnt lgkmcnt(7)\n\t" \
                "v_mfma_f32_16x16x32_bf16 %[s0], %[k1], %[q3], %[s0]\n\t" \
                "ds_read_b128 %[k1], %[ad] offset:17728\n\t" \
                "s_waitcnt lgkmcnt(7)\n\t" \
                "v_mfma_f32_16x16x32_bf16 %[s1], %[k2], %[q3], %[s1]\n\t" \
                "ds_read_b128 %[k2], %[ad] offset:384\n\t" \
                "s_waitcnt lgkmcnt(7)\n\t" \
                "v_mfma_f32_16x16x32_bf16 %[s2], %[k3], %[q3], %[s2]\n\t" \
                "ds_read_b128 %[k3], %[ad] offset:9088\n\t" \
                "s_waitcnt lgkmcnt(7)\n\t" \
                "v_mfma_f32_16x16x32_bf16 %[s0], %[k4], %[q4], %[s0]\n\t" \
                "ds_read_b128 %[k4], %[ad] offset:17792\n\t" \
                "s_waitcnt lgkmcnt(7)\n\t" \
                "v_mfma_f32_16x16x32_bf16 %[s1], %[k5], %[q4], %[s1]\n\t" \
                "ds_read_b128 %[k5], %[ad] offset:448\n\t" \
                "s_waitcnt lgkmcnt(7)\n\t" \
                "v_mfma_f32_16x16x32_bf16 %[s2], %[k6], %[q4], %[s2]\n\t" \
                "ds_read_b128 %[k6], %[ad] offset:9152\n\t" \
                "s_waitcnt lgkmcnt(7)\n\t" \
                "v_mfma_f32_16x16x32_bf16 %[s0], %[k7], %[q5], %[s0]\n\t" \
                "ds_read_b128 %[k7], %[ad] offset:17856\n\t" \
                "s_waitcnt lgkmcnt(7)\n\t" \
                "v_mfma_f32_16x16x32_bf16 %[s1], %[k0], %[q5], %[s1]\n\t" \
                "s_waitcnt lgkmcnt(6)\n\t" \
                "v_mfma_f32_16x16x32_bf16 %[s2], %[k1], %[q5], %[s2]\n\t" \
                "s_waitcnt lgkmcnt(5)\n\t" \
                "v_mfma_f32_16x16x32_bf16 %[s0], %[k2], %[q6], %[s0]\n\t" \
                "s_waitcnt lgkmcnt(4)\n\t" \
                "v_mfma_f32_16x16x32_bf16 %[s1], %[k3], %[q6], %[s1]\n\t" \
                "s_waitcnt lgkmcnt(3)\n\t" \
                "v_mfma_f32_16x16x32_bf16 %[s2], %[k4], %[q6], %[s2]\n\t" \
                "s_waitcnt lgkmcnt(2)\n\t" \
                "v_mfma_f32_16x16x32_bf16 %[s0], %[k5], %[q7], %[s0]\n\t" \
                "s_waitcnt lgkmcnt(1)\n\t" \
                "v_mfma_f32_16x16x32_bf16 %[s1], %[k6], %[q7], %[s1]\n\t" \
                "s_waitcnt lgkmcnt(0)\n\t" \
                "v_mfma_f32_16x16x32_bf16 %[s2], %[k7], %[q7], %[s2]\n\t" \
                "s_nop 7\n\t" \
                "s_nop 7\n\t" \
                "s_nop 7\n\t" \
                : [s0] "=&v"(S0), [s1] "=&v"(S1), [s2] "=&v"(S2), [k0] "=&v"(k0_), [k1] "=&v"(k1_), [k2] "=&v"(k2_), [k3] "=&v"(k3_), [k4] "=&v"(k4_), [k5] "=&v"(k5_), [k6] "=&v"(k6_), [k7] "=&v"(k7_) \
                : [ad] "v"(AD), [q0] "v"(qf[0]), [q1] "v"(qf[1]), [q2] "v"(qf[2]), [q3] "v"(qf[3]), [q4] "v"(qf[4]), [q5] "v"(qf[5]), [q6] "v"(qf[6]), [q7] "v"(qf[7]) : "memory"); } while (0)
#define RET_ST_BLOCK4(S0, S1, S2, S3, AD) do { bf16x8 k0_, k1_, k2_, k3_, k4_, k5_, k6_, k7_; asm volatile( \
                "ds_read_b128 %[k0], %[ad] offset:0\n\t" \
                "ds_read_b128 %[k1], %[ad] offset:8704\n\t" \
                "ds_read_b128 %[k2], %[ad] offset:17408\n\t" \
                "ds_read_b128 %[k3], %[ad] offset:26112\n\t" \
                "ds_read_b128 %[k4], %[ad] offset:64\n\t" \
                "ds_read_b128 %[k5], %[ad] offset:8768\n\t" \
                "ds_read_b128 %[k6], %[ad] offset:17472\n\t" \
                "ds_read_b128 %[k7], %[ad] offset:26176\n\t" \
                "s_waitcnt lgkmcnt(7)\n\t" \
                "v_mfma_f32_16x16x32_bf16 %[s0], %[k0], %[q0], 0\n\t" \
                "ds_read_b128 %[k0], %[ad] offset:128\n\t" \
                "s_waitcnt lgkmcnt(7)\n\t" \
                "v_mfma_f32_16x16x32_bf16 %[s1], %[k1], %[q0], 0\n\t" \
                "ds_read_b128 %[k1], %[ad] offset:8832\n\t" \
                "s_waitcnt lgkmcnt(7)\n\t" \
                "v_mfma_f32_16x16x32_bf16 %[s2], %[k2], %[q0], 0\n\t" \
                "ds_read_b128 %[k2], %[ad] offset:17536\n\t" \
                "s_waitcnt lgkmcnt(7)\n\t" \
                "v_mfma_f32_16x16x32_bf16 %[s3], %[k3], %[q0], 0\n\t" \
                "ds_read_b128 %[k3], %[ad] offset:26240\n\t" \
                "s_waitcnt lgkmcnt(7)\n\t" \
                "v_mfma_f32_16x16x32_bf16 %[s0], %[k4], %[q1], %[s0]\n\t" \
                "ds_read_b128 %[k4], %[ad] offset:192\n\t" \
                "s_waitcnt lgkmcnt(7)\n\t" \
                "v_mfma_f32_16x16x32_bf16 %[s1], %[k5], %[q1], %[s1]\n\t" \
                "ds_read_b128 %[k5], %[ad] offset:8896\n\t" \
                "s_waitcnt lgkmcnt(7)\n\t" \
                "v_mfma_f32_16x16x32_bf16 %[s2], %[k6], %[q1], %[s2]\n\t" \
                "ds_read_b128 %[k6], %[ad] offset:17600\n\t" \
                "s_waitcnt lgkmcnt(7)\n\t" \
                "v_mfma_f32_16x16x32_bf16 %[s3], %[k7], %[q1], %[s3]\n\t" \
                "ds_read_b128 %[k7], %[ad] offset:26304\n\t" \
                "s_waitcnt lgkmcnt(7)\n\t" \
                "v_mfma_f32_16x16x32_bf16 %[s0], %[k0], %[q2], %[s0]\n\t" \
                "ds_read_b128 %[k0], %[ad] offset:256\n\t" \
                "s_waitcnt lgkmcnt(7)\n\t" \
                "v_mfma_f32_16x16x32_bf16 %[s1], %[k1], %[q2], %[s1]\n\t" \
                "ds_read_b128 %[k1], %[ad] offset:8960\n\t" \
                "s_waitcnt lgkmcnt(7)\n\t" \
                "v_mfma_f32_16x16x32_bf16 %[s2], %[k2], %[q2], %[s2]\n\t" \
                "ds_read_b128 %[k2], %[ad] offset:17664\n\t" \
                "s_waitcnt lgkmcnt(7)\n\t" \
                "v_mfma_f32_16x16x32_bf16 %[s3], %[k3], %[q2], %[s3]\n\t" \
                "ds_read_b128 %[k3], %[ad] offset:26368\n\t" \
                "s_waitcnt lgkmcnt(7)\n\t" \
                "v_mfma_f32_16x16x32_bf16 %[s0], %[k4], %[q3], %[s0]\n\t" \
                "ds_read_b128 %[k4], %[ad] offset:320\n\t" \
                "s_waitcnt lgkmcnt(7)\n\t" \
                "v_mfma_f32_16x16x32_bf16 %[s1], %[k5], %[q3], %[s1]\n\t" \
                "ds_read_b128 %[k5], %[ad] offset:9024\n\t" \
                "s_waitcnt lgkmcnt(7)\n\t" \
                "v_mfma_f32_16x16x32_bf16 %[s2], %[k6], %[q3], %[s2]\n\t" \
                "ds_read_b128 %[k6], %[ad] offset:17728\n\t" \
                "s_waitcnt lgkmcnt(7)\n\t" \
                "v_mfma_f32_16x16x32_bf16 %[s3], %[k7], %[q3], %[s3]\n\t" \
                "ds_read_b128 %[k7], %[ad] offset:26432\n\t" \
                "s_waitcnt lgkmcnt(7)\n\t" \
                "v_mfma_f32_16x16x32_bf16 %[s0], %[k0], %[q4], %[s0]\n\t" \
                "ds_read_b128 %[k0], %[ad] offset:384\n\t" \
                "s_waitcnt lgkmcnt(7)\n\t" \
                "v_mfma_f32_16x16x32_bf16 %[s1], %[k1], %[q4], %[s1]\n\t" \
                "ds_read_b128 %[k1], %[ad] offset:9088\n\t" \
                "s_waitcnt lgkmcnt(7)\n\t" \
                "v_mfma_f32_16x16x32_bf16 %[s2], %[k2], %[q4], %[s2]\n\t" \
                "ds_read_b128 %[k2], %[ad] offset:17792\n\t" \
                "s_waitcnt lgkmcnt(7)\n\t" \
                "v_mfma_f32_16x16x32_bf16 %[s3], %[k3], %[q4], %[s3]\n\t" \
                "ds_read_b128 %[k3], %[ad] offset:26496\n\t" \
                "s_waitcnt lgkmcnt(7)\n\t" \
                "v_mfma_f32_16x16x32_bf16 %[s0], %[k4], %[q5], %[s0]\n\t" \
                "ds_read_b128 %[k4], %[ad] offset:448\n\t" \
                "s_waitcnt lgkmcnt(7)\n\t" \
                "v_mfma_f32_16x16x32_bf16 %[s1], %[k5], %[q5], %[s1]\n\t" \
                "ds_read_b128 %[k5], %[ad] offset:9152\n\t" \
                "s_waitcnt lgkmcnt(7)\n\t" \
                "v_mfma_f32_16x16x32_bf16 %[s2], %[k6], %[q5], %[s2]\n\t" \
                "ds_read_b128 %[k6], %[ad] offset:17856\n\t" \
                "s_waitcnt lgkmcnt(7)\n\t" \
                "v_mfma_f32_16x16x32_bf16 %[s3], %[k7], %[q5], %[s3]\n\t" \
                "ds_read_b128 %[k7], %[ad] offset:26560\n\t" \
                "s_waitcnt lgkmcnt(7)\n\t" \
                "v_mfma_f32_16x16x32_bf16 %[s0], %[k0], %[q6], %[s0]\n\t" \
                "s_waitcnt lgkmcnt(6)\n\t" \
                "v_mfma_f32_16x16x32_bf16 %[s1], %[k1], %[q6], %[s1]\n\t" \
                "s_waitcnt lgkmcnt(5)\n\t" \
                "v_mfma_f32_16x16x32_bf16 %[s2], %[k2], %[q6], %[s2]\n\t" \
                "s_waitcnt lgkmcnt(4)\n\t" \
                "v_mfma_f32_16x16x32_bf16 %[s3], %[k3], %[q6], %[s3]\n\t" \
                "s_waitcnt lgkmcnt(3)\n\t" \
                "v_mfma_f32_16x16x32_bf16 %[s0], %[k4], %[q7], %[s0]\n\t" \
                "s_waitcnt lgkmcnt(2)\n\t" \
                "v_mfma_f32_16x16x32_bf16 %[s1], %[k5], %[q7], %[s1]\n\t" \
                "s_waitcnt lgkmcnt(1)\n\t" \
                "v_mfma_f32_16x16x32_bf16 %[s2], %[k6], %[q7], %[s2]\n\t" \
                "s_waitcnt lgkmcnt(0)\n\t" \
                "v_mfma_f32_16x16x32_bf16 %[s3], %[k7], %[q7], %[s3]\n\t" \
                "s_nop 7\n\t" \
                "s_nop 7\n\t" \
                "s_nop 7\n\t" \
                : [s0] "=&v"(S0), [s1] "=&v"(S1), [s2] "=&v"(S2), [s3] "=&v"(S3), [k0] "=&v"(k0_), [k1] "=&v"(k1_), [k2] "=&v"(k2_), [k3] "=&v"(k3_), [k4] "=&v"(k4_), [k5] "=&v"(k5_), [k6] "=&v"(k6_), [k7] "=&v"(k7_) \
                : [ad] "v"(AD), [q0] "v"(qf[0]), [q1] "v"(qf[1]), [q2] "v"(qf[2]), [q3] "v"(qf[3]), [q4] "v"(qf[4]), [q5] "v"(qf[5]), [q6] "v"(qf[6]), [q7] "v"(qf[7]) : "memory"); } while (0)
#define RET_PACK(P0) do { _Pragma("unroll") for (int p_ = 0; p_ < 2; ++p_) { float m[8]; \
                _Pragma("unroll") for (int rr = 0; rr < 4; ++rr) { const int j0 = 32 * (P0 + p_) + 4 * g4 + rr, j1 = j0 + 16; \
                    m[rr] = (j0 <= i) ? sacc[2 * p_][rr] : 0.f; \
                    m[4 + rr] = (j1 <= i) ? sacc[2 * p_ + 1][rr] : 0.f; } \
                v4u sw; sw.x = cvtpk(m[0], m[1]); sw.y = cvtpk(m[2], m[3]); sw.z = cvtpk(m[4], m[5]); sw.w = cvtpk(m[6], m[7]); \
                sf[P0 + p_] = __builtin_bit_cast(bf16x8, sw); } } while (0)
            bf16x8 sf[4];
            { f32x4 sacc[4];
              const unsigned kad = (unsigned)(size_t)(K_t + i16 * 544 + 16 * g4);
#define RET_ST_N(NB_, AD_) do { const f32x4 z4_ = (f32x4){0.f, 0.f, 0.f, 0.f}; \
                if ((NB_) == 4) RET_ST_BLOCK4(sacc[0], sacc[1], sacc[2], sacc[3], AD_); \
                else if ((NB_) == 3) { RET_ST_BLOCK3(sacc[0], sacc[1], sacc[2], AD_); sacc[3] = z4_; } \
                else if ((NB_) == 2) { RET_ST_BLOCK2(sacc[0], sacc[1], AD_); sacc[2] = z4_; sacc[3] = z4_; } \
                else { RET_ST_BLOCK1(sacc[0], AD_); sacc[1] = z4_; sacc[2] = z4_; sacc[3] = z4_; } } while (0)
              const int nb1 = (ib < 3) ? ib + 1 : 4;
              RET_ST_N(nb1, kad);
              RET_PACK(0);
              if (ib >= 4) { const unsigned kad2 = kad + 34816u; const int nb2 = ib - 3; RET_ST_N(nb2, kad2); RET_PACK(2); }
              else { sf[2] = __builtin_bit_cast(bf16x8, (v4u){0u, 0u, 0u, 0u}); sf[3] = sf[2]; } }
#undef RET_ST_N
#undef RET_PACK
#undef RET_ST_BLOCK1
#undef RET_ST_BLOCK2
#undef RET_ST_BLOCK3
#undef RET_ST_BLOCK4
            f32x4 o[2];
            o[0] = (f32x4){0.f, 0.f, 0.f, 0.f}; o[1] = (f32x4){0.f, 0.f, 0.f, 0.f};
#pragma unroll
            for (int k2 = 0; k2 < 8; k2 += 2) {
                bf16x8 rf[2][2];
#pragma unroll
                for (int kk = 0; kk < 2; ++kk)
#pragma unroll
                    for (int eb = 0; eb < 2; ++eb) rf[kk][eb] = *(const LAS bf16x8*)(RT_c + (16 * eb + i16) * 544 + (32 * (k2 + kk) + 8 * g4) * 2);
                asm volatile("" ::: "memory");
#pragma unroll
                for (int kk = 0; kk < 2; ++kk)
#pragma unroll
                    for (int eb = 0; eb < 2; ++eb) o[eb] = MFMA16(rf[kk][eb], qf[k2 + kk], o[eb]);
            }
            bf16x8 vfi[4][2];
#pragma unroll
            for (int p = 0; p < 4; ++p)
#pragma unroll
                for (int eb = 0; eb < 2; ++eb) vfi[p][eb] = lds_tr_pair(V_t, 96, 32 * p + 4 * g4, 32 * p + 16 + 4 * g4, 16 * eb, lane);
            asm volatile("" ::: "memory");
#pragma unroll
            for (int p = 0; p < 4; ++p)
#pragma unroll
                for (int eb = 0; eb < 2; ++eb) o[eb] = MFMA16(vfi[p][eb], sf[p], o[eb]);
            { const size_t advq = (size_t)((n + 1 < NCHUNK) ? n + 1 : n) * 128 * LDT;
#pragma unroll
              for (int ks = 0; ks < 8; ++ks) qf[ks] = *(const bf16x8*)(qg + advq + 32 * ks); }
            { const size_t token = tb + (size_t)n * 128 + i; float s = 0.f, q = 0.f;
#pragma unroll
              for (int eb = 0; eb < 2; ++eb) { u32x2 pk; pk.x = cvtpk(o[eb][0], o[eb][1]); pk.y = cvtpk(o[eb][2], o[eb][3]);
                  *(u32x2*)(Opre + token * LDT + hc + 32 * es + 16 * eb + 4 * g4) = pk;
#pragma unroll
                  for (int rr = 0; rr < 4; ++rr) { s += o[eb][rr]; q += o[eb][rr] * o[eb][rr]; } }
              s += __shfl_xor(s, 16); q += __shfl_xor(q, 16); s += __shfl_xor(s, 32); q += __shfl_xor(q, 32);
              if (g4 == 0) *(f32x2v*)(stats + ((token * 8 + h) * 8 + es) * 2) = (f32x2v){s, q}; }
            if (n + 1 < NCHUNK) {
#pragma unroll
                for (int k2 = 0; k2 < 4; k2 += 2) {
                    bf16x8 kfs[2][2], vfs[2][2];
#pragma unroll
                    for (int kk = 0; kk < 2; ++kk) { kfs[kk][0] = lds_tr_frag_c(K_t, 544, 32 * (k2 + kk), 32 * w, lane); kfs[kk][1] = lds_tr_frag_c(K_t, 544, 32 * (k2 + kk), 32 * w + 16, lane);
                        vfs[kk][0] = lds_tr_frag_c(V_t, 96, 32 * (k2 + kk), 0, lane); vfs[kk][1] = lds_tr_frag_c(V_t, 96, 32 * (k2 + kk), 16, lane); }
                    asm volatile("" ::: "memory");
#pragma unroll
                    for (int kk = 0; kk < 2; ++kk) { r[0][0] = MFMA16(kfs[kk][0], vfs[kk][0], r[0][0]); r[0][1] = MFMA16(kfs[kk][0], vfs[kk][1], r[0][1]);
                        r[1][0] = MFMA16(kfs[kk][1], vfs[kk][0], r[1][0]); r[1][1] = MFMA16(kfs[kk][1], vfs[kk][1], r[1][1]); }
                }
#pragma unroll
                for (int a = 0; a < 2; ++a)
#pragma unroll
                    for (int c = 0; c < 2; ++c) r[a][c] = r[a][c] * gamma_c;
#pragma unroll
                for (int db = 0; db < 2; ++db)
#pragma unroll
                    for (int eb = 0; eb < 2; ++eb) { u32x2 pk; pk.x = cvtpk(r[db][eb][0], r[db][eb][1]); pk.y = cvtpk(r[db][eb][2], r[db][eb][3]);
                        *(LAS u32x2*)(RT_n + (16 * eb + i16) * 544 + (32 * w + 16 * db + 4 * g4) * 2) = pk; }
            }
        }
        LDS_BARRIER();
    }
}
__device__ __forceinline__ void phase_sgumix2(LAS unsigned char* lds, const bf16* WM, const bf16* VS, const float* sgst, const float* lngain, bf16* U, const float* sb, int vcu, int G, int tid) {
    asm volatile("" : "+v"(tid));
    const int lane = tid & 63, w = __builtin_amdgcn_readfirstlane(tid >> 6), i16 = lane & 15, g4 = lane >> 4;
    LAS unsigned char* W_t = lds;
    LAS unsigned char* V_t = lds + 34816;
    LAS float* mr = (LAS float*)(lds + 102400);
    for (int bn = vcu; bn < BATCH * NCHUNK; bn += G) {
        const size_t t0 = (size_t)bn * 128;
        LDS_BARRIER();
        if (tid < 128) { const f32x4* sp = (const f32x4*)(sgst + (t0 + tid) * 64); float s = 0.f, q = 0.f;
#pragma unroll
            for (int k = 0; k < 16; ++k) { const f32x4 v = sp[k]; s += v[0]; q += v[1]; s += v[2]; q += v[3]; }
            const float mean = s * (1.0f / 2048.0f), var = q * (1.0f / 2048.0f) - mean * mean;
            mr[tid * 2] = mean; mr[tid * 2 + 1] = 1.0f / sqrtf(fmaxf(var, 0.f) + EPS); }
        v4u wpre[4], vpre[8]; f32x4 gpre[2];
        const bf16* vg = VS + (t0 + (tid >> 5)) * LDT + (tid & 31) * 8;
        const bf16* wg = WM + (tid >> 4) * 128 + (tid & 15) * 8;
#pragma unroll
        for (int k = 0; k < 4; ++k) wpre[k] = *(const v4u*)(wg + k * 32 * 128);
#pragma unroll
        for (int k = 0; k < 8; ++k) vpre[k] = *(const v4u*)(vg + (size_t)k * 16 * LDT);
        gpre[0] = *(const f32x4*)(lngain + (tid & 31) * 8); gpre[1] = *(const f32x4*)(lngain + (tid & 31) * 8 + 4);
        for (int g = 0; g < 8; ++g) {
            const int c0 = g * 256;
            LDS_BARRIER();
#pragma unroll
            for (int k = 0; k < 4; ++k) *(LAS v4u*)(W_t + ((tid >> 4) + 32 * k) * 272 + (tid & 15) * 16) = wpre[k];
#pragma unroll
            for (int k = 0; k < 8; ++k) { const int row = (tid >> 5) + 16 * k; const float mean = mr[row * 2], rstd = mr[row * 2 + 1]; const v4u x = vpre[k];
                v4u o; o.x = cvtpk((bflo(x.x) - mean) * rstd * gpre[0][0], (bfhi(x.x) - mean) * rstd * gpre[0][1]); o.y = cvtpk((bflo(x.y) - mean) * rstd * gpre[0][2], (bfhi(x.y) - mean) * rstd * gpre[0][3]);
                o.z = cvtpk((bflo(x.z) - mean) * rstd * gpre[1][0], (bfhi(x.z) - mean) * rstd * gpre[1][1]); o.w = cvtpk((bflo(x.w) - mean) * rstd * gpre[1][2], (bfhi(x.w) - mean) * rstd * gpre[1][3]);
                *(LAS v4u*)(V_t + row * 528 + (tid & 31) * 16) = o; }
            { const int gn = (g + 1 < 8) ? g + 1 : g;
#pragma unroll
              for (int k = 0; k < 4; ++k) wpre[k] = *(const v4u*)(wg + (size_t)gn * 16384 + k * 32 * 128);
#pragma unroll
              for (int k = 0; k < 8; ++k) vpre[k] = *(const v4u*)(vg + gn * 256 + (size_t)k * 16 * LDT);
              gpre[0] = *(const f32x4*)(lngain + gn * 256 + (tid & 31) * 8); gpre[1] = *(const f32x4*)(lngain + gn * 256 + (tid & 31) * 8 + 4); }
            LDS_BARRIER();
            u32x2 uw[2][8];
#pragma unroll
            for (int ib = 0; ib < 8; ++ib)
#pragma unroll
                for (int cb = 0; cb < 2; ++cb) uw[cb][ib] = *(const u32x2*)(U + (t0 + 16 * ib + i16) * LDT + c0 + 32 * w + 16 * cb + 4 * g4);
            f32x4 acc[2][8];
#pragma unroll
            for (int a = 0; a < 2; ++a)
#pragma unroll
                for (int b = 0; b < 8; ++b) acc[a][b] = (f32x4){0.f, 0.f, 0.f, 0.f};
#pragma unroll
            for (int ks = 0; ks < 4; ++ks) {
                const bf16x8 vf0 = lds_tr_frag(V_t, 528, 32 * ks, 32 * w, lane), vf1 = lds_tr_frag(V_t, 528, 32 * ks, 32 * w + 16, lane);
#pragma unroll
                for (int ib = 0; ib < 8; ++ib) if (2 * ks <= ib) {
                    const bf16x8 wf = *(const LAS bf16x8*)(W_t + (16 * ib + i16) * 272 + (32 * ks + 8 * g4) * 2);
                    acc[0][ib] = MFMA16(vf0, wf, acc[0][ib]); acc[1][ib] = MFMA16(vf1, wf, acc[1][ib]); }
            }
#pragma unroll
            for (int ib = 0; ib < 8; ++ib) { const int i = 16 * ib + i16; const float bias = sb[g * 128 + i];
#pragma unroll
                for (int cb = 0; cb < 2; ++cb) { const u32x2 x = uw[cb][ib]; const f32x4 a = acc[cb][ib];
                    u32x2 o; o.x = cvtpk(bflo(x.x) * (a[0] + bias), bfhi(x.x) * (a[1] + bias)); o.y = cvtpk(bflo(x.y) * (a[2] + bias), bfhi(x.y) * (a[3] + bias));
                    *(u32x2*)(U + (t0 + i) * LDT + c0 + 32 * w + 16 * cb + 4 * g4) = o; } }
        }
    }
    LDS_BARRIER();
}
__device__ __forceinline__ void phase_retln(const bf16* Opre, const float* stats, const bf16* Gi, bf16* Gt, const float* gn, int gw, int NGW, int lane) {
    asm volatile("" : "+v"(lane));
    f32x4 gv[8];
#pragma unroll
    for (int h = 0; h < 8; ++h) gv[h] = *(const f32x4*)(gn + h * 256 + 4 * lane);
    for (int m = gw; m < M; m += NGW) {
        f32x2v st = *(const f32x2v*)(stats + ((size_t)m * 64 + lane) * 2);
        float s = st.x, q = st.y;
        s += __shfl_xor(s, 1); q += __shfl_xor(q, 1); s += __shfl_xor(s, 2); q += __shfl_xor(q, 2); s += __shfl_xor(s, 4); q += __shfl_xor(q, 4);
        const float mean_l = s * (1.0f / 256.0f), var_l = q * (1.0f / 256.0f) - mean_l * mean_l, rstd_l = 1.0f / sqrtf(fmaxf(var_l, 0.f) + EPS);
        const u32x2* op = (const u32x2*)(Opre + (size_t)m * LDT) + lane; u32x2* gp = (u32x2*)(Gt + (size_t)m * LDT) + lane; const u32x2* gi = (const u32x2*)(Gi + (size_t)m * LDT) + lane;
#pragma unroll
        for (int h = 0; h < 8; ++h) { const float mean = __shfl(mean_l, 8 * h), rstd = __shfl(rstd_l, 8 * h);
            const u32x2 ow = op[64 * h], gw2 = gi[64 * h];
            u32x2 y; y.x = cvtpk((bflo(ow.x) - mean) * rstd * gv[h][0] * bflo(gw2.x), (bfhi(ow.x) - mean) * rstd * gv[h][1] * bfhi(gw2.x));
            y.y = cvtpk((bflo(ow.y) - mean) * rstd * gv[h][2] * bflo(gw2.y), (bfhi(ow.y) - mean) * rstd * gv[h][3] * bfhi(gw2.y));
            gp[64 * h] = y; }
    }
}

__device__ __forceinline__ int fresh_tid() { int t = threadIdx.x; asm volatile("" : "+v"(t)); return t; }
struct Args { const void* in[19]; float* out; unsigned char* ws; };
__global__ void __launch_bounds__(NWAVES * 64, 2) fwd(Args args) {
    extern __shared__ __attribute__((aligned(16))) unsigned char lds_raw[];
    LAS unsigned char* lds = (LAS unsigned char*)lds_raw;
    volatile LAS unsigned* MISC = (volatile LAS unsigned*)(lds + MISC_OFF);
#define TID fresh_tid()
#define LANE (fresh_tid() & 63)
    const int wave = __builtin_amdgcn_readfirstlane(TID >> 6);
    const int G = gridDim.x; const int bx = blockIdx.x; const int vcu = (G % 8 == 0) ? (bx % 8) * (G / 8) + bx / 8 : bx;
    const int gw = vcu * NWAVES + wave, NGW = G * NWAVES;
    unsigned char* ws = args.ws; float* X = args.out;
    for (int u = TID; u < (LDS_BYTES - LDSCTL_OFF) / 4; u += NWAVES * 64) ((LAS unsigned*)(lds + LDSCTL_OFF))[u] = 0u;
    __syncthreads();
    XcdBarrier bar = xcd_barrier_post((unsigned*)(ws + WS_CTL) + CW_BAR, MISC + 8);

    bf16* Hb = (bf16*)(ws + WS_H);
    bf16* BIG = (bf16*)(ws + WS_BIG);
    bf16 *tQ = BIG, *tK = BIG + TSTRIDE, *tV = BIG + 2 * TSTRIDE, *tG = BIG + 3 * TSTRIDE, *tU = BIG + 4 * TSTRIDE, *tVS = BIG + 5 * TSTRIDE, *tGA = BIG + 6 * TSTRIDE, *tGB = BIG + 7 * TSTRIDE;
    float* CS = (float*)(ws + WS_CS);
    bf16* RT = (bf16*)(ws + WS_RT);

    float* SSQ = (float*)(ws + WS_SSQ);
    {
        for (int m = gw; m < M; m += NGW) {
            const f32x4* xr = (const f32x4*)((const float*)args.in[0] + (size_t)m * D) + LANE; u32x2* ho = (u32x2*)(Hb + (size_t)m * LDT) + LANE;
            float sq = 0.f;
#pragma unroll
            for (int j = 0; j < 8; ++j) { const f32x4 v = xr[64 * j]; u32x2 w; w.x = cvtpk(v[0], v[1]); w.y = cvtpk(v[2], v[3]); ho[64 * j] = w; sq += (v[0] * v[0] + v[1] * v[1]) + (v[2] * v[2] + v[3] * v[3]); }
            sq = wave_sum(sq);
            if (LANE < 32) SSQ[(size_t)m * 32 + LANE] = (LANE == 0) ? sq : 0.0f;
        }
        const size_t gt = (size_t)bx * (NWAVES * 64) + TID, gs = (size_t)G * (NWAVES * 64);
        const int* pos = (const int*)args.in[1];
        for (size_t i = gt; i < (size_t)M * 128; i += gs) { const int tkn = (int)(i >> 7), j = (int)(i & 127);
            double inv = 0.15915494309189535;
            inv *= (j & 1) ? 0.930572040929699 : 1.0; inv *= (j & 2) ? 0.8659643233600653 : 1.0; inv *= (j & 4) ? 0.7498942093324559 : 1.0; inv *= (j & 8) ? 0.5623413251903491 : 1.0;
            inv *= (j & 16) ? 0.31622776601683794 : 1.0; inv *= (j & 32) ? 0.1 : 1.0; inv *= (j & 64) ? 0.01 : 1.0;
            double t = (double)pos[tkn] * inv; t -= floor(t); const float tf = (float)t;
            CS[2 * i] = __builtin_amdgcn_cosf(tf); CS[2 * i + 1] = __builtin_amdgcn_sinf(tf); }
    }
    for (int it = 0; it < 2 * DEPTH; ++it) {
        const int l = it >> 1, second = it & 1;
        if (!second) {
            ConvSrc cs;
            cs.gu1 = (const float*)args.in[3] + (size_t)l * D * 2 * FF; cs.d1 = (const float*)args.in[4] + (size_t)l * FF * D; cs.win = (const float*)args.in[6] + (size_t)l * D * INCOLS;
            cs.br = (const float*)args.in[12] + (size_t)l * D * D; cs.bs = (const float*)args.in[13] + (size_t)l * D * D; cs.wo = (const float*)args.in[14] + (size_t)l * D * D;
            cs.gu2 = (const float*)args.in[16] + (size_t)l * D * 2 * FF; cs.d2 = (const float*)args.in[17] + (size_t)l * FF * D; cs.sw = (const float*)args.in[10] + (size_t)l * 8 * 128 * 128;
            cs.g1 = (const float*)args.in[2] + (size_t)l * D; cs.gm = (const float*)args.in[5] + (size_t)l * D; cs.g2 = (const float*)args.in[15] + (size_t)l * D;
            phase_conv(lds, ws, cs, gw, NGW, wave, LANE);
            xcd_barrier(bar);
        }
        {
            const int ci = 3 * l + (second ? 2 : 0);
            pg8::Gemm g{Hb, (const bf16*)(ws + (second ? WS_WGU2 : WS_WGU1)), M, 2 * FF, D, LDT, D}; pg8::StaticOrder S; S.init(M, 2 * FF, G, bx);
            pg8::EpiSwiglu E{BIG, FF, SSQ + (size_t)ci * SSQ_STRIDE, (LAS float*)(lds + RS_OFF), -1};
            pg8::gemm_phase<pg8::EpiSwiglu, pg8::StaticOrder, true, true>(lds, g, S, E);
        }
        xcd_barrier(bar);
        {
            const int pi = 3 * l + (second ? 3 : 1);
            pg8::Gemm g{BIG, (const bf16*)(ws + (second ? WS_WD2 : WS_WD1)), M, D, FF, FF, FF}; pg8::ReverseOrder S; S.init(M, D, G, bx);
            pg8::EpiResid E{0.5f, Hb, SSQ + (size_t)pi * SSQ_STRIDE};
            pg8::gemm_phase<pg8::EpiResid, pg8::ReverseOrder, true, true>(lds, g, S, E);
        }
        xcd_barrier(bar);
        if (!second) {
            {
                const int ci = 3 * l + 1;
                pg8::Gemm g{Hb, (const bf16*)(ws + WS_WIN), M, INCOLS, D, LDT, D}; pg8::StaticOrder S; S.init(M, INCOLS, G, bx);
                pg8::EpiIn E{BIG, TSTRIDE, CS, (const float*)args.in[7] + (size_t)l * 2 * D, SSQ + (size_t)ci * SSQ_STRIDE, (LAS float*)(lds + RS_OFF), -1, (float*)(ws + WS_SGST)};
                pg8::gemm_phase<pg8::EpiIn, pg8::StaticOrder, true, true>(lds, g, S, E);
            }
            xcd_barrier(bar);
            phase_ret(lds, tQ, tK, tV, (bf16*)(ws + WS_OPRE), (float*)(ws + WS_RT), vcu, G, TID);
            xcd_barrier(bar);
            phase_sgumix2(lds, (const bf16*)(ws + WS_WMASK), tVS, (const float*)(ws + WS_SGST), (const float*)args.in[9] + (size_t)l * 2048, tU, (const float*)args.in[11] + (size_t)l * 8 * 128, vcu, G, TID);
            phase_retln((const bf16*)(ws + WS_OPRE), (const float*)(ws + WS_RT), tG, tG, (const float*)args.in[8] + (size_t)l * 2048, gw, NGW, LANE);
            xcd_barrier(bar);
            {
                pg8::Gemm g{tG, (const bf16*)(ws + WS_WBR), M, D, D, LDT, D}; pg8::DualOrder S; S.init(M, D, G, bx); S.A2 = tU; S.B2 = (const bf16*)(ws + WS_WBS);
                pg8::EpiBr<2> E{tQ, tGA, tGB};
                pg8::gemm_phase<pg8::EpiBr<2>, pg8::DualOrder, true, true>(lds, g, S, E);
            }
            xcd_barrier(bar);
            {
                const int pi = 3 * l + 2;
                pg8::Gemm g{tQ, (const bf16*)(ws + WS_WOUT), M, D, D, LDT, D}; pg8::StaticOrder S; S.init(M, D, G, bx);
                pg8::EpiResid E{1.0f, Hb, SSQ + (size_t)pi * SSQ_STRIDE};
                pg8::gemm_phase<pg8::EpiResid, pg8::StaticOrder, true, true>(lds, g, S, E);
            }
            xcd_barrier(bar);
        }
    }
    phase_final(Hb, X, (const float*)args.in[18], gw, NGW, LANE);
}

extern "C" void kernel_launch(void* const* d_in, const int* in_sizes, int n_in, void* d_out, int out_size, void* d_ws, size_t ws_size, hipStream_t stream) {
    static int grid = 0;
    if (grid == 0) {
        if (n_in != 19 || in_sizes[0] != M * D || out_size != M * D || ws_size < WS_END) { fprintf(stderr, "kernel_launch: unexpected shapes / workspace (n_in %d, in0 %d, out %d, ws %zu, need %zu); nothing launched\n", n_in, n_in > 0 ? in_sizes[0] : -1, out_size, ws_size, (size_t)WS_END); grid = -1; return; }
        int dev = 0, cus = 0, per_cu = 0;
        if (hipGetDevice(&dev) != hipSuccess || hipDeviceGetAttribute(&cus, hipDeviceAttributeMultiprocessorCount, dev) != hipSuccess) { fprintf(stderr, "kernel_launch: device query failed\n"); grid = -1; return; }
        if (hipFuncSetAttribute((const void*)fwd, hipFuncAttributeMaxDynamicSharedMemorySize, LDS_BYTES) != hipSuccess) { fprintf(stderr, "kernel_launch: hipFuncSetAttribute failed\n"); grid = -1; return; }
        if (hipOccupancyMaxActiveBlocksPerMultiprocessor(&per_cu, (const void*)fwd, NWAVES * 64, LDS_BYTES) != hipSuccess || per_cu < 1) fprintf(stderr, "kernel_launch: note: occupancy query reports %d workgroups per CU\n", per_cu);
        (void)hipGetLastError();
        grid = cus;
    }
    if (grid < 0) return;
    if (hipMemsetAsync((char*)d_ws + WS_CTL, 0, CTL_ZERO_BYTES, stream) != hipSuccess) { fprintf(stderr, "kernel_launch: memset failed\n"); return; }
    Args a{};
    for (int i = 0; i < 19; ++i) a.in[i] = d_in[i];
    a.out = (float*)d_out; a.ws = (unsigned char*)d_ws;
    hipLaunchKernelGGL(fwd, dim3(grid), dim3(NWAVES * 64), LDS_BYTES, stream, a);
    const hipError_t le = hipPeekAtLastError();
    if (le != hipSuccess) fprintf(stderr, "kernel_launch: launch failed: %s\n", hipGetErrorName(le));
}
```

```cpp
#include <hip/hip_runtime.h>
#include <cstdio>
#include <cstdint>
#include <cmath>
namespace pg8 {
#define PG8_LAS __attribute__((address_space(3)))
typedef unsigned short bf16_t;
typedef short bf16x8 __attribute__((ext_vector_type(8)));
typedef float f32x4 __attribute__((ext_vector_type(4)));
typedef unsigned u32x4 __attribute__((ext_vector_type(4)));
constexpr int LDT = 2048 + 64;
constexpr int BM = 256, BK = 64, HALF = 128, HTB = HALF * BK * 2  , STAGE_BYTES = 8 * HTB, NXCD = 8, WGM = 8;

__host__ __device__ __forceinline__ int lds_byte(int r, int c) { const int st = (r >> 4) * 2 + (c >> 5), rr = r & 15, cc = c & 31, ob = rr * 64 + cc * 2; return st * 1024 + (ob ^ (((ob >> 9) & 1) << 5)); }
__host__ __device__ __forceinline__ void stage_rc(int b, int& R, int& C) { const int st = b / 1024, sb = b % 1024, swz = sb ^ (((sb >> 9) & 1) << 5); R = (st >> 1) * 16 + swz / 64; C = (st & 1) * 32 + (swz % 64) / 2; }
__host__ __device__ __forceinline__ int perm32(int rho) { const int n = rho >> 4, i = rho & 15; return 8 * (i >> 2) + 4 * n + (i & 3); }

struct Unit { int pm, pn, z; };
struct Gemm { const bf16_t* A; const bf16_t* Bt; int M, N, K; int lda, ldb; };

struct StaticOrder {
    int nM, nN, nwg, G, c;
    __host__ __device__ void init(int M, int N, int G_, int c_) { nM = M / BM; nN = N / BM; nwg = nM * nN; G = G_; c = c_; }
    __host__ __device__ bool next(int i, Unit& u) const {
        const long L = (long)i * G + c; if (L >= nwg) return false;
        int wgid = (int)L; { const int q = nwg / NXCD, r = nwg % NXCD, xcd = wgid % NXCD, off = wgid / NXCD; wgid = (xcd < r ? xcd * (q + 1) : r * (q + 1) + (xcd - r) * q) + off; }
        const int nig = WGM * nN, gid = wgid / nig, fm = gid * WGM, gsz = (nM - fm) < WGM ? (nM - fm) : WGM;
        u.pm = fm + ((wgid % nig) % gsz); u.pn = (wgid % nig) / gsz; u.z = 0; return true;
    }
    __device__ __forceinline__ void a_ready(const Unit&) const {}
    __device__ __forceinline__ void done(const Unit&) const {}
    __device__ __forceinline__ const bf16_t* opA(const Gemm& g, const Unit&) const { return g.A; }
    __device__ __forceinline__ const bf16_t* opB(const Gemm& g, const Unit&) const { return g.Bt; }
};
struct ReverseOrder : StaticOrder {
    __device__ bool next(int i, Unit& u) const { const int rounds = nwg / G; if (i >= rounds) return false; return StaticOrder::next(rounds - 1 - i, u); }
};
struct DualOrder : StaticOrder {
    const bf16_t* A2; const bf16_t* B2;
    __device__ bool next(int i, Unit& u) const { const int rounds = nwg / G; if (i >= 2 * rounds) return false; const bool ok = StaticOrder::next(i >= rounds ? i - rounds : i, u); u.z = (i >= rounds) ? 1 : 0; return ok; }
    __device__ __forceinline__ const bf16_t* opA(const Gemm& g, const Unit& u) const { return u.z ? A2 : g.A; }
    __device__ __forceinline__ const bf16_t* opB(const Gemm& g, const Unit& u) const { return u.z ? B2 : g.Bt; }
};
typedef float f32x2_c __attribute__((ext_vector_type(2))); typedef __bf16 bf16x2_c __attribute__((ext_vector_type(2)));
__device__ __forceinline__ unsigned cvt_pk_bf16(float lo, float hi) { f32x2_c v = {lo, hi}; bf16x2_c b = __builtin_convertvector(v, bf16x2_c); return __builtin_bit_cast(unsigned, b); }
typedef float f32x2 __attribute__((ext_vector_type(2)));
__device__ __forceinline__ f32x2 gelu_pk(f32x2 v) {
    const f32x2 av = __builtin_elementwise_abs(v), d = av * 0.2316418882f + 1.0f;
    f32x2 t; t.x = __builtin_amdgcn_rcpf(d.x); t.y = __builtin_amdgcn_rcpf(d.y);
    f32x2 q = t * 0.5307027145f + (-0.7265760135f); q = q * t + 0.7107068705f; q = q * t + (-0.142248368f); q = q * t + 0.127414796f; q = q * t;
    const f32x2 s = (v * v) * (-0.72134752044f);
    f32x2 e; e.x = __builtin_amdgcn_exp2f(s.x); e.y = __builtin_amdgcn_exp2f(s.y);
    const f32x2 m = v * (q * e), r = v - m;
    f32x2 o; o.x = v.x < 0.f ? m.x : r.x; o.y = v.y < 0.f ? m.y : r.y; return o;
}

__device__ __forceinline__ float bf_lo(unsigned u) { return __uint_as_float(u << 16); }
__device__ __forceinline__ float bf_hi(unsigned u) { return __uint_as_float(u & 0xffff0000u); }
__device__ __forceinline__ float silu_f(float g) { return g * __builtin_amdgcn_rcpf(1.0f + __builtin_amdgcn_exp2f(-1.44269504f * g)); }
__device__ __forceinline__ float sigmoid_f(float g) { return __builtin_amdgcn_rcpf(1.0f + __builtin_amdgcn_exp2f(-1.44269504f * g)); }

__device__ __forceinline__ float row_rs(const float* ssq, int row, int fq) {
    const float* pp = ssq + (size_t)row * 32 + 8 * fq; const f32x4 p0 = *(const f32x4*)pp, p1 = *(const f32x4*)(pp + 4);
    float s = ((p0[0] + p0[1]) + (p0[2] + p0[3])) + ((p1[0] + p1[1]) + (p1[2] + p1[3]));
    s += __shfl_xor(s, 16); s += __shfl_xor(s, 32);
    return __builtin_amdgcn_rsqf(s * (1.0f / 2048.0f) + 1e-6f);
}
struct EpiSwiglu {
    static constexpr bool PERM = true, AFTER_DRAIN = false; static constexpr int NST = 8;
    bf16_t* O; int ldc; const float* ssq;
    PG8_LAS float* rsl; mutable int cpm;
    __device__ __forceinline__ void operator()(const f32x4 (&acc)[2][2][4][2], const Unit& u, int wr, int wc, int fr, int fq) const {
        const int row0 = u.pm * BM + wr * 64 + fr, col0 = u.pn * HALF + wc * 32 + 8 * fq;
        PG8_LAS float* my = rsl + (wr * 4 + wc) * 128 + fr;
        if (u.pm != cpm) { cpm = u.pm;
#pragma unroll
            for (int ai = 0; ai < 2; ++ai)
#pragma unroll
                for (int m = 0; m < 4; ++m) { const float r = row_rs(ssq, row0 + ai * HALF + m * 16, fq); if (fq == 0) my[(ai * 4 + m) * 16] = r; } }
#pragma unroll
        for (int ai = 0; ai < 2; ++ai)
#pragma unroll
            for (int m = 0; m < 4; ++m) { bf16_t* rowp = O + (size_t)(row0 + ai * HALF + m * 16) * ldc + col0;
                const float rs = my[(ai * 4 + m) * 16];
                const f32x4 a0 = acc[ai][0][m][0] * rs, a1 = acc[ai][0][m][1] * rs, g0 = acc[ai][1][m][0] * rs, g1 = acc[ai][1][m][1] * rs;
                u32x4 w; w.x = cvt_pk_bf16(a0[0] * silu_f(g0[0]), a0[1] * silu_f(g0[1])); w.y = cvt_pk_bf16(a0[2] * silu_f(g0[2]), a0[3] * silu_f(g0[3]));
                w.z = cvt_pk_bf16(a1[0] * silu_f(g1[0]), a1[1] * silu_f(g1[1])); w.w = cvt_pk_bf16(a1[2] * silu_f(g1[2]), a1[3] * silu_f(g1[3]));
                *(u32x4*)rowp = w; }
    }
};
struct EpiResid {
    static constexpr bool PERM = true, AFTER_DRAIN = false; static constexpr int NST = 8;
    float scale; bf16_t* Hx; float* ssq;
    __device__ __forceinline__ void operator()(const f32x4 (&acc)[2][2][4][2], const Unit& u, int wr, int wc, int fr, int fq) const {
        const int row0 = u.pm * BM + wr * 64 + fr, col0 = u.pn * BM + wc * 32 + 8 * fq;
#pragma unroll
        for (int ai = 0; ai < 2; ++ai) {
            u32x4 xv[4][2];
#pragma unroll
            for (int m = 0; m < 4; ++m)
#pragma unroll
                for (int bj = 0; bj < 2; ++bj) xv[m][bj] = *(const u32x4*)(Hx + (size_t)(row0 + ai * HALF + m * 16) * LDT + col0 + bj * HALF);
#pragma unroll
            for (int m = 0; m < 4; ++m) { const int row = row0 + ai * HALF + m * 16; bf16_t* hp = Hx + (size_t)row * LDT + col0;
                float ss = 0.f;
#pragma unroll
                for (int bj = 0; bj < 2; ++bj) { const u32x4 x = xv[m][bj]; const f32x4 a0 = acc[ai][bj][m][0], a1 = acc[ai][bj][m][1];
                    const float y0 = bf_lo(x.x) + a0[0] * scale, y1 = bf_hi(x.x) + a0[1] * scale, y2 = bf_lo(x.y) + a0[2] * scale, y3 = bf_hi(x.y) + a0[3] * scale;
                    const float y4 = bf_lo(x.z) + a1[0] * scale, y5 = bf_hi(x.z) + a1[1] * scale, y6 = bf_lo(x.w) + a1[2] * scale, y7 = bf_hi(x.w) + a1[3] * scale;
                    ss += ((y0 * y0 + y1 * y1) + (y2 * y2 + y3 * y3)) + ((y4 * y4 + y5 * y5) + (y6 * y6 + y7 * y7));
                    u32x4 w; w.x = cvt_pk_bf16(y0, y1); w.y = cvt_pk_bf16(y2, y3); w.z = cvt_pk_bf16(y4, y5); w.w = cvt_pk_bf16(y6, y7);
                    *(u32x4*)(hp + bj * HALF) = w; }
                ss += __shfl_xor(ss, 16); ss += __shfl_xor(ss, 32);
                if (fq == 0) ssq[(size_t)row * 32 + u.pn * 4 + wc] = ss; }
            asm volatile("" ::: "memory"); }
    }
};
__device__ __forceinline__ float lg2_gamma_h(int h) {
    const float x = __builtin_amdgcn_exp2f(-5.0f - (float)h);
    const float l = -x * (1.0f + x * (0.5f + x * (0.33333334f + x * (0.25f + x * (0.2f + x * 0.16666667f)))));
    return l * 1.44269504f;
}
constexpr int GATE_PITCH = 2112;
typedef _Float16 h2_t __attribute__((ext_vector_type(2)));
struct EpiIn {
    static constexpr bool PERM = true, AFTER_DRAIN = false; static constexpr int NST = 8;
    bf16_t* O; size_t tstride; const unsigned* cs; const float* bgate; const float* ssq; PG8_LAS float* rsl; mutable int cpm; float* sgst;
    __device__ __forceinline__ void operator()(const f32x4 (&acc)[2][2][4][2], const Unit& u, int wr, int wc, int fr, int fq) const {
        const int t = ((u.pn >> 3) + 3) & 7, hh = u.pn & 7;
        bf16_t* base = O + (size_t)t * tstride;
        const int row0 = u.pm * BM + wr * 64 + fr, cw = wc * 32 + 8 * fq, col0 = hh * BM + cw;
        PG8_LAS float* my = rsl + (wr * 4 + wc) * 128 + fr;
        if (u.pm != cpm) { cpm = u.pm;
#pragma unroll
            for (int ai = 0; ai < 2; ++ai)
#pragma unroll
                for (int m = 0; m < 4; ++m) { const float r = row_rs(ssq, row0 + ai * HALF + m * 16, fq); if (fq == 0) my[(ai * 4 + m) * 16] = r; } }
        if (t <= 1) {
            const float sc = (t == 1) ? 0.0625f : 1.0f, lgs = (t == 1) ? -lg2_gamma_h(hh) : lg2_gamma_h(hh);
#pragma unroll
            for (int ai = 0; ai < 2; ++ai) {
                u32x4 cv[4][2];
#pragma unroll
                for (int m = 0; m < 4; ++m) { const u32x4* cp = (const u32x4*)(cs + ((size_t)(row0 + ai * HALF + m * 16) * 128 + cw));
                    cv[m][0] = cp[0]; cv[m][1] = cp[1]; }
#pragma unroll
                for (int m = 0; m < 4; ++m) { const int row = row0 + ai * HALF + m * 16;
                    int rl = row; asm volatile("" : "+v"(rl));
                    const float rs = my[(ai * 4 + m) * 16] * sc * __builtin_amdgcn_exp2f((float)((rl & 127) + 1) * lgs);
                    const f32x4 xa0 = acc[ai][0][m][0] * rs, xa1 = acc[ai][0][m][1] * rs, xb0 = acc[ai][1][m][0] * rs, xb1 = acc[ai][1][m][1] * rs;
                    const unsigned cw8[8] = {cv[m][0].x, cv[m][0].y, cv[m][0].z, cv[m][0].w, cv[m][1].x, cv[m][1].y, cv[m][1].z, cv[m][1].w};
                    float co[8], si[8];
#pragma unroll
                    for (int j = 0; j < 8; ++j) { const h2_t hv = __builtin_bit_cast(h2_t, cw8[j]); co[j] = (float)hv.x; si[j] = (float)hv.y; }
                    const float x1[8] = {xa0[0], xa0[1], xa0[2], xa0[3], xa1[0], xa1[1], xa1[2], xa1[3]};
                    const float x2[8] = {xb0[0], xb0[1], xb0[2], xb0[3], xb1[0], xb1[1], xb1[2], xb1[3]};
                    float o1[8], o2[8];
#pragma unroll
                    for (int j = 0; j < 8; ++j) { o1[j] = x1[j] * co[j] - x2[j] * si[j]; o2[j] = x1[j] * si[j] + x2[j] * co[j]; }
                    u32x4 w1, w2;
                    w1.x = cvt_pk_bf16(o1[0], o1[1]); w1.y = cvt_pk_bf16(o1[2], o1[3]); w1.z = cvt_pk_bf16(o1[4], o1[5]); w1.w = cvt_pk_bf16(o1[6], o1[7]);
                    w2.x = cvt_pk_bf16(o2[0], o2[1]); w2.y = cvt_pk_bf16(o2[2], o2[3]); w2.z = cvt_pk_bf16(o2[4], o2[5]); w2.w = cvt_pk_bf16(o2[6], o2[7]);
                    bf16_t* rowp = base + (size_t)row * LDT + col0;
                    *(u32x4*)rowp = w1; *(u32x4*)(rowp + HALF) = w2; }
                asm volatile("" ::: "memory"); }
        } else if (t == 2) other<2>(acc, base, row0, col0, my, t, hh, wc, fq);
        else if (t == 3) other<3>(acc, base, row0, col0, my, t, hh, wc, fq);
        else if (t == 4) other<4>(acc, base, row0, col0, my, t, hh, wc, fq);
        else if (t == 5) other<5>(acc, base, row0, col0, my, t, hh, wc, fq);
        else other<6>(acc, base, row0, col0, my, t, hh, wc, fq);
    }
    template <int TT> __device__ __forceinline__ void other(const f32x4 (&acc)[2][2][4][2], bf16_t* base, int row0, int col0, PG8_LAS float* my, int t, int hh, int wc, int fq) const {
        asm volatile("" : "+v"(row0), "+v"(col0), "+v"(fq));
        f32x4 bv[2][2];
#pragma unroll
        for (int bj = 0; bj < 2; ++bj)
#pragma unroll
            for (int n = 0; n < 2; ++n) bv[bj][n] = (TT >= 6) ? *(const f32x4*)(bgate + (t - 6) * 2048 + col0 + bj * HALF + 4 * n) : (f32x4){0.f, 0.f, 0.f, 0.f};
#pragma unroll
        for (int ai = 0; ai < 2; ++ai)
#pragma unroll
            for (int m = 0; m < 4; ++m) { bf16_t* rowp = base + (size_t)(row0 + ai * HALF + m * 16) * LDT + col0;
                const float rs = my[(ai * 4 + m) * 16]; float ps = 0.f, pq = 0.f; u32x4 gq = {0u, 0u, 0u, 0u};
#pragma unroll
                for (int bj = 0; bj < 2; ++bj) { f32x4 v0 = acc[ai][bj][m][0] * rs + bv[bj][0], v1 = acc[ai][bj][m][1] * rs + bv[bj][1];
                    if (TT == 3) {
#pragma unroll
                        for (int j = 0; j < 4; ++j) { v0[j] = silu_f(v0[j]); v1[j] = silu_f(v1[j]); } }
                    else if (TT == 4 || TT == 5) { f32x2 a = gelu_pk((f32x2){v0[0], v0[1]}), b = gelu_pk((f32x2){v0[2], v0[3]}), c = gelu_pk((f32x2){v1[0], v1[1]}), d = gelu_pk((f32x2){v1[2], v1[3]});
                        v0 = (f32x4){a.x, a.y, b.x, b.y}; v1 = (f32x4){c.x, c.y, d.x, d.y};
                        if (TT == 5) { ps += ((v0[0] + v0[1]) + (v0[2] + v0[3])) + ((v1[0] + v1[1]) + (v1[2] + v1[3]));
                            pq += ((v0[0] * v0[0] + v0[1] * v0[1]) + (v0[2] * v0[2] + v0[3] * v0[3])) + ((v1[0] * v1[0] + v1[1] * v1[1]) + (v1[2] * v1[2] + v1[3] * v1[3])); } }
                    else if (TT >= 6) {
#pragma unroll
                        for (int j = 0; j < 4; ++j) { v0[j] = sigmoid_f(v0[j]); v1[j] = sigmoid_f(v1[j]); } }
                    if (TT >= 6) { unsigned b0 = 0u, b1 = 0u;
#pragma unroll
                        for (int j = 0; j < 4; ++j) { b0 = __builtin_amdgcn_cvt_pk_u8_f32(__builtin_rintf(v0[j] * 255.0f), j, b0); b1 = __builtin_amdgcn_cvt_pk_u8_f32(__builtin_rintf(v1[j] * 255.0f), j, b1); }
                        if (bj == 0) { gq.x = b0; gq.y = b1; } else { gq.z = b0; gq.w = b1; } }
                    else { u32x4 w; w.x = cvt_pk_bf16(v0[0], v0[1]); w.y = cvt_pk_bf16(v0[2], v0[3]); w.z = cvt_pk_bf16(v1[0], v1[1]); w.w = cvt_pk_bf16(v1[2], v1[3]);
                        *(u32x4*)(rowp + bj * HALF) = w; } }
                if (TT >= 6) *(u32x4*)((unsigned char*)base + (size_t)(row0 + ai * HALF + m * 16) * GATE_PITCH + hh * 256 + (wc * 4 + fq) * 16) = gq;
                if (TT == 5) { ps += __shfl_xor(ps, 16); pq += __shfl_xor(pq, 16); ps += __shfl_xor(ps, 32); pq += __shfl_xor(pq, 32);
                    if (fq == 0) *(f32x2*)(sgst + ((size_t)((row0 + ai * HALF + m * 16) * 8 + hh) * 4 + wc) * 2) = (f32x2){ps, pq}; } }
    }
};
template <int MODE> struct EpiBr {
    static constexpr bool PERM = true, AFTER_DRAIN = false; static constexpr int NST = 0;
    bf16_t* T; const bf16_t* gate; const bf16_t* gate2;
    __device__ __forceinline__ void operator()(const f32x4 (&acc)[2][2][4][2], const Unit& u, int wr, int wc, int fr, int fq) const {
        const int row0 = u.pm * BM + wr * 64 + fr, col0 = u.pn * BM + wc * 32 + 8 * fq;
        const bool addp = (MODE == 1) || (MODE == 2 && u.z != 0); const bf16_t* const gt = (MODE == 2 && u.z != 0) ? gate2 : gate;
#pragma unroll
        for (int ai = 0; ai < 2; ++ai) {
            u32x4 gv[4], pv[4][2];
#pragma unroll
            for (int m = 0; m < 4; ++m) { gv[m] = *(const u32x4*)((const unsigned char*)gt + (size_t)(row0 + ai * HALF + m * 16) * GATE_PITCH + u.pn * 256 + (wc * 4 + fq) * 16);
#pragma unroll
                for (int bj = 0; bj < 2; ++bj) { const size_t off = (size_t)(row0 + ai * HALF + m * 16) * LDT + col0 + bj * HALF;
                    pv[m][bj] = addp ? *(const u32x4*)(T + off) : (u32x4){0u, 0u, 0u, 0u}; } }
#pragma unroll
            for (int m = 0; m < 4; ++m)
#pragma unroll
                for (int bj = 0; bj < 2; ++bj) { const size_t off = (size_t)(row0 + ai * HALF + m * 16) * LDT + col0 + bj * HALF; const unsigned g0 = bj ? gv[m].z : gv[m].x, g1 = bj ? gv[m].w : gv[m].y;
                    const f32x4 a0 = acc[ai][bj][m][0] * (1.0f / 255.0f), a1 = acc[ai][bj][m][1] * (1.0f / 255.0f);
                    float o[8] = {a0[0] * (float)(g0 & 255u), a0[1] * (float)((g0 >> 8) & 255u), a0[2] * (float)((g0 >> 16) & 255u), a0[3] * (float)(g0 >> 24), a1[0] * (float)(g1 & 255u), a1[1] * (float)((g1 >> 8) & 255u), a1[2] * (float)((g1 >> 16) & 255u), a1[3] * (float)(g1 >> 24)};
                    { const u32x4 pw = pv[m][bj];
                        o[0] += bf_lo(pw.x); o[1] += bf_hi(pw.x); o[2] += bf_lo(pw.y); o[3] += bf_hi(pw.y); o[4] += bf_lo(pw.z); o[5] += bf_hi(pw.z); o[6] += bf_lo(pw.w); o[7] += bf_hi(pw.w); }
                    u32x4 w; w.x = cvt_pk_bf16(o[0], o[1]); w.y = cvt_pk_bf16(o[2], o[3]); w.z = cvt_pk_bf16(o[4], o[5]); w.w = cvt_pk_bf16(o[6], o[7]);
                    *(u32x4*)(T + off) = w; }
            asm volatile("" ::: "memory"); }
    }
};
template <class Epi, class Sched, bool ALIGN_EPI = false, bool SP2 = false>
__device__ __forceinline__ void gemm_phase(PG8_LAS unsigned char* lds, const Gemm g, const Sched& S, const Epi& E) {
    int tid_l = threadIdx.x; asm volatile("" : "+v"(tid_l));
    const int tid = tid_l, wid = __builtin_amdgcn_readfirstlane(tid >> 6), lane = tid & 63, wr = wid >> 2, wc = wid & 3, fr = lane & 15, fq = lane >> 4;
    const int K = g.K, nt = K / BK;
    unsigned voffA, voffB;
    { int R, C; stage_rc(tid * 16, R, C); const int Rb = Epi::PERM ? ((R & ~31) + perm32(R & 31)) : R;
        voffA = (unsigned)(R * g.lda + C) * 2u; voffB = (unsigned)(Rb * g.ldb + C) * 2u; }
    const size_t voffA_step = (size_t)64 * g.lda * 2, voffB_step = (size_t)64 * g.ldb * 2;
    const size_t kstep = (size_t)(BK * 2);
    const size_t hstepA = (size_t)HALF * g.lda * 2, hstepB = (size_t)HALF * g.ldb * 2;
    const size_t tstepA = 2 * hstepA, tstepB = 2 * hstepB;
    const unsigned ldsw = (unsigned)wid * 1024u;
    const int aoff = lds_byte(wr * 64 + fr, fq * 8), boff = lds_byte(wc * 32 + fr, fq * 8);
#define PG8_SA(b, h) (((b) * 2 + (h)) * HTB)
#define PG8_SB(b, h) ((4 + (b) * 2 + (h)) * HTB)
#define PG8_STAGE(bufoff, gbase, voff) do { _Pragma("unroll") for (int _i = 0; _i < 2; ++_i) \
        __builtin_amdgcn_global_load_lds((const unsigned*)((const char*)(gbase) + _i * voff##_step + (voff)), (PG8_LAS unsigned*)(lds + (bufoff) + ldsw + _i * 8192), 16, 0, 0); } while (0)
#define PG8_LDA(dst, b, h) do { _Pragma("unroll") for (int m = 0; m < 4; ++m) _Pragma("unroll") for (int k = 0; k < 2; ++k) dst[m][k] = *(const PG8_LAS bf16x8*)(lds + PG8_SA(b, h) + aoff + m * 2048 + k * 1024); } while (0)
#define PG8_LDB(dst, b, h) do { _Pragma("unroll") for (int n = 0; n < 2; ++n) _Pragma("unroll") for (int k = 0; k < 2; ++k) dst[n][k] = *(const PG8_LAS bf16x8*)(lds + PG8_SB(b, h) + boff + n * 2048 + k * 1024); } while (0)
#define PG8_MMA(ai, bj, At, Bt) do { __builtin_amdgcn_s_setprio(1); _Pragma("unroll") for (int m = 0; m < 4; ++m) _Pragma("unroll") for (int n = 0; n < 2; ++n) _Pragma("unroll") for (int k = 0; k < 2; ++k) \
        acc[ai][bj][m][n] = __builtin_amdgcn_mfma_f32_16x16x32_bf16(Bt[n][k], At[m][k], acc[ai][bj][m][n], 0, 0, 0); __builtin_amdgcn_s_setprio(0); } while (0)
#define PG8_MMAZ(ai, bj, At, Bt) do { __builtin_amdgcn_s_setprio(1); _Pragma("unroll") for (int m = 0; m < 4; ++m) _Pragma("unroll") for (int n = 0; n < 2; ++n) { \
        acc[ai][bj][m][n] = __builtin_amdgcn_mfma_f32_16x16x32_bf16(Bt[n][0], At[m][0], (f32x4){0.f, 0.f, 0.f, 0.f}, 0, 0, 0); \
        acc[ai][bj][m][n] = __builtin_amdgcn_mfma_f32_16x16x32_bf16(Bt[n][1], At[m][1], acc[ai][bj][m][n], 0, 0, 0); } __builtin_amdgcn_s_setprio(0); } while (0)
#define PG8_WAIT_V(n) asm volatile("s_waitcnt vmcnt(" #n ")" ::: "memory")
#define PG8_WAIT_L(n) asm volatile("s_waitcnt lgkmcnt(" #n ")" ::: "memory")
#define PG8_BAR __builtin_amdgcn_s_barrier()
#define PG8_SCHED __builtin_amdgcn_sched_barrier(0)
    Unit cur, nxt; int ui = 0;
    if (!S.next(0, cur)) return;
    f32x4 acc[2][2][4][2];
    if constexpr (!SP2) {
#pragma unroll
    for (int a = 0; a < 2; ++a)
#pragma unroll
        for (int b = 0; b < 2; ++b)
#pragma unroll
            for (int m = 0; m < 4; ++m)
#pragma unroll
                for (int n = 0; n < 2; ++n) acc[a][b][m][n] = (f32x4){0.f, 0.f, 0.f, 0.f};
    }
    bf16x8 At[4][2], B0[2][2], B1[2][2];
    const char* cA = (const char*)S.opA(g, cur) + (size_t)cur.pm * tstepA; const char* cB = (const char*)S.opB(g, cur) + (size_t)cur.pn * tstepB;
    S.a_ready(cur);
    if constexpr (SP2) {
        PG8_STAGE(PG8_SB(0, 0), cB, voffB); PG8_STAGE(PG8_SB(0, 1), cB + hstepB, voffB); PG8_STAGE(PG8_SA(0, 0), cA, voffA); PG8_STAGE(PG8_SA(0, 1), cA + hstepA, voffA);
        if (wr == 1) PG8_BAR;
        PG8_WAIT_V(2); PG8_BAR;
        PG8_STAGE(PG8_SB(1, 0), cB + kstep, voffB); PG8_STAGE(PG8_SA(1, 0), cA + kstep, voffA); PG8_STAGE(PG8_SB(1, 1), cB + hstepB + kstep, voffB);
        if (Epi::NST > 0) PG8_WAIT_V(0); else PG8_WAIT_V(6);
        PG8_BAR;
    } else {
        PG8_STAGE(PG8_SB(0, 0), cB, voffB); PG8_STAGE(PG8_SA(0, 0), cA, voffA); PG8_STAGE(PG8_SB(0, 1), cB + hstepB, voffB); PG8_STAGE(PG8_SA(0, 1), cA + hstepA, voffA);
        if (wr == 1) PG8_BAR;
        PG8_WAIT_V(4); PG8_BAR;
        PG8_STAGE(PG8_SB(1, 0), cB + kstep, voffB); PG8_STAGE(PG8_SA(1, 0), cA + kstep, voffA); PG8_STAGE(PG8_SB(1, 1), cB + hstepB + kstep, voffB);
        PG8_WAIT_V(6); PG8_BAR;
    }
    for (;;) {
        const bool has_next = S.next(ui + 1, nxt);
        const char* nA = has_next ? (const char*)S.opA(g, nxt) + (size_t)nxt.pm * tstepA : cA; const char* nB = has_next ? (const char*)S.opB(g, nxt) + (size_t)nxt.pn * tstepB : cB;
#define PG8_TRIP_HEAD(T) const int t = (T); const bool last = (t == nt - 2); \
            const char* a1 = cA + (size_t)(t + 1) * kstep; \
            const char* a2 = last ? nA : cA + (size_t)(t + 2) * kstep; const char* b2 = last ? nB : cB + (size_t)(t + 2) * kstep; \
            const char* a3 = a2 + kstep; const char* b3 = b2 + kstep; \
            if (last && has_next) S.a_ready(nxt);
#define PG8_TRIP_SP2(W12, MM0) \
            PG8_LDB(B0, 0, 0); PG8_LDB(B1, 0, 1); PG8_SCHED; PG8_LDA(At, 0, 0); PG8_STAGE(PG8_SA(1, 1), a1 + hstepA, voffA); \
            W12; PG8_WAIT_L(0); PG8_BAR; MM0(0, 0, At, B0); MM0(0, 1, At, B1); PG8_BAR; PG8_SCHED; \
            PG8_LDA(At, 0, 1); PG8_STAGE(PG8_SB(0, 0), b2, voffB); PG8_STAGE(PG8_SB(0, 1), b2 + hstepB, voffB); PG8_STAGE(PG8_SA(0, 0), a2, voffA); \
            W12; PG8_WAIT_L(0); PG8_BAR; MM0(1, 0, At, B0); MM0(1, 1, At, B1); PG8_BAR; PG8_SCHED; \
            PG8_LDB(B0, 1, 0); PG8_LDB(B1, 1, 1); PG8_SCHED; PG8_LDA(At, 1, 0); PG8_STAGE(PG8_SA(0, 1), a2 + hstepA, voffA); \
            PG8_WAIT_V(8); PG8_WAIT_L(0); PG8_BAR; PG8_MMA(0, 0, At, B0); PG8_MMA(0, 1, At, B1); PG8_BAR; PG8_SCHED; \
            PG8_LDA(At, 1, 1); PG8_STAGE(PG8_SB(1, 0), b3, voffB); PG8_STAGE(PG8_SB(1, 1), b3 + hstepB, voffB); PG8_STAGE(PG8_SA(1, 0), a3, voffA); \
            PG8_WAIT_V(8); PG8_WAIT_L(0); PG8_BAR; PG8_MMA(1, 0, At, B0); PG8_MMA(1, 1, At, B1); PG8_BAR; PG8_SCHED;
        if constexpr (SP2) {
            { PG8_TRIP_HEAD(0) PG8_TRIP_SP2(asm volatile("s_waitcnt vmcnt(%0)" :: "n"(8 + Epi::NST) : "memory"), PG8_MMAZ) }
            for (int tt = 2; tt < nt; tt += 2) { PG8_TRIP_HEAD(tt) PG8_TRIP_SP2(PG8_WAIT_V(8), PG8_MMA) }
        } else {
        for (int tt = 0; tt < nt; tt += 2) { PG8_TRIP_HEAD(tt)
            PG8_LDB(B0, 0, 0); PG8_SCHED; PG8_LDA(At, 0, 0); PG8_STAGE(PG8_SA(1, 1), a1 + hstepA, voffA);
            PG8_WAIT_L(8); PG8_BAR; PG8_WAIT_L(0); PG8_MMA(0, 0, At, B0); PG8_BAR; PG8_SCHED;
            PG8_LDB(B1, 0, 1); PG8_STAGE(PG8_SB(0, 0), b2, voffB);
            PG8_BAR; PG8_WAIT_L(0); PG8_MMA(0, 1, At, B1); PG8_BAR;
            PG8_LDA(At, 0, 1); PG8_STAGE(PG8_SA(0, 0), a2, voffA);
            PG8_BAR; PG8_WAIT_L(0); PG8_MMA(1, 0, At, B0); PG8_BAR; PG8_SCHED;
            PG8_STAGE(PG8_SB(0, 1), b2 + hstepB, voffB);
            PG8_WAIT_V(6); PG8_BAR; PG8_MMA(1, 1, At, B1); PG8_BAR;
            PG8_LDB(B0, 1, 0); PG8_SCHED; PG8_LDA(At, 1, 0); PG8_STAGE(PG8_SA(0, 1), a2 + hstepA, voffA);
            PG8_WAIT_L(8); PG8_BAR; PG8_WAIT_L(0); PG8_MMA(0, 0, At, B0); PG8_BAR; PG8_SCHED;
            PG8_LDB(B1, 1, 1); PG8_STAGE(PG8_SB(1, 0), b3, voffB);
            PG8_BAR; PG8_WAIT_L(0); PG8_MMA(0, 1, At, B1); PG8_BAR;
            PG8_LDA(At, 1, 1); PG8_STAGE(PG8_SA(1, 0), a3, voffA);
            PG8_BAR; PG8_WAIT_L(0); PG8_MMA(1, 0, At, B0); PG8_BAR; PG8_SCHED;
            PG8_STAGE(PG8_SB(1, 1), b3 + hstepB, voffB);
            PG8_WAIT_V(6); PG8_BAR; PG8_MMA(1, 1, At, B1); PG8_BAR;
        }
        }
#undef PG8_TRIP_HEAD
#undef PG8_TRIP_SP2
        if constexpr (ALIGN_EPI) { if (wr == 0) PG8_BAR; }
        if constexpr (!Epi::AFTER_DRAIN) { E(acc, cur, wr, wc, fr, fq); S.done(cur); }
        if (!has_next) break;
        if constexpr (!SP2) {
#pragma unroll
        for (int a = 0; a < 2; ++a)
#pragma unroll
            for (int b = 0; b < 2; ++b)
#pragma unroll
                for (int m = 0; m < 4; ++m)
#pragma unroll
                    for (int n = 0; n < 2; ++n) acc[a][b][m][n] = (f32x4){0.f, 0.f, 0.f, 0.f};
        }
        cur = nxt; cA = nA; cB = nB; ++ui;
        if constexpr (ALIGN_EPI) { if (wr == 1) PG8_BAR; }
    }
    PG8_WAIT_V(0);
    if constexpr (!ALIGN_EPI) { if (wr == 0) PG8_BAR; }
    PG8_BAR;
    if constexpr (Epi::AFTER_DRAIN) { E.fused(acc, cur, wr, wc, fr, fq, lds, wid, lane); S.done(cur); }
#undef PG8_SA
#undef PG8_SB
#undef PG8_STAGE
#undef PG8_LDA
#undef PG8_LDB
#undef PG8_MMA
#undef PG8_MMAZ
#undef PG8_WAIT_V
#undef PG8_WAIT_L
#undef PG8_BAR
#undef PG8_SCHED
}
}
#define GAS __attribute__((address_space(1)))
#define LAS __attribute__((address_space(3)))
typedef unsigned short bf16;
typedef unsigned v4u __attribute__((ext_vector_type(4)));
typedef float f32x4 __attribute__((ext_vector_type(4)));
typedef short bf16x8 __attribute__((ext_vector_type(8)));
typedef GAS unsigned gu32;
typedef GAS unsigned long long gu64;
#define RLX_AGENT __ATOMIC_RELAXED, __HIP_MEMORY_SCOPE_AGENT
#define LDS_WAIT() asm volatile("s_waitcnt lgkmcnt(0)" ::: "memory")
#define VM_WAIT() asm volatile("s_waitcnt vmcnt(0)" ::: "memory")
__device__ __forceinline__ unsigned long long rt() { return __builtin_amdgcn_s_memrealtime(); }
__device__ __forceinline__ unsigned f2bf(float f) { unsigned u = __builtin_bit_cast(unsigned, f); return (u + 0x7fffu + ((u >> 16) & 1u)) >> 16; }
__device__ __forceinline__ unsigned pk2(float lo, float hi) { return f2bf(lo) | (f2bf(hi) << 16); }
#define XB_TMO      128
#define XB_XCNT(j)  (256  + 64 * (j))
#define XB_XSUB(j)  (1280 + 64 * (j))
#define XB_XGEN(j)  (2304 + 64 * (j))
#define XB_TOP      3328
#define XB_TOPGEN   3392
#define XCD_BAR_WORDS 3456
#define XB_SPIN_CAP (1u << 18)

__device__ __forceinline__ unsigned xb_ld(unsigned* p)              { return __hip_atomic_load(p, __ATOMIC_RELAXED, __HIP_MEMORY_SCOPE_AGENT); }
__device__ __forceinline__ unsigned xb_add(unsigned* p, unsigned v) { return __hip_atomic_fetch_add(p, v, __ATOMIC_RELAXED, __HIP_MEMORY_SCOPE_AGENT); }
__device__ __forceinline__ unsigned xb_xcc_id() { return (unsigned)__builtin_amdgcn_s_getreg((3 << 11) | 20) & 0xFu; }
#define XB_SPIN(cond, bar) do { unsigned _sp = 0; while (cond) { __builtin_amdgcn_s_sleep(1); \
    if ((++_sp & 255u) == 0u) { if (xb_ld(&(bar)[XB_TMO])) break; if (_sp > XB_SPIN_CAP) { atomicAdd(&(bar)[XB_TMO], 1u); break; } } } } while (0)

struct XcdBarrier {
    unsigned* bar; unsigned x;
    volatile LAS unsigned* st;
};

__device__ __forceinline__ XcdBarrier xcd_barrier_post(unsigned* bar, volatile LAS unsigned* st) {
    XcdBarrier b; b.bar = bar; b.x = xb_xcc_id(); b.st = st;
    if (threadIdx.x == 0) (void)xb_add(&bar[XB_XCNT(b.x)], 1u);
    return b;
}
__device__ __forceinline__ void xcd_barrier_complete(unsigned* bar, unsigned x, unsigned& nloc, unsigned& nx) {
    const unsigned G = gridDim.x * gridDim.y * gridDim.z;
    unsigned sum, cnt, mine, sp = 0u;
    for (;;) {
        sum = 0u; cnt = 0u; mine = 0u;
#pragma unroll
        for (unsigned j = 0; j < 16; ++j) { const unsigned c = xb_ld(&bar[XB_XCNT(j)]); sum += c; cnt += (c > 0u) ? 1u : 0u; mine = (j == x) ? c : mine; }
        if (sum == G) break;
        __builtin_amdgcn_s_sleep(1);
        if ((++sp & 255u) == 0u) { if (xb_ld(&bar[XB_TMO])) break; if (sp > XB_SPIN_CAP) { atomicAdd(&bar[XB_TMO], 1u); break; } }
    }
    nloc = mine > 0u ? mine : 1u; nx = cnt > 0u ? cnt : 1u;
}

__device__ __forceinline__ void xcd_barrier(const XcdBarrier& b) {
    asm volatile("s_waitcnt vmcnt(0)" ::: "memory");
    __syncthreads();
    if (threadIdx.x == 0) {
        unsigned* bar = b.bar; const unsigned bx_ = xb_xcc_id();
        __builtin_amdgcn_s_waitcnt(0);
        unsigned nloc = b.st[0], nx = b.st[1];
        if (nloc == 0u) { xcd_barrier_complete(bar, bx_, nloc, nx); b.st[0] = nloc; b.st[1] = nx; }
        const unsigned old = xb_add(&bar[XB_XSUB(bx_)], 1u);
        const unsigned gen = old / nloc;
        if (old + 1u == (gen + 1u) * nloc) {
            __builtin_amdgcn_fence(__ATOMIC_RELEASE, "agent");
            asm volatile("s_waitcnt vmcnt(0)" ::: "memory");
            const unsigned og = xb_add(&bar[XB_TOP], 1u);
            const unsigned tg = og / nx;
            if (og + 1u == (tg + 1u) * nx) xb_add(&bar[XB_TOPGEN], 1u);
            else XB_SPIN(xb_ld(&bar[XB_TOPGEN]) == tg, bar);
            __builtin_amdgcn_fence(__ATOMIC_ACQUIRE, "agent");
            xb_add(&bar[XB_XGEN(bx_)], 1u);
            asm volatile("s_waitcnt vmcnt(0)" ::: "memory");
        } else {
            XB_SPIN(xb_ld(&bar[XB_XGEN(bx_)]) == gen, bar);
            __builtin_amdgcn_fence(__ATOMIC_ACQUIRE, "agent");
            asm volatile("s_waitcnt vmcnt(0)" ::: "memory");
        }
    }
    __syncthreads();
}

constexpr int NWAVES = 8;
constexpr int BATCH = 4, SEQ = 8192, D = 2048, DEPTH = 4, HEADS = 8, FF = 5632, INCOLS = 16384, NCHUNK = SEQ / 128;
constexpr int M = BATCH * SEQ;
constexpr float EPS = 1e-6f;
constexpr size_t MiB = 1u << 20;
constexpr size_t WS_CTL = 0, CTL_ZERO_BYTES = 1 * MiB;
constexpr size_t WS_CS = 1 * MiB;
constexpr size_t WS_WMASK = 33 * MiB;
constexpr size_t WS_WGU1 = 34 * MiB, WS_WD1 = 78 * MiB, WS_WIN = 100 * MiB, WS_WBR = 164 * MiB, WS_WBS = 172 * MiB, WS_WOUT = 180 * MiB, WS_WGU2 = 188 * MiB, WS_WD2 = 232 * MiB;
constexpr size_t WS_H = 256 * MiB;
constexpr size_t WS_BIG = 392 * MiB;
constexpr size_t WS_RT = 1452 * MiB;
constexpr size_t WS_SGST = WS_RT + 96 * MiB;
constexpr size_t WS_OPRE = WS_RT + 112 * MiB;
constexpr size_t WS_END = 1708 * MiB;
constexpr int LDT = pg8::LDT;
constexpr size_t TSTRIDE = (size_t)M * LDT;
constexpr int CW_BAR = 4096;
constexpr size_t WS_SSQ = WS_RT + 32 * MiB, SSQ_STRIDE = (size_t)M * 32;
constexpr int RING_BYTES = 131072;
constexpr int LDSCTL_OFF = RING_BYTES, MISC_OFF = LDSCTL_OFF + 320;
constexpr int RS_OFF = RING_BYTES + 1024;
constexpr int LDS_BYTES = 147456;

typedef short s16x4 __attribute__((ext_vector_type(4)));
typedef short v4i16_t __attribute__((ext_vector_type(4)));
typedef unsigned u32x2 __attribute__((ext_vector_type(2)));
typedef float f32x2v __attribute__((ext_vector_type(2)));

__device__ __forceinline__ float wave_sum(float v) {
#pragma unroll
    for (int o = 1; o < 64; o <<= 1) v += __shfl_xor(v, o);
    return v;
}
typedef float f32x2_t __attribute__((ext_vector_type(2))); typedef __bf16 bf16x2_t __attribute__((ext_vector_type(2)));
__device__ __forceinline__ unsigned cvtpk(float lo, float hi) { f32x2_t v = {lo, hi}; bf16x2_t b = __builtin_convertvector(v, bf16x2_t); return __builtin_bit_cast(unsigned, b); }
__device__ __forceinline__ float bflo(unsigned u) { return __uint_as_float(u << 16); }
__device__ __forceinline__ float bfhi(unsigned u) { return __uint_as_float(u & 0xffff0000u); }
__device__ __forceinline__ s16x4 vtr(const LAS unsigned char* p) { return __builtin_bit_cast(s16x4, __builtin_amdgcn_ds_read_tr16_b64_v4i16((LAS v4i16_t*)p)); }
__device__ __forceinline__ bf16x8 lds_tr_frag(const LAS unsigned char* tile, int strideB, int k0, int c0, int lane) {
    const int g = lane >> 4, q = (lane & 15) >> 2, p = lane & 3;
    const LAS unsigned char* a = tile + (k0 + 8 * g + q) * strideB + (c0 + 4 * p) * 2;
    const s16x4 lo = vtr(a), hi = vtr(a + 4 * strideB);
    return __builtin_shufflevector(lo, hi, 0, 1, 2, 3, 4, 5, 6, 7);
}
__device__ __forceinline__ bf16x8 lds_tr_frag_c(const LAS unsigned char* tile, int strideB, int k0, int c0, int lane) {
    const int g = lane >> 4, q = (lane & 15) >> 2, p = lane & 3;
    const LAS unsigned char* a = tile + (k0 + 4 * g + q) * strideB + (c0 + 4 * p) * 2;
    const s16x4 lo = vtr(a), hi = vtr(a + 16 * strideB);
    return __builtin_shufflevector(lo, hi, 0, 1, 2, 3, 4, 5, 6, 7);
}
#define MFMA16(a, b, c) __builtin_amdgcn_mfma_f32_16x16x32_bf16((a), (b), (c), 0, 0, 0)
__device__ __forceinline__ float log2_gamma(int h) {
    const float x = __builtin_amdgcn_exp2f(-5.0f - (float)h);
    const float l = -x * (1.0f + x * (0.5f + x * (0.33333334f + x * (0.25f + x * (0.2f + x * 0.16666667f)))));
    return l * 1.44269504f;
}

__device__ __forceinline__ void conv_item(const float* W, int K, int N, bf16* WT, int mode, const float* gain, LAS float* scr, int item, int lane) {
    const int nblk = N / 32, kb = item / nblk, nb = item % nblk, k0 = 64 * kb, n0 = 32 * nb;
#pragma unroll
    for (int i = 0; i < 8; ++i) { const int kk = 8 * i + (lane >> 3), nn = 4 * (lane & 7);
        const f32x4 v = *(const f32x4*)(W + (size_t)(k0 + kk) * N + n0 + nn);
        LAS float* d = scr + kk * 33 + nn; d[0] = v[0]; d[1] = v[1]; d[2] = v[2]; d[3] = v[3]; }
    LDS_WAIT(); asm volatile("" ::: "memory");
    int r0 = n0;
    if (mode == 3) r0 = ((((n0 >> 11) + 5) & 7) << 11) + (n0 & 2047);
    if (mode == 1) { const int isg = n0 >= FF, j0 = isg ? n0 - FF : n0; r0 = 256 * (j0 >> 7) + (j0 & 127) + (isg ? 128 : 0); }
    const int c = lane & 7;
    f32x4 ga = {1.f, 1.f, 1.f, 1.f}, gb = {1.f, 1.f, 1.f, 1.f};
    if (gain) { ga = *(const f32x4*)(gain + k0 + 8 * c); gb = *(const f32x4*)(gain + k0 + 8 * c + 4); }
#pragma unroll
    for (int j = 0; j < 4; ++j) { const int n = (lane >> 3) + 8 * j; const LAS float* s = scr + (8 * c) * 33 + n;
        v4u o; o.x = pk2(s[0 * 33] * ga[0], s[1 * 33] * ga[1]); o.y = pk2(s[2 * 33] * ga[2], s[3 * 33] * ga[3]); o.z = pk2(s[4 * 33] * gb[0], s[5 * 33] * gb[1]); o.w = pk2(s[6 * 33] * gb[2], s[7 * 33] * gb[3]);
        *(GAS v4u*)(WT + (size_t)(r0 + n) * K + k0 + 8 * c) = o; }
    LDS_WAIT(); asm volatile("" ::: "memory");
}
struct ConvSrc { const float *gu1, *d1, *win, *br, *bs, *wo, *gu2, *d2, *sw, *g1, *gm, *g2; };
__device__ __forceinline__ void phase_conv(LAS unsigned char* lds, unsigned char* ws, const ConvSrc& s, int gw, int NGW, int wave, int lane) {
    asm volatile("" : "+v"(lane));
    LAS float* scr = (LAS float*)(lds + wave * 16384);
    constexpr int I_GU = (D / 64) * (2 * FF / 32), I_D = (FF / 64) * (D / 32), I_IN = (D / 64) * (INCOLS / 32), I_SQ = (D / 64) * (D / 32);
    constexpr int NITEMS = 2 * I_GU + 2 * I_D + I_IN + 3 * I_SQ;
    for (int it = gw; it < NITEMS; it += NGW) {
        int r = it;
        if (r < I_GU) { conv_item(s.gu1, D, 2 * FF, (bf16*)(ws + WS_WGU1), 1, s.g1, scr, r, lane); continue; } r -= I_GU;
        if (r < I_GU) { conv_item(s.gu2, D, 2 * FF, (bf16*)(ws + WS_WGU2), 1, s.g2, scr, r, lane); continue; } r -= I_GU;
        if (r < I_D) { conv_item(s.d1, FF, D, (bf16*)(ws + WS_WD1), 0, nullptr, scr, r, lane); continue; } r -= I_D;
        if (r < I_D) { conv_item(s.d2, FF, D, (bf16*)(ws + WS_WD2), 0, nullptr, scr, r, lane); continue; } r -= I_D;
        if (r < I_IN) { conv_item(s.win, D, INCOLS, (bf16*)(ws + WS_WIN), 3, s.gm, scr, r, lane); continue; } r -= I_IN;
        if (r < I_SQ) { conv_item(s.br, D, D, (bf16*)(ws + WS_WBR), 0, nullptr, scr, r, lane); continue; } r -= I_SQ;
        if (r < I_SQ) { conv_item(s.bs, D, D, (bf16*)(ws + WS_WBS), 0, nullptr, scr, r, lane); continue; } r -= I_SQ;
        conv_item(s.wo, D, D, (bf16*)(ws + WS_WOUT), 0, nullptr, scr, r, lane);
    }
    bf16* wm = (bf16*)(ws + WS_WMASK);
    for (int e = gw * 64 + lane; e < 8 * 128 * 128; e += NGW * 64) { const int j = e & 127, i = (e >> 7) & 127; wm[e] = (bf16)((j <= i) ? f2bf(s.sw[e]) : 0u); }
}
__device__ __forceinline__ void phase_final(const bf16* Xb, float* out, const float* gain, int gw, int NGW, int lane) {
    asm volatile("" : "+v"(lane));
    f32x4 g0[4], g1[4];
#pragma unroll
    for (int j = 0; j < 4; ++j) { g0[j] = *(const f32x4*)(gain + (lane + 64 * j) * 8); g1[j] = *(const f32x4*)(gain + (lane + 64 * j) * 8 + 4); }
    for (int m = gw; m < M; m += NGW) {
        const v4u* xr = (const v4u*)(Xb + (size_t)m * LDT) + lane;
        float x[4][8]; float s = 0.f;
#pragma unroll
        for (int j = 0; j < 4; ++j) { const v4u w = xr[64 * j];
            x[j][0] = bflo(w.x); x[j][1] = bfhi(w.x); x[j][2] = bflo(w.y); x[j][3] = bfhi(w.y); x[j][4] = bflo(w.z); x[j][5] = bfhi(w.z); x[j][6] = bflo(w.w); x[j][7] = bfhi(w.w);
#pragma unroll
            for (int e = 0; e < 8; ++e) s += x[j][e] * x[j][e]; }
        const float rs = 1.0f / sqrtf(wave_sum(s) * (1.0f / D) + EPS);
        float* orow = out + (size_t)m * D;
#pragma unroll
        for (int j = 0; j < 4; ++j) { f32x4 o0, o1;
            o0[0] = x[j][0] * rs * g0[j][0]; o0[1] = x[j][1] * rs * g0[j][1]; o0[2] = x[j][2] * rs * g0[j][2]; o0[3] = x[j][3] * rs * g0[j][3];
            o1[0] = x[j][4] * rs * g1[j][0]; o1[1] = x[j][5] * rs * g1[j][1]; o1[2] = x[j][6] * rs * g1[j][2]; o1[3] = x[j][7] * rs * g1[j][3];
            *(f32x4*)(orow + (lane + 64 * j) * 8) = o0; *(f32x4*)(orow + (lane + 64 * j) * 8 + 4) = o1; }
    }
}
#define LDS_BARRIER() do { asm volatile("s_waitcnt lgkmcnt(0)" ::: "memory"); __builtin_amdgcn_s_barrier(); asm volatile("" ::: "memory"); } while (0)
__device__ __forceinline__ bf16x8 lds_tr_pair(const LAS unsigned char* tile, int strideB, int r0, int r1, int c0, int lane) {
    const int q = (lane & 15) >> 2, p = lane & 3;
    const s16x4 lo = vtr(tile + (r0 + q) * strideB + (c0 + 4 * p) * 2), hi = vtr(tile + (r1 + q) * strideB + (c0 + 4 * p) * 2);
    return __builtin_shufflevector(lo, hi, 0, 1, 2, 3, 4, 5, 6, 7);
}
__device__ __forceinline__ void phase_ret(LAS unsigned char* lds, const bf16* Q, const bf16* Kb, const bf16* V, bf16* Opre, float* stats, int vcu, int G, int tid) {
    asm volatile("" : "+v"(tid));
    const int lane = tid & 63, w = __builtin_amdgcn_readfirstlane(tid >> 6), i16 = lane & 15, g4 = lane >> 4;
    const int ib = (w < 4) ? w : 11 - w;
    LAS unsigned char* K_t = lds;
    LAS unsigned char* V_t = lds + 69632;
    LAS unsigned char* RT_t = lds + 94208;
    for (int u = vcu; u < BATCH * HEADS * 8; u += G) {
        const int es = u & 7, h = (u >> 3) & 7, b = u >> 6, hc = h * 256;
        const float lg2 = log2_gamma(h), gamma_c = __builtin_amdgcn_exp2f(128.0f * lg2);
        const size_t tb = (size_t)b * SEQ;
        f32x4 r[2][2];
#pragma unroll
        for (int a = 0; a < 2; ++a)
#pragma unroll
            for (int c = 0; c < 2; ++c) r[a][c] = (f32x4){0.f, 0.f, 0.f, 0.f};
        { v4u zz = (v4u){0u, 0u, 0u, 0u}; asm volatile("" : "+v"(zz));
          int tz = tid; asm volatile("" : "+v"(tz));
          for (int c = tz; c < 17408 / 16; c += NWAVES * 64) *(LAS v4u*)(RT_t + c * 16) = zz; }
        v4u kpre[8], vpre;
        const bf16* kg = Kb + (tb + (tid >> 5)) * LDT + hc + (tid & 31) * 8;
        const bf16* vg = V + (tb + (tid >> 2)) * LDT + hc + 32 * es + (tid & 3) * 8;
        const bf16* qg = Q + (tb + 16 * ib + i16) * LDT + hc + 8 * g4;
#pragma unroll
        for (int k = 0; k < 8; ++k) kpre[k] = *(const v4u*)(kg + (size_t)k * 16 * LDT);
        vpre = *(const v4u*)vg;
        const int i = 16 * ib + i16;
        bf16x8 qf[8];
#pragma unroll
        for (int ks = 0; ks < 8; ++ks) qf[ks] = *(const bf16x8*)(qg + 32 * ks);
        for (int n = 0; n < NCHUNK; ++n) {
            LDS_BARRIER();
#pragma unroll
            for (int k = 0; k < 8; ++k) *(LAS v4u*)(K_t + ((tid >> 5) + 16 * k) * 544 + (tid & 31) * 16) = kpre[k];
            *(LAS v4u*)(V_t + (tid >> 2) * 96 + (tid & 3) * 16) = vpre;
            {
                const size_t adv = (size_t)((n + 1 < NCHUNK) ? n + 1 : n) * 128 * LDT;
#pragma unroll
                for (int k = 0; k < 8; ++k) kpre[k] = *(const v4u*)(kg + adv + (size_t)k * 16 * LDT);
                vpre = *(const v4u*)(vg + adv);
            }
            LDS_BARRIER();
            const LAS unsigned char* RT_c = RT_t + (n & 1) * 17408; LAS unsigned char* RT_n = RT_t + ((n & 1) ^ 1) * 17408;
#define RET_ST_BLOCK1(S0, AD) do { bf16x8 k0_, k1_, k2_, k3_, k4_, k5_, k6_, k7_; asm volatile( \
                "ds_read_b128 %[k0], %[ad] offset:0\n\t" \
                "ds_read_b128 %[k1], %[ad] offset:64\n\t" \
                "ds_read_b128 %[k2], %[ad] offset:128\n\t" \
                "ds_read_b128 %[k3], %[ad] offset:192\n\t" \
                "ds_read_b128 %[k4], %[ad] offset:256\n\t" \
                "ds_read_b128 %[k5], %[ad] offset:320\n\t" \
                "ds_read_b128 %[k6], %[ad] offset:384\n\t" \
                "ds_read_b128 %[k7], %[ad] offset:448\n\t" \
                "s_waitcnt lgkmcnt(7)\n\t" \
                "v_mfma_f32_16x16x32_bf16 %[s0], %[k0], %[q0], 0\n\t" \
                "s_waitcnt lgkmcnt(6)\n\t" \
                "v_mfma_f32_16x16x32_bf16 %[s0], %[k1], %[q1], %[s0]\n\t" \
                "s_waitcnt lgkmcnt(5)\n\t" \
                "v_mfma_f32_16x16x32_bf16 %[s0], %[k2], %[q2], %[s0]\n\t" \
                "s_waitcnt lgkmcnt(4)\n\t" \
                "v_mfma_f32_16x16x32_bf16 %[s0], %[k3], %[q3], %[s0]\n\t" \
                "s_waitcnt lgkmcnt(3)\n\t" \
                "v_mfma_f32_16x16x32_bf16 %[s0], %[k4], %[q4], %[s0]\n\t" \
                "s_waitcnt lgkmcnt(2)\n\t" \
                "v_mfma_f32_16x16x32_bf16 %[s0], %[k5], %[q5], %[s0]\n\t" \
                "s_waitcnt lgkmcnt(1)\n\t" \
                "v_mfma_f32_16x16x32_bf16 %[s0], %[k6], %[q6], %[s0]\n\t" \
                "s_waitcnt lgkmcnt(0)\n\t" \
                "v_mfma_f32_16x16x32_bf16 %[s0], %[k7], %[q7], %[s0]\n\t" \
                "s_nop 7\n\t" \
                "s_nop 7\n\t" \
                "s_nop 7\n\t" \
                : [s0] "=&v"(S0), [k0] "=&v"(k0_), [k1] "=&v"(k1_), [k2] "=&v"(k2_), [k3] "=&v"(k3_), [k4] "=&v"(k4_), [k5] "=&v"(k5_), [k6] "=&v"(k6_), [k7] "=&v"(k7_) \
                : [ad] "v"(AD), [q0] "v"(qf[0]), [q1] "v"(qf[1]), [q2] "v"(qf[2]), [q3] "v"(qf[3]), [q4] "v"(qf[4]), [q5] "v"(qf[5]), [q6] "v"(qf[6]), [q7] "v"(qf[7]) : "memory"); } while (0)
#define RET_ST_BLOCK2(S0, S1, AD) do { bf16x8 k0_, k1_, k2_, k3_, k4_, k5_, k6_, k7_; asm volatile( \
                "ds_read_b128 %[k0], %[ad] offset:0\n\t" \
                "ds_read_b128 %[k1], %[ad] offset:8704\n\t" \
                "ds_read_b128 %[k2], %[ad] offset:64\n\t" \
                "ds_read_b128 %[k3], %[ad] offset:8768\n\t" \
                "ds_read_b128 %[k4], %[ad] offset:128\n\t" \
                "ds_read_b128 %[k5], %[ad] offset:8832\n\t" \
                "ds_read_b128 %[k6], %[ad] offset:192\n\t" \
                "ds_read_b128 %[k7], %[ad] offset:8896\n\t" \
                "s_waitcnt lgkmcnt(7)\n\t" \
                "v_mfma_f32_16x16x32_bf16 %[s0], %[k0], %[q0], 0\n\t" \
                "ds_read_b128 %[k0], %[ad] offset:256\n\t" \
                "s_waitcnt lgkmcnt(7)\n\t" \
                "v_mfma_f32_16x16x32_bf16 %[s1], %[k1], %[q0], 0\n\t" \
                "ds_read_b128 %[k1], %[ad] offset:8960\n\t" \
                "s_waitcnt lgkmcnt(7)\n\t" \
                "v_mfma_f32_16x16x32_bf16 %[s0], %[k2], %[q1], %[s0]\n\t" \
                "ds_read_b128 %[k2], %[ad] offset:320\n\t" \
                "s_waitcnt lgkmcnt(7)\n\t" \
                "v_mfma_f32_16x16x32_bf16 %[s1], %[k3], %[q1], %[s1]\n\t" \
                "ds_read_b128 %[k3], %[ad] offset:9024\n\t" \
                "s_waitcnt lgkmcnt(7)\n\t" \
                "v_mfma_f32_16x16x32_bf16 %[s0], %[k4], %[q2], %[s0]\n\t" \
                "ds_read_b128 %[k4], %[ad] offset:384\n\t" \
                "s_waitcnt lgkmcnt(7)\n\t" \
                "v_mfma_f32_16x16x32_bf16 %[s1], %[k5], %[q2], %[s1]\n\t" \
                "ds_read_b128 %[k5], %[ad] offset:9088\n\t" \
                "s_waitcnt lgkmcnt(7)\n\t" \
                "v_mfma_f32_16x16x32_bf16 %[s0], %[k6], %[q3], %[s0]\n\t" \
                "ds_read_b128 %[k6], %[ad] offset:448\n\t" \
                "s_waitcnt lgkmcnt(7)\n\t" \
                "v_mfma_f32_16x16x32_bf16 %[s1], %[k7], %[q3], %[s1]\n\t" \
                "ds_read_b128 %[k7], %[ad] offset:9152\n\t" \
                "s_waitcnt lgkmcnt(7)\n\t" \
                "v_mfma_f32_16x16x32_bf16 %[s0], %[k0], %[q4], %[s0]\n\t" \
                "s_waitcnt lgkmcnt(6)\n\t" \
                "v_mfma_f32_16x16x32_bf16 %[s1], %[k1], %[q4], %[s1]\n\t" \
                "s_waitcnt lgkmcnt(5)\n\t" \
                "v_mfma_f32_16x16x32_bf16 %[s0], %[k2], %[q5], %[s0]\n\t" \
                "s_waitcnt lgkmcnt(4)\n\t" \
                "v_mfma_f32_16x16x32_bf16 %[s1], %[k3], %[q5], %[s1]\n\t" \
                "s_waitcnt lgkmcnt(3)\n\t" \
                "v_mfma_f32_16x16x32_bf16 %[s0], %[k4], %[q6], %[s0]\n\t" \
                "s_waitcnt lgkmcnt(2)\n\t" \
                "v_mfma_f32_16x16x32_bf16 %[s1], %[k5], %[q6], %[s1]\n\t" \
                "s_waitcnt lgkmcnt(1)\n\t" \
                "v_mfma_f32_16x16x32_bf16 %[s0], %[k6], %[q7], %[s0]\n\t" \
                "s_waitcnt lgkmcnt(0)\n\t" \
                "v_mfma_f32_16x16x32_bf16 %[s1], %[k7], %[q7], %[s1]\n\t" \
                "s_nop 7\n\t" \
                "s_nop 7\n\t" \
                "s_nop 7\n\t" \
                : [s0] "=&v"(S0), [s1] "=&v"(S1), [k0] "=&v"(k0_), [k1] "=&v"(k1_), [k2] "=&v"(k2_), [k3] "=&v"(k3_), [k4] "=&v"(k4_), [k5] "=&v"(k5_), [k6] "=&v"(k6_), [k7] "=&v"(k7_) \
                : [ad] "v"(AD), [q0] "v"(qf[0]), [q1] "v"(qf[1]), [q2] "v"(qf[2]), [q3] "v"(qf[3]), [q4] "v"(qf[4]), [q5] "v"(qf[5]), [q6] "v"(qf[6]), [q7] "v"(qf[7]) : "memory"); } while (0)
#define RET_ST_BLOCK3(S0, S1, S2, AD) do { bf16x8 k0_, k1_, k2_, k3_, k4_, k5_, k6_, k7_; asm volatile( \
                "ds_read_b128 %[k0], %[ad] offset:0\n\t" \
                "ds_read_b128 %[k1], %[ad] offset:8704\n\t" \
                "ds_read_b128 %[k2], %[ad] offset:17408\n\t" \
                "ds_read_b128 %[k3], %[ad] offset:64\n\t" \
                "ds_read_b128 %[k4], %[ad] offset:8768\n\t" \
                "ds_read_b128 %[k5], %[ad] offset:17472\n\t" \
                "ds_read_b128 %[k6], %[ad] offset:128\n\t" \
                "ds_read_b128 %[k7], %[ad] offset:8832\n\t" \
                "s_waitcnt lgkmcnt(7)\n\t" \
                "v_mfma_f32_16x16x32_bf16 %[s0], %[k0], %[q0], 0\n\t" \
                "ds_read_b128 %[k0], %[ad] offset:17536\n\t" \
                "s_waitcnt lgkmcnt(7)\n\t" \
                "v_mfma_f32_16x16x32_bf16 %[s1], %[k1], %[q0], 0\n\t" \
                "ds_read_b128 %[k1], %[ad] offset:192\n\t" \
                "s_waitcnt lgkmcnt(7)\n\t" \
                "v_mfma_f32_16x16x32_bf16 %[s2], %[k2], %[q0], 0\n\t" \
                "ds_read_b128 %[k2], %[ad] offset:8896\n\t" \
                "s_waitcnt lgkmcnt(7)\n\t" \
                "v_mfma_f32_16x16x32_bf16 %[s0], %[k3], %[q1], %[s0]\n\t" \
                "ds_read_b128 %[k3], %[ad] offset:17600\n\t" \
                "s_waitcnt lgkmcnt(7)\n\t" \
                "v_mfma_f32_16x16x32_bf16 %[s1], %[k4], %[q1], %[s1]\n\t" \
                "ds_read_b128 %[k4], %[ad] offset:256\n\t" \
                "s_waitcnt lgkmcnt(7)\n\t" \
                "v_mfma_f32_16x16x32_bf16 %[s2], %[k5], %[q1], %[s2]\n\t" \
                "ds_read_b128 %[k5], %[ad] offset:8960\n\t" \
                "s_waitcnt lgkmcnt(7)\n\t" \
                "v_mfma_f32_16x16x32_bf16 %[s0], %[k6], %[q2], %[s0]\n\t" \
                "ds_read_b128 %[k6], %[ad] offset:17664\n\t" \
                "s_waitcnt lgkmcnt(7)\n\t" \
                "v_mfma_f32_16x16x32_bf16 %[s1], %[k7], %[q2], %[s1]\n\t" \
                "ds_read_b128 %[k7], %[ad] offset:320\n\t" \
                "s_waitcnt lgkmcnt(7)\n\t" \
                "v_mfma_f32_16x16x32_bf16 %[s2], %[k0], %[q2], %[s2]\n\t" \
                "ds_read_b128 %[k0], %[ad] offset:9024\n\t" \
                "s_waitcnt lgkmcnt(7)\n\t" \
                "v_mfma_f32_16x16x32_bf16 %[s0], %[k1], %[q3], %[s0]\n\t" \
                "ds_read_b128 %[k1], %[ad] offset:17728\n\t" \
                "s_waitcnt lgkmcnt(7)\n\t" \
                "v_mfma_f32_16x16x32_bf16 %[s1], %[k2], %[q3], %[s1]\n\t" \
                "ds_read_b128 %[k2], %[ad] offset:384\n\t" \
                "s_waitcnt lgkmcnt(7)\n\t" \
                "v_mfma_f32_16x16x32_bf16 %[s2], %[k3], %[q3], %[s2]\n\t" \
                "ds_read_b128 %[k3], %[ad] offset:9088\n\t" \
                "s_waitcnt lgkmcnt(7)\n\t" \
                "v_mfma_f32_16x16x32_bf16 %[s0], %[k4], %[q4], %[s0]\n\t" \
                "ds_read_b128 %[k4], %[ad] offset:17792\n\t" \
                "s_waitcnt lgkmcnt(7)\n\t" \
                "v_mfma_f32_16x16x32_bf16 %[s1], %[k5], %[q4], %[s1]\n\t" \
                "ds_read_b128 %[k5], %[ad] offset:448\n\t" \
                "s_waitcnt lgkmcnt(7)\n\t" \
                "v_mfma_f32_16x16x32_bf16 %[s2], %[k6], %[q4], %[s2]\n\t" \
                "ds_read_b128 %[k6], %[ad] offset:9152\n\t" \
                "s_waitcnt lgkmcnt(7)\n\t" \
                "v_mfma_f32_16x16x32_bf16 %[s0], %[k7], %[q5], %[s0]\n\t" \
                "ds_read_b128 %[k7], %[ad] offset:17856\n\t" \
                "s_waitcnt lgkmcnt(7)\n\t" \
                "v_mfma_f32_16x16x32_bf16 %[s1], %[k0], %[q5], %[s1]\n\t" \
                "s_waitcnt lgkmcnt(6)\n\t" \
                "v_mfma_f32_16x16x32_bf16 %[s2], %[k1], %[q5], %[s2]\n\t" \
                "s_waitcnt lgkmcnt(5)\n\t" \
                "v_mfma_f32_16x16x32_bf16 %[s0], %[k2], %[q6], %[s0]\n\t" \
                "s_waitcnt lgkmcnt(4)\n\t" \
                "v_mfma_f32_16x16x32_bf16 %[s1], %[k3], %[q6], %[s1]\n\t" \
                "s_waitcnt lgkmcnt(3)\n\t" \
                "v_mfma_f32_16x16x32_bf16 %[s2], %[k4], %[q6], %[s2]\n\t" \
                "s_waitcnt lgkmcnt(2)\n\t" \
                "v_mfma_f32_16x16x32_bf16 %[s0], %[k5], %[q7], %[s0]\n\t" \
                "s_waitcnt lgkmcnt(1)\n\t" \
                "v_mfma_f32_16x16x32_bf16 %[s1], %[k6], %[q7], %[s1]\n\t" \
                "s_waitcnt lgkmcnt(0)\n\t" \
                "v_mfma_f32_16x16x32_bf16 %[s2], %[k7], %[q7], %[s2]\n\t" \
                "s_nop 7\n\t" \
                "s_nop 7\n\t" \
                "s_nop 7\n\t" \
                : [s0] "=&v"(S0), [s1] "=&v"(S1), [s2] "=&v"(S2), [k0] "=&v"(k0_), [k1] "=&v"(k1_), [k2] "=&v"(k2_), [k3] "=&v"(k3_), [k4] "=&v"(k4_), [k5] "=&v"(k5_), [k6] "=&v"(k6_), [k7] "=&v"(k7_) \
                : [ad] "v"(AD), [q0] "v"(qf[0]), [q1] "v"(qf[1]), [q2] "v"(qf[2]), [q3] "v"(qf[3]), [q4] "v"(qf[4]), [q5] "v"(qf[5]), [q6] "v"(qf[6]), [q7] "v"(qf[7]) : "memory"); } while (0)
#define RET_ST_BLOCK4(S0, S1, S2, S3, AD) do { bf16x8 k0_, k1_, k2_, k3_, k4_, k5_, k6_, k7_; asm volatile( \
                "ds_read_b128 %[k0], %[ad] offset:0\n\t" \
                "ds_read_b128 %[k1], %[ad] offset:8704\n\t" \
                "ds_read_b128 %[k2], %[ad] offset:17408\n\t" \
                "ds_read_b128 %[k3], %[ad] offset:26112\n\t" \
                "ds_read_b128 %[k4], %[ad] offset:64\n\t" \
                "ds_read_b128 %[k5], %[ad] offset:8768\n\t" \
                "ds_read_b128 %[k6], %[ad] offset:17472\n\t" \
                "ds_read_b128 %[k7], %[ad] offset:26176\n\t" \
                "s_waitcnt lgkmcnt(7)\n\t" \
                "v_mfma_f32_16x16x32_bf16 %[s0], %[k0], %[q0], 0\n\t" \
                "ds_read_b128 %[k0], %[ad] offset:128\n\t" \
                "s_waitcnt lgkmcnt(7)\n\t" \
                "v_mfma_f32_16x16x32_bf16 %[s1], %[k1], %[q0], 0\n\t" \
                "ds_read_b128 %[k1], %[ad] offset:8832\n\t" \
                "s_waitcnt lgkmcnt(7)\n\t" \
                "v_mfma_f32_16x16x32_bf16 %[s2], %[k2], %[q0], 0\n\t" \
                "ds_read_b128 %[k2], %[ad] offset:17536\n\t" \
                "s_waitcnt lgkmcnt(7)\n\t" \
                "v_mfma_f32_16x16x32_bf16 %[s3], %[k3], %[q0], 0\n\t" \
                "ds_read_b128 %[k3], %[ad] offset:26240\n\t" \
                "s_waitcnt lgkmcnt(7)\n\t" \
                "v_mfma_f32_16x16x32_bf16 %[s0], %[k4], %[q1], %[s0]\n\t" \
                "ds_read_b128 %[k4], %[ad] offset:192\n\t" \
                "s_waitcnt lgkmcnt(7)\n\t" \
                "v_mfma_f32_16x16x32_bf16 %[s1], %[k5], %[q1], %[s1]\n\t" \
                "ds_read_b128 %[k5], %[ad] offset:8896\n\t" \
                "s_waitcnt lgkmcnt(7)\n\t" \
                "v_mfma_f32_16x16x32_bf16 %[s2], %[k6], %[q1], %[s2]\n\t" \
                "ds_read_b128 %[k6], %[ad] offset:17600\n\t" \
                "s_waitcnt lgkmcnt(7)\n\t" \
                "v_mfma_f32_16x16x32_bf16 %[s3], %[k7], %[q1], %[s3]\n\t" \
                "ds_read_b128 %[k7], %[ad] offset:26304\n\t" \
                "s_waitcnt lgkmcnt(7)\n\t" \
                "v_mfma_f32_16x16x32_bf16 %[s0], %[k0], %[q2], %[s0]\n\t" \
                "ds_read_b128 %[k0], %[ad] offset:256\n\t" \
                "s_waitcnt lgkmcnt(7)\n\t" \
                "v_mfma_f32_16x16x32_bf16 %[s1], %[k1], %[q2], %[s1]\n\t" \
                "ds_read_b128 %[k1], %[ad] offset:8960\n\t" \
                "s_waitcnt lgkmcnt(7)\n\t" \
                "v_mfma_f32_16x16x32_bf16 %[s2], %[k2], %[q2], %[s2]\n\t" \
                "ds_read_b128 %[k2], %[ad] offset:17664\n\t" \
                "s_waitcnt lgkmcnt(7)\n\t" \
                "v_mfma_f32_16x16x32_bf16 %[s3], %[k3], %[q2], %[s3]\n\t" \
                "ds_read_b128 %[k3], %[ad] offset:26368\n\t" \
                "s_waitcnt lgkmcnt(7)\n\t" \
                "v_mfma_f32_16x16x32_bf16 %[s0], %[k4], %[q3], %[s0]\n\t" \
                "ds_read_b128 %[k4], %[ad] offset:320\n\t" \
                "s_waitcnt lgkmcnt(7)\n\t" \
                "v_mfma_f32_16x16x32_bf16 %[s1], %[k5], %[q3], %[s1]\n\t" \
                "ds_read_b128 %[k5], %[ad] offset:9024\n\t" \
                "s_waitcnt lgkmcnt(7)\n\t" \
                "v_mfma_f32_16x16x32_bf16 %[s2], %[k6], %[q3], %[s2]\n\t" \
                "ds_read_b128 %[k6], %[ad] offset:17728\n\t" \
                "s_waitcnt lgkmcnt(7)\n\t" \
                "v_mfma_f32_16x16x32_bf16 %[s3], %[k7], %[q3], %[s3]\n\t" \
                "ds_read_b128 %[k7], %[ad] offset:26432\n\t" \
                "s_waitcnt lgkmcnt(7)\n\t" \
                "v_mfma_f32_16x16x32_bf16 %[s0], %[k0], %[q4], %[s0]\n\t" \
                "ds_read_b128 %[k0], %[ad] offset:384\n\t" \
                "s_waitcnt lgkmcnt(7)\n\t" \
                "v_mfma_f32_16x16x32_bf16 %[s1], %[k1], %[q4], %[s1]\n\t" \
                "ds_read_b128 %[k1], %[ad] offset:9088\n\t" \
                "s_waitcnt lgkmcnt(7)\n\t" \
                "v_mfma_f32_16x16x32_bf16 %[s2], %[k2], %[q4], %[s2]\n\t" \
                "ds_read_b128 %[k2], %[ad] offset:17792\n\t" \
                "s_waitcnt lgkmcnt(7)\n\t" \
                "v_mfma_f32_16x16x32_bf16 %[s3], %[k3], %[q4], %[s3]\n\t" \
                "ds_read_b128 %[k3], %[ad] offset:26496\n\t" \
                "s_waitcnt lgkmcnt(7)\n\t" \
                "v_mfma_f32_16x16x32_bf16 %[s0], %[k4], %[q5], %[s0]\n\t" \
                "ds_read_b128 %[k4], %[ad] offset:448\n\t" \
                "s_waitcnt lgkmcnt(7)\n\t" \
                "v_mfma_f32_16x16x32_bf16 %[s1], %[k5], %[q5], %[s1]\n\t" \
                "ds_read_b128 %[k5], %[ad] offset:9152\n\t" \
                "s_waitcnt lgkmcnt(7)\n\t" \
                "v_mfma_f32_16x16x32_bf16 %[s2], %[k6], %[q5], %[s2]\n\t" \
                "ds_read_b128 %[k6], %[ad] offset:17856\n\t" \
                "s_waitcnt lgkmcnt(7)\n\t" \
                "v_mfma_f32_16x16x32_bf16 %[s3], %[k7], %[q5], %[s3]\n\t" \
                "ds_read_b128 %[k7], %[ad] offset:26560\n\t" \
                "s_waitcnt lgkmcnt(7)\n\t" \
                "v_mfma_f32_16x16x32_bf16 %[s0], %[k0], %[q6], %[s0]\n\t" \
                "s_waitcnt lgkmcnt(6)\n\t" \
                "v_mfma_f32_16x16x32_bf16 %[s1], %[k1], %[q6], %[s1]\n\t" \
                "s_waitcnt lgkmcnt(5)\n\t" \
                "v_mfma_f32_16x16x32_bf16 %[s2], %[k2], %[q6], %[s2]\n\t" \
                "s_waitcnt lgkmcnt(4)\n\t" \
                "v_mfma_f32_16x16x32_bf16 %[s3], %[k3], %[q6], %[s3]\n\t" \
                "s_waitcnt lgkmcnt(3)\n\t" \
                "v_mfma_f32_16x16x32_bf16 %[s0], %[k4], %[q7], %[s0]\n\t" \
                "s_waitcnt lgkmcnt(2)\n\t" \
                "v_mfma_f32_16x16x32_bf16 %[s1], %[k5], %[q7], %[s1]\n\t" \
                "s_waitcnt lgkmcnt(1)\n\t" \
                "v_mfma_f32_16x16x32_bf16 %[s2], %[k6], %[q7], %[s2]\n\t" \
                "s_waitcnt lgkmcnt(0)\n\t" \
                "v_mfma_f32_16x16x32_bf16 %[s3], %[k7], %[q7], %[s3]\n\t" \
                "s_nop 7\n\t" \
                "s_nop 7\n\t" \
                "s_nop 7\n\t" \
                : [s0] "=&v"(S0), [s1] "=&v"(S1), [s2] "=&v"(S2), [s3] "=&v"(S3), [k0] "=&v"(k0_), [k1] "=&v"(k1_), [k2] "=&v"(k2_), [k3] "=&v"(k3_), [k4] "=&v"(k4_), [k5] "=&v"(k5_), [k6] "=&v"(k6_), [k7] "=&v"(k7_) \
                : [ad] "v"(AD), [q0] "v"(qf[0]), [q1] "v"(qf[1]), [q2] "v"(qf[2]), [q3] "v"(qf[3]), [q4] "v"(qf[4]), [q5] "v"(qf[5]), [q6] "v"(qf[6]), [q7] "v"(qf[7]) : "memory"); } while (0)
#define RET_PACK(P0) do { _Pragma("unroll") for (int p_ = 0; p_ < 2; ++p_) { float m[8]; \
                _Pragma("unroll") for (int rr = 0; rr < 4; ++rr) { const int j0 = 32 * (P0 + p_) + 4 * g4 + rr, j1 = j0 + 16; \
                    m[rr] = (j0 <= i) ? sacc[2 * p_][rr] : 0.f; \
                    m[4 + rr] = (j1 <= i) ? sacc[2 * p_ + 1][rr] : 0.f; } \
                v4u sw; sw.x = cvtpk(m[0], m[1]); sw.y = cvtpk(m[2], m[3]); sw.z = cvtpk(m[4], m[5]); sw.w = cvtpk(m[6], m[7]); \
                sf[P0 + p_] = __builtin_bit_cast(bf16x8, sw); } } while (0)
            bf16x8 sf[4];
            { f32x4 sacc[4];
              const unsigned kad = (unsigned)(size_t)(K_t + i16 * 544 + 16 * g4);
#define RET_ST_N(NB_, AD_) do { const f32x4 z4_ = (f32x4){0.f, 0.f, 0.f, 0.f}; \
                if ((NB_) == 4) RET_ST_BLOCK4(sacc[0], sacc[1], sacc[2], sacc[3], AD_); \
                else if ((NB_) == 3) { RET_ST_BLOCK3(sacc[0], sacc[1], sacc[2], AD_); sacc[3] = z4_; } \
                else if ((NB_) == 2) { RET_ST_BLOCK2(sacc[0], sacc[1], AD_); sacc[2] = z4_; sacc[3] = z4_; } \
                else { RET_ST_BLOCK1(sacc[0], AD_); sacc[1] = z4_; sacc[2] = z4_; sacc[3] = z4_; } } while (0)
              const int nb1 = (ib < 3) ? ib + 1 : 4;
              RET_ST_N(nb1, kad);
              RET_PACK(0);
              if (ib >= 4) { const unsigned kad2 = kad + 34816u; const int nb2 = ib - 3; RET_ST_N(nb2, kad2); RET_PACK(2); }
              else { sf[2] = __builtin_bit_cast(bf16x8, (v4u){0u, 0u, 0u, 0u}); sf[3] = sf[2]; } }
#undef RET_ST_N
#undef RET_PACK
#undef RET_ST_BLOCK1
#undef RET_ST_BLOCK2
#undef RET_ST_BLOCK3
#undef RET_ST_BLOCK4
            f32x4 o[2];
            o[0] = (f32x4){0.f, 0.f, 0.f, 0.f}; o[1] = (f32x4){0.f, 0.f, 0.f, 0.f};
#pragma unroll
            for (int k2 = 0; k2 < 8; k2 += 2) {
                bf16x8 rf[2][2];
#pragma unroll
                for (int kk = 0; kk < 2; ++kk)
#pragma unroll
                    for (int eb = 0; eb < 2; ++eb) rf[kk][eb] = *(const LAS bf16x8*)(RT_c + (16 * eb + i16) * 544 + (32 * (k2 + kk) + 8 * g4) * 2);
                asm volatile("" ::: "memory");
#pragma unroll
                for (int kk = 0; kk < 2; ++kk)
#pragma unroll
                    for (int eb = 0; eb < 2; ++eb) o[eb] = MFMA16(rf[kk][eb], qf[k2 + kk], o[eb]);
            }
            bf16x8 vfi[4][2];
#pragma unroll
            for (int p = 0; p < 4; ++p)
#pragma unroll
                for (int eb = 0; eb < 2; ++eb) vfi[p][eb] = lds_tr_pair(V_t, 96, 32 * p + 4 * g4, 32 * p + 16 + 4 * g4, 16 * eb, lane);
            asm volatile("" ::: "memory");
#pragma unroll
            for (int p = 0; p < 4; ++p)
#pragma unroll
                for (int eb = 0; eb < 2; ++eb) o[eb] = MFMA16(vfi[p][eb], sf[p], o[eb]);
            { const size_t advq = (size_t)((n + 1 < NCHUNK) ? n + 1 : n) * 128 * LDT;
#pragma unroll
              for (int ks = 0; ks < 8; ++ks) qf[ks] = *(const bf16x8*)(qg + advq + 32 * ks); }
            { const size_t token = tb + (size_t)n * 128 + i; float s = 0.f, q = 0.f;
#pragma unroll
              for (int eb = 0; eb < 2; ++eb) { u32x2 pk; pk.x = cvtpk(o[eb][0], o[eb][1]); pk.y = cvtpk(o[eb][2], o[eb][3]);
                  *(u32x2*)(Opre + token * LDT + hc + 32 * es + 16 * eb + 4 * g4) = pk;
#pragma unroll
                  for (int rr = 0; rr < 4; ++rr) { s += o[eb][rr]; q += o[eb][rr] * o[eb][rr]; } }
              s += __shfl_xor(s, 16); q += __shfl_xor(q, 16); s += __shfl_xor(s, 32); q += __shfl_xor(q, 32);
              if (g4 == 0) *(f32x2v*)(stats + ((token * 8 + h) * 8 + es) * 2) = (f32x2v){s, q}; }
            if (n + 1 < NCHUNK) {
#pragma unroll
                for (int k2 = 0; k2 < 4; k2 += 2) {
                    bf16x8 kfs[2][2], vfs[2][2];
#pragma unroll
                    for (int kk = 0; kk < 2; ++kk) { kfs[kk][0] = lds_tr_frag_c(K_t, 544, 32 * (k2 + kk), 32 * w, lane); kfs[kk][1] = lds_tr_frag_c(K_t, 544, 32 * (k2 + kk), 32 * w + 16, lane);
                        vfs[kk][0] = lds_tr_frag_c(V_t, 96, 32 * (k2 + kk), 0, lane); vfs[kk][1] = lds_tr_frag_c(V_t, 96, 32 * (k2 + kk), 16, lane); }
                    asm volatile("" ::: "memory");
#pragma unroll
                    for (int kk = 0; kk < 2; ++kk) { r[0][0] = MFMA16(kfs[kk][0], vfs[kk][0], r[0][0]); r[0][1] = MFMA16(kfs[kk][0], vfs[kk][1], r[0][1]);
                        r[1][0] = MFMA16(kfs[kk][1], vfs[kk][0], r[1][0]); r[1][1] = MFMA16(kfs[kk][1], vfs[kk][1], r[1][1]); }
                }
#pragma unroll
                for (int a = 0; a < 2; ++a)
#pragma unroll
                    for (int c = 0; c < 2; ++c) r[a][c] = r[a][c] * gamma_c;
#pragma unroll
                for (int db = 0; db < 2; ++db)
#pragma unroll
                    for (int eb = 0; eb < 2; ++eb) { u32x2 pk; pk.x = cvtpk(r[db][eb][0], r[db][eb][1]); pk.y = cvtpk(r[db][eb][2], r[db][eb][3]);
                        *(LAS u32x2*)(RT_n + (16 * eb + i16) * 544 + (32 * w + 16 * db + 4 * g4) * 2) = pk; }
            }
        }
        LDS_BARRIER();
    }
}
__device__ __forceinline__ void phase_sgumix2(LAS unsigned char* lds, const bf16* WM, const bf16* VS, const float* sgst, const float* lngain, bf16* U, const float* sb, int vcu, int G, int tid) {
    asm volatile("" : "+v"(tid));
    const int lane = tid & 63, w = __builtin_amdgcn_readfirstlane(tid >> 6), i16 = lane & 15, g4 = lane >> 4;
    LAS unsigned char* W_t = lds;
    LAS unsigned char* V_t = lds + 34816;
    LAS float* mr = (LAS float*)(lds + 102400);
    for (int bn = vcu; bn < BATCH * NCHUNK; bn += G) {
        const size_t t0 = (size_t)bn * 128;
        LDS_BARRIER();
        if (tid < 128) { const f32x4* sp = (const f32x4*)(sgst + (t0 + tid) * 64); float s = 0.f, q = 0.f;
#pragma unroll
            for (int k = 0; k < 16; ++k) { const f32x4 v = sp[k]; s += v[0]; q += v[1]; s += v[2]; q += v[3]; }
            const float mean = s * (1.0f / 2048.0f), var = q * (1.0f / 2048.0f) - mean * mean;
            mr[tid * 2] = mean; mr[tid * 2 + 1] = 1.0f / sqrtf(fmaxf(var, 0.f) + EPS); }
        v4u wpre[4], vpre[8]; f32x4 gpre[2];
        const bf16* vg = VS + (t0 + (tid >> 5)) * LDT + (tid & 31) * 8;
        const bf16* wg = WM + (tid >> 4) * 128 + (tid & 15) * 8;
#pragma unroll
        for (int k = 0; k < 4; ++k) wpre[k] = *(const v4u*)(wg + k * 32 * 128);
#pragma unroll
        for (int k = 0; k < 8; ++k) vpre[k] = *(const v4u*)(vg + (size_t)k * 16 * LDT);
        gpre[0] = *(const f32x4*)(lngain + (tid & 31) * 8); gpre[1] = *(const f32x4*)(lngain + (tid & 31) * 8 + 4);
        for (int g = 0; g < 8; ++g) {
            const int c0 = g * 256;
            LDS_BARRIER();
#pragma unroll
            for (int k = 0; k < 4; ++k) *(LAS v4u*)(W_t + ((tid >> 4) + 32 * k) * 272 + (tid & 15) * 16) = wpre[k];
#pragma unroll
            for (int k = 0; k < 8; ++k) { const int row = (tid >> 5) + 16 * k; const float mean = mr[row * 2], rstd = mr[row * 2 + 1]; const v4u x = vpre[k];
                v4u o; o.x = cvtpk((bflo(x.x) - mean) * rstd * gpre[0][0], (bfhi(x.x) - mean) * rstd * gpre[0][1]); o.y = cvtpk((bflo(x.y) - mean) * rstd * gpre[0][2], (bfhi(x.y) - mean) * rstd * gpre[0][3]);
                o.z = cvtpk((bflo(x.z) - mean) * rstd * gpre[1][0], (bfhi(x.z) - mean) * rstd * gpre[1][1]); o.w = cvtpk((bflo(x.w) - mean) * rstd * gpre[1][2], (bfhi(x.w) - mean) * rstd * gpre[1][3]);
                *(LAS v4u*)(V_t + row * 528 + (tid & 31) * 16) = o; }
            { const int gn = (g + 1 < 8) ? g + 1 : g;
#pragma unroll
              for (int k = 0; k < 4; ++k) wpre[k] = *(const v4u*)(wg + (size_t)gn * 16384 + k * 32 * 128);
#pragma unroll
              for (int k = 0; k < 8; ++k) vpre[k] = *(const v4u*)(vg + gn * 256 + (size_t)k * 16 * LDT);
              gpre[0] = *(const f32x4*)(lngain + gn * 256 + (tid & 31) * 8); gpre[1] = *(const f32x4*)(lngain + gn * 256 + (tid & 31) * 8 + 4); }
            LDS_BARRIER();
            u32x2 uw[2][8];
#pragma unroll
            for (int ib = 0; ib < 8; ++ib)
#pragma unroll
                for (int cb = 0; cb < 2; ++cb) uw[cb][ib] = *(const u32x2*)(U + (t0 + 16 * ib + i16) * LDT + c0 + 32 * w + 16 * cb + 4 * g4);
            f32x4 acc[2][8];
#pragma unroll
            for (int a = 0; a < 2; ++a)
#pragma unroll
                for (int b = 0; b < 8; ++b) acc[a][b] = (f32x4){0.f, 0.f, 0.f, 0.f};
#pragma unroll
            for (int ks = 0; ks < 4; ++ks) {
                const bf16x8 vf0 = lds_tr_frag(V_t, 528, 32 * ks, 32 * w, lane), vf1 = lds_tr_frag(V_t, 528, 32 * ks, 32 * w + 16, lane);
#pragma unroll
                for (int ib = 0; ib < 8; ++ib) if (2 * ks <= ib) {
                    const bf16x8 wf = *(const LAS bf16x8*)(W_t + (16 * ib + i16) * 272 + (32 * ks + 8 * g4) * 2);
                    acc[0][ib] = MFMA16(vf0, wf, acc[0][ib]); acc[1][ib] = MFMA16(vf1, wf, acc[1][ib]); }
            }
#pragma unroll
            for (int ib = 0; ib < 8; ++ib) { const int i = 16 * ib + i16; const float bias = sb[g * 128 + i];
#pragma unroll
                for (int cb = 0; cb < 2; ++cb) { const u32x2 x = uw[cb][ib]; const f32x4 a = acc[cb][ib];
                    u32x2 o; o.x = cvtpk(bflo(x.x) * (a[0] + bias), bfhi(x.x) * (a[1] + bias)); o.y = cvtpk(bflo(x.y) * (a[2] + bias), bfhi(x.y) * (a[3] + bias));
                    *(u32x2*)(U + (t0 + i) * LDT + c0 + 32 * w + 16 * cb + 4 * g4) = o; } }
        }
    }
    LDS_BARRIER();
}
__device__ __forceinline__ void phase_retln(const bf16* Opre, const float* stats, const bf16* Gi, bf16* Gt, const float* gn, int gw, int NGW, int lane) {
    asm volatile("" : "+v"(lane));
    f32x4 gv[8];
#pragma unroll
    for (int h = 0; h < 8; ++h) gv[h] = *(const f32x4*)(gn + h * 256 + 4 * lane);
    for (int m = gw; m < M; m += NGW) {
        f32x2v st = *(const f32x2v*)(stats + ((size_t)m * 64 + lane) * 2);
        float s = st.x, q = st.y;
        s += __shfl_xor(s, 1); q += __shfl_xor(q, 1); s += __shfl_xor(s, 2); q += __shfl_xor(q, 2); s += __shfl_xor(s, 4); q += __shfl_xor(q, 4);
        const float mean_l = s * (1.0f / 256.0f), var_l = q * (1.0f / 256.0f) - mean_l * mean_l, rstd_l = 1.0f / sqrtf(fmaxf(var_l, 0.f) + EPS);
        const u32x2* op = (const u32x2*)(Opre + (size_t)m * LDT) + lane; u32x2* gp = (u32x2*)(Gt + (size_t)m * LDT) + lane; const u32x2* gi = (const u32x2*)(Gi + (size_t)m * LDT) + lane;
#pragma unroll
        for (int h = 0; h < 8; ++h) { const float mean = __shfl(mean_l, 8 * h), rstd = __shfl(rstd_l, 8 * h);
            const u32x2 ow = op[64 * h], gw2 = gi[64 * h];
            u32x2 y; y.x = cvtpk((bflo(ow.x) - mean) * rstd * gv[h][0] * bflo(gw2.x), (bfhi(ow.x) - mean) * rstd * gv[h][1] * bfhi(gw2.x));
            y.y = cvtpk((bflo(ow.y) - mean) * rstd * gv[h][2] * bflo(gw2.y), (bfhi(ow.y) - mean) * rstd * gv[h][3] * bfhi(gw2.y));
            gp[64 * h] = y; }
    }
}

__device__ __forceinline__ int fresh_tid() { int t = threadIdx.x; asm volatile("" : "+v"(t)); return t; }
struct Args { const void* in[19]; float* out; unsigned char* ws; };
__global__ void __launch_bounds__(NWAVES * 64, 2) fwd(Args args) {
    extern __shared__ __attribute__((aligned(16))) unsigned char lds_raw[];
    LAS unsigned char* lds = (LAS unsigned char*)lds_raw;
    volatile LAS unsigned* MISC = (volatile LAS unsigned*)(lds + MISC_OFF);
#define TID fresh_tid()
#define LANE (fresh_tid() & 63)
    const int wave = __builtin_amdgcn_readfirstlane(TID >> 6);
    const int G = gridDim.x; const int bx = blockIdx.x; const int vcu = (G % 8 == 0) ? (bx % 8) * (G / 8) + bx / 8 : bx;
    const int gw = vcu * NWAVES + wave, NGW = G * NWAVES;
    unsigned char* ws = args.ws; float* X = args.out;
    for (int u = TID; u < (LDS_BYTES - LDSCTL_OFF) / 4; u += NWAVES * 64) ((LAS unsigned*)(lds + LDSCTL_OFF))[u] = 0u;
    __syncthreads();
    XcdBarrier bar = xcd_barrier_post((unsigned*)(ws + WS_CTL) + CW_BAR, MISC + 8);

    bf16* Hb = (bf16*)(ws + WS_H);
    bf16* BIG = (bf16*)(ws + WS_BIG);
    bf16 *tQ = BIG, *tK = BIG + TSTRIDE, *tV = BIG + 2 * TSTRIDE, *tG = BIG + 3 * TSTRIDE, *tU = BIG + 4 * TSTRIDE, *tVS = BIG + 5 * TSTRIDE, *tGA = BIG + 6 * TSTRIDE, *tGB = BIG + 7 * TSTRIDE;
    unsigned* CS = (unsigned*)(ws + WS_CS);
    bf16* RT = (bf16*)(ws + WS_RT);

    float* SSQ = (float*)(ws + WS_SSQ);
    {
        for (int m = gw; m < M; m += NGW) {
            const f32x4* xr = (const f32x4*)((const float*)args.in[0] + (size_t)m * D) + LANE; u32x2* ho = (u32x2*)(Hb + (size_t)m * LDT) + LANE;
            float sq = 0.f;
#pragma unroll
            for (int j = 0; j < 8; ++j) { const f32x4 v = xr[64 * j]; u32x2 w; w.x = cvtpk(v[0], v[1]); w.y = cvtpk(v[2], v[3]); ho[64 * j] = w; sq += (v[0] * v[0] + v[1] * v[1]) + (v[2] * v[2] + v[3] * v[3]); }
            sq = wave_sum(sq);
            if (LANE < 32) SSQ[(size_t)m * 32 + LANE] = (LANE == 0) ? sq : 0.0f;
        }
        const size_t gt = (size_t)bx * (NWAVES * 64) + TID, gs = (size_t)G * (NWAVES * 64);
        const int* pos = (const int*)args.in[1];
        for (size_t i = gt; i < (size_t)M * 128; i += gs) { const int tkn = (int)(i >> 7), j = (int)(i & 127);
            double inv = 0.15915494309189535;
            inv *= (j & 1) ? 0.930572040929699 : 1.0; inv *= (j & 2) ? 0.8659643233600653 : 1.0; inv *= (j & 4) ? 0.7498942093324559 : 1.0; inv *= (j & 8) ? 0.5623413251903491 : 1.0;
            inv *= (j & 16) ? 0.31622776601683794 : 1.0; inv *= (j & 32) ? 0.1 : 1.0; inv *= (j & 64) ? 0.01 : 1.0;
            double t = (double)pos[tkn] * inv; t -= floor(t); const float tf = (float)t;
            pg8::h2_t hv; hv.x = (_Float16)__builtin_amdgcn_cosf(tf); hv.y = (_Float16)__builtin_amdgcn_sinf(tf); CS[i] = __builtin_bit_cast(unsigned, hv); }
    }
    for (int it = 0; it < 2 * DEPTH; ++it) {
        const int l = it >> 1, second = it & 1;
        if (!second) {
            ConvSrc cs;
            cs.gu1 = (const float*)args.in[3] + (size_t)l * D * 2 * FF; cs.d1 = (const float*)args.in[4] + (size_t)l * FF * D; cs.win = (const float*)args.in[6] + (size_t)l * D * INCOLS;
            cs.br = (const float*)args.in[12] + (size_t)l * D * D; cs.bs = (const float*)args.in[13] + (size_t)l * D * D; cs.wo = (const float*)args.in[14] + (size_t)l * D * D;
            cs.gu2 = (const float*)args.in[16] + (size_t)l * D * 2 * FF; cs.d2 = (const float*)args.in[17] + (size_t)l * FF * D; cs.sw = (const float*)args.in[10] + (size_t)l * 8 * 128 * 128;
            cs.g1 = (const float*)args.in[2] + (size_t)l * D; cs.gm = (const float*)args.in[5] + (size_t)l * D; cs.g2 = (const float*)args.in[15] + (size_t)l * D;
            phase_conv(lds, ws, cs, gw, NGW, wave, LANE);
            xcd_barrier(bar);
        }
        {
            const int ci = 3 * l + (second ? 2 : 0);
            pg8::Gemm g{Hb, (const bf16*)(ws + (second ? WS_WGU2 : WS_WGU1)), M, 2 * FF, D, LDT, D}; pg8::StaticOrder S; S.init(M, 2 * FF, G, bx);
            pg8::EpiSwiglu E{BIG, FF, SSQ + (size_t)ci * SSQ_STRIDE, (LAS float*)(lds + RS_OFF), -1};
            pg8::gemm_phase<pg8::EpiSwiglu, pg8::StaticOrder, true, true>(lds, g, S, E);
        }
        xcd_barrier(bar);
        {
            const int pi = 3 * l + (second ? 3 : 1);
            pg8::Gemm g{BIG, (const bf16*)(ws + (second ? WS_WD2 : WS_WD1)), M, D, FF, FF, FF}; pg8::ReverseOrder S; S.init(M, D, G, bx);
            pg8::EpiResid E{0.5f, Hb, SSQ + (size_t)pi * SSQ_STRIDE};
            pg8::gemm_phase<pg8::EpiResid, pg8::ReverseOrder, true, true>(lds, g, S, E);
        }
        xcd_barrier(bar);
        if (!second) {
            {
                const int ci = 3 * l + 1;
                pg8::Gemm g{Hb, (const bf16*)(ws + WS_WIN), M, INCOLS, D, LDT, D}; pg8::StaticOrder S; S.init(M, INCOLS, G, bx);
                pg8::EpiIn E{BIG, TSTRIDE, CS, (const float*)args.in[7] + (size_t)l * 2 * D, SSQ + (size_t)ci * SSQ_STRIDE, (LAS float*)(lds + RS_OFF), -1, (float*)(ws + WS_SGST)};
                pg8::gemm_phase<pg8::EpiIn, pg8::StaticOrder, true, true>(lds, g, S, E);
            }
            xcd_barrier(bar);
            phase_ret(lds, tQ, tK, tV, (bf16*)(ws + WS_OPRE), (float*)(ws + WS_RT), vcu, G, TID);
            xcd_barrier(bar);
            phase_sgumix2(lds, (const bf16*)(ws + WS_WMASK), tVS, (const float*)(ws + WS_SGST), (const float*)args.in[9] + (size_t)l * 2048, tU, (const float*)args.in[11] + (size_t)l * 8 * 128, vcu, G, TID);
            phase_retln((const bf16*)(ws + WS_OPRE), (const float*)(ws + WS_RT), tG, tG, (const float*)args.in[8] + (size_t)l * 2048, gw, NGW, LANE);
            xcd_barrier(bar);
            {
                pg8::Gemm g{tG, (const bf16*)(ws + WS_WBR), M, D, D, LDT, D}; pg8::DualOrder S; S.init(M, D, G, bx); S.A2 = tU; S.B2 = (const bf16*)(ws + WS_WBS);
                pg8::EpiBr<2> E{tQ, tGA, tGB};
                pg8::gemm_phase<pg8::EpiBr<2>, pg8::DualOrder, true, true>(lds, g, S, E);
            }
            xcd_barrier(bar);
            {
                const int pi = 3 * l + 2;
                pg8::Gemm g{tQ, (const bf16*)(ws + WS_WOUT), M, D, D, LDT, D}; pg8::StaticOrder S; S.init(M, D, G, bx);
                pg8::EpiResid E{1.0f, Hb, SSQ + (size_t)pi * SSQ_STRIDE};
                pg8::gemm_phase<pg8::EpiResid, pg8::StaticOrder, true, true>(lds, g, S, E);
            }
            xcd_barrier(bar);
        }
    }
    phase_final(Hb, X, (const float*)args.in[18], gw, NGW, LANE);
}

extern "C" void kernel_launch(void* const* d_in, const int* in_sizes, int n_in, void* d_out, int out_size, void* d_ws, size_t ws_size, hipStream_t stream) {
    static int grid = 0;
    if (grid == 0) {
        if (n_in != 19 || in_sizes[0] != M * D || out_size != M * D || ws_size < WS_END) { fprintf(stderr, "kernel_launch: unexpected shapes / workspace (n_in %d, in0 %d, out %d, ws %zu, need %zu); nothing launched\n", n_in, n_in > 0 ? in_sizes[0] : -1, out_size, ws_size, (size_t)WS_END); grid = -1; return; }
        int dev = 0, cus = 0, per_cu = 0;
        if (hipGetDevice(&dev) != hipSuccess || hipDeviceGetAttribute(&cus, hipDeviceAttributeMultiprocessorCount, dev) != hipSuccess) { fprintf(stderr, "kernel_launch: device query failed\n"); grid = -1; return; }
        if (hipFuncSetAttribute((const void*)fwd, hipFuncAttributeMaxDynamicSharedMemorySize, LDS_BYTES) != hipSuccess) { fprintf(stderr, "kernel_launch: hipFuncSetAttribute failed\n"); grid = -1; return; }
        if (hipOccupancyMaxActiveBlocksPerMultiprocessor(&per_cu, (const void*)fwd, NWAVES * 64, LDS_BYTES) != hipSuccess || per_cu < 1) fprintf(stderr, "kernel_launch: note: occupancy query reports %d workgroups per CU\n", per_cu);
        (void)hipGetLastError();
        grid = cus;
    }
    if (grid < 0) return;
    if (hipMemsetAsync((char*)d_ws + WS_CTL, 0, CTL_ZERO_BYTES, stream) != hipSuccess) { fprintf(stderr, "kernel_launch: memset failed\n"); return; }
    Args a{};
    for (int i = 0; i < 19; ++i) a.in[i] = d_in[i];
    a.out = (float*)d_out; a.ws = (unsigned char*)d_ws;
    hipLaunchKernelGGL(fwd, dim3(grid), dim3(NWAVES * 64), LDS_BYTES, stream, a);
    const hipError_t le = hipPeekAtLastError();
    if (le != hipSuccess) fprintf(stderr, "kernel_launch: launch failed: %s\n", hipGetErrorName(le));
}
```

```cpp
#include <hip/hip_runtime.h>
#include <cstdio>
#include <cstdint>
#include <cmath>
namespace pg8 {
#define PG8_LAS __attribute__((address_space(3)))
typedef unsigned short bf16_t;
typedef short bf16x8 __attribute__((ext_vector_type(8)));
typedef float f32x4 __attribute__((ext_vector_type(4)));
typedef unsigned u32x4 __attribute__((ext_vector_type(4)));
constexpr int LDT = 2048 + 64;
constexpr int BM = 256, BK = 64, HALF = 128, HTB = HALF * BK * 2  , STAGE_BYTES = 8 * HTB, NXCD = 8, WGM = 8;

__host__ __device__ __forceinline__ int lds_byte(int r, int c) { const int st = (r >> 4) * 2 + (c >> 5), rr = r & 15, cc = c & 31, ob = rr * 64 + cc * 2; return st * 1024 + (ob ^ (((ob >> 9) & 1) << 5)); }
__host__ __device__ __forceinline__ void stage_rc(int b, int& R, int& C) { const int st = b / 1024, sb = b % 1024, swz = sb ^ (((sb >> 9) & 1) << 5); R = (st >> 1) * 16 + swz / 64; C = (st & 1) * 32 + (swz % 64) / 2; }
__host__ __device__ __forceinline__ int perm32(int rho) { const int n = rho >> 4, i = rho & 15; return 8 * (i >> 2) + 4 * n + (i & 3); }

struct Unit { int pm, pn, z; };
struct Gemm { const bf16_t* A; const bf16_t* Bt; int M, N, K; int lda, ldb; };

struct StaticOrder {
    int nM, nN, nwg, G, c;
    __host__ __device__ void init(int M, int N, int G_, int c_) { nM = M / BM; nN = N / BM; nwg = nM * nN; G = G_; c = c_; }
    __host__ __device__ bool next(int i, Unit& u) const {
        const long L = (long)i * G + c; if (L >= nwg) return false;
        int wgid = (int)L; { const int q = nwg / NXCD, r = nwg % NXCD, xcd = wgid % NXCD, off = wgid / NXCD; wgid = (xcd < r ? xcd * (q + 1) : r * (q + 1) + (xcd - r) * q) + off; }
        const int nig = WGM * nN, gid = wgid / nig, fm = gid * WGM, gsz = (nM - fm) < WGM ? (nM - fm) : WGM;
        u.pm = fm + ((wgid % nig) % gsz); u.pn = (wgid % nig) / gsz; u.z = 0; return true;
    }
    __device__ __forceinline__ void a_ready(const Unit&) const {}
    __device__ __forceinline__ void done(const Unit&) const {}
    __device__ __forceinline__ const bf16_t* opA(const Gemm& g, const Unit&) const { return g.A; }
    __device__ __forceinline__ const bf16_t* opB(const Gemm& g, const Unit&) const { return g.Bt; }
};
struct ReverseOrder : StaticOrder {
    __device__ bool next(int i, Unit& u) const { const int rounds = nwg / G; if (i >= rounds) return false; return StaticOrder::next(rounds - 1 - i, u); }
};
struct DualOrder : StaticOrder {
    const bf16_t* A2; const bf16_t* B2;
    __device__ bool next(int i, Unit& u) const { const int rounds = nwg / G; if (i >= 2 * rounds) return false; const bool ok = StaticOrder::next(i >= rounds ? i - rounds : i, u); u.z = (i >= rounds) ? 1 : 0; return ok; }
    __device__ __forceinline__ const bf16_t* opA(const Gemm& g, const Unit& u) const { return u.z ? A2 : g.A; }
    __device__ __forceinline__ const bf16_t* opB(const Gemm& g, const Unit& u) const { return u.z ? B2 : g.Bt; }
};
typedef float f32x2_c __attribute__((ext_vector_type(2))); typedef __bf16 bf16x2_c __attribute__((ext_vector_type(2)));
__device__ __forceinline__ unsigned cvt_pk_bf16(float lo, float hi) { f32x2_c v = {lo, hi}; bf16x2_c b = __builtin_convertvector(v, bf16x2_c); return __builtin_bit_cast(unsigned, b); }
typedef float f32x2 __attribute__((ext_vector_type(2)));
__device__ __forceinline__ f32x2 gelu_pk(f32x2 v) {
    const f32x2 av = __builtin_elementwise_abs(v), d = av * 0.2316418882f + 1.0f;
    f32x2 t; t.x = __builtin_amdgcn_rcpf(d.x); t.y = __builtin_amdgcn_rcpf(d.y);
    f32x2 q = t * 0.5307027145f + (-0.7265760135f); q = q * t + 0.7107068705f; q = q * t + (-0.142248368f); q = q * t + 0.127414796f; q = q * t;
    const f32x2 s = (v * v) * (-0.72134752044f);
    f32x2 e; e.x = __builtin_amdgcn_exp2f(s.x); e.y = __builtin_amdgcn_exp2f(s.y);
    const f32x2 m = v * (q * e), r = v - m;
    f32x2 o; o.x = v.x < 0.f ? m.x : r.x; o.y = v.y < 0.f ? m.y : r.y; return o;
}

__device__ __forceinline__ float bf_lo(unsigned u) { return __uint_as_float(u << 16); }
__device__ __forceinline__ float bf_hi(unsigned u) { return __uint_as_float(u & 0xffff0000u); }
__device__ __forceinline__ float silu_f(float g) { return g * __builtin_amdgcn_rcpf(1.0f + __builtin_amdgcn_exp2f(-1.44269504f * g)); }
__device__ __forceinline__ float sigmoid_f(float g) { return __builtin_amdgcn_rcpf(1.0f + __builtin_amdgcn_exp2f(-1.44269504f * g)); }

__device__ __forceinline__ float row_rs(const float* ssq, int row, int fq) {
    const float* pp = ssq + (size_t)row * 32 + 8 * fq; const f32x4 p0 = *(const f32x4*)pp, p1 = *(const f32x4*)(pp + 4);
    float s = ((p0[0] + p0[1]) + (p0[2] + p0[3])) + ((p1[0] + p1[1]) + (p1[2] + p1[3]));
    s += __shfl_xor(s, 16); s += __shfl_xor(s, 32);
    return __builtin_amdgcn_rsqf(s * (1.0f / 2048.0f) + 1e-6f);
}
struct EpiSwiglu {
    static constexpr bool PERM = true, AFTER_DRAIN = false; static constexpr int NST = 8;
    bf16_t* O; int ldc; const float* ssq;
    PG8_LAS float* rsl; mutable int cpm;
    __device__ __forceinline__ void operator()(const f32x4 (&acc)[2][2][4][2], const Unit& u, int wr, int wc, int fr, int fq) const {
        const int row0 = u.pm * BM + wr * 64 + fr, col0 = u.pn * HALF + wc * 32 + 8 * fq;
        PG8_LAS float* my = rsl + (wr * 4 + wc) * 128 + fr;
        if (u.pm != cpm) { cpm = u.pm;
#pragma unroll
            for (int ai = 0; ai < 2; ++ai)
#pragma unroll
                for (int m = 0; m < 4; ++m) { const float r = row_rs(ssq, row0 + ai * HALF + m * 16, fq); if (fq == 0) my[(ai * 4 + m) * 16] = r; } }
#pragma unroll
        for (int ai = 0; ai < 2; ++ai)
#pragma unroll
            for (int m = 0; m < 4; ++m) { bf16_t* rowp = O + (size_t)(row0 + ai * HALF + m * 16) * ldc + col0;
                const float rs = my[(ai * 4 + m) * 16];
                const f32x4 a0 = acc[ai][0][m][0] * rs, a1 = acc[ai][0][m][1] * rs, g0 = acc[ai][1][m][0] * rs, g1 = acc[ai][1][m][1] * rs;
                u32x4 w; w.x = cvt_pk_bf16(a0[0] * silu_f(g0[0]), a0[1] * silu_f(g0[1])); w.y = cvt_pk_bf16(a0[2] * silu_f(g0[2]), a0[3] * silu_f(g0[3]));
                w.z = cvt_pk_bf16(a1[0] * silu_f(g1[0]), a1[1] * silu_f(g1[1])); w.w = cvt_pk_bf16(a1[2] * silu_f(g1[2]), a1[3] * silu_f(g1[3]));
                *(u32x4*)rowp = w; }
    }
};
struct EpiResid {
    static constexpr bool PERM = true, AFTER_DRAIN = false; static constexpr int NST = 8;
    float scale; bf16_t* Hx; float* ssq;
    __device__ __forceinline__ void operator()(const f32x4 (&acc)[2][2][4][2], const Unit& u, int wr, int wc, int fr, int fq) const {
        const int row0 = u.pm * BM + wr * 64 + fr, col0 = u.pn * BM + wc * 32 + 8 * fq;
#pragma unroll
        for (int ai = 0; ai < 2; ++ai) {
            u32x4 xv[4][2];
#pragma unroll
            for (int m = 0; m < 4; ++m)
#pragma unroll
                for (int bj = 0; bj < 2; ++bj) xv[m][bj] = *(const u32x4*)(Hx + (size_t)(row0 + ai * HALF + m * 16) * LDT + col0 + bj * HALF);
            float ssm[4];
#pragma unroll
            for (int m = 0; m < 4; ++m) { const int row = row0 + ai * HALF + m * 16; bf16_t* hp = Hx + (size_t)row * LDT + col0;
                float ss = 0.f;
#pragma unroll
                for (int bj = 0; bj < 2; ++bj) { const u32x4 x = xv[m][bj]; const f32x4 a0 = acc[ai][bj][m][0], a1 = acc[ai][bj][m][1];
                    const float y0 = bf_lo(x.x) + a0[0] * scale, y1 = bf_hi(x.x) + a0[1] * scale, y2 = bf_lo(x.y) + a0[2] * scale, y3 = bf_hi(x.y) + a0[3] * scale;
                    const float y4 = bf_lo(x.z) + a1[0] * scale, y5 = bf_hi(x.z) + a1[1] * scale, y6 = bf_lo(x.w) + a1[2] * scale, y7 = bf_hi(x.w) + a1[3] * scale;
                    ss += ((y0 * y0 + y1 * y1) + (y2 * y2 + y3 * y3)) + ((y4 * y4 + y5 * y5) + (y6 * y6 + y7 * y7));
                    u32x4 w; w.x = cvt_pk_bf16(y0, y1); w.y = cvt_pk_bf16(y2, y3); w.z = cvt_pk_bf16(y4, y5); w.w = cvt_pk_bf16(y6, y7);
                    *(u32x4*)(hp + bj * HALF) = w; }
                ss += __shfl_xor(ss, 16); ss += __shfl_xor(ss, 32); ssm[m] = ss; }
            { const float sv = (fq == 0) ? ssm[0] : (fq == 1) ? ssm[1] : (fq == 2) ? ssm[2] : ssm[3];
              ssq[(size_t)(row0 + ai * HALF + fq * 16) * 32 + u.pn * 4 + wc] = sv; }
            asm volatile("" ::: "memory"); }
    }
};
__device__ __forceinline__ float lg2_gamma_h(int h) {
    const float x = __builtin_amdgcn_exp2f(-5.0f - (float)h);
    const float l = -x * (1.0f + x * (0.5f + x * (0.33333334f + x * (0.25f + x * (0.2f + x * 0.16666667f)))));
    return l * 1.44269504f;
}
constexpr int GATE_PITCH = 2112;
typedef _Float16 h2_t __attribute__((ext_vector_type(2)));
struct EpiIn {
    static constexpr bool PERM = true, AFTER_DRAIN = false; static constexpr int NST = 8;
    bf16_t* O; size_t tstride; const unsigned* cs; const float* bgate; const float* ssq; PG8_LAS float* rsl; mutable int cpm; float* sgst;
    __device__ __forceinline__ void operator()(const f32x4 (&acc)[2][2][4][2], const Unit& u, int wr, int wc, int fr, int fq) const {
        const int t = ((u.pn >> 3) + 3) & 7, hh = u.pn & 7;
        bf16_t* base = O + (size_t)t * tstride;
        const int row0 = u.pm * BM + wr * 64 + fr, cw = wc * 32 + 8 * fq, col0 = hh * BM + cw;
        PG8_LAS float* my = rsl + (wr * 4 + wc) * 128 + fr;
        if (u.pm != cpm) { cpm = u.pm;
#pragma unroll
            for (int ai = 0; ai < 2; ++ai)
#pragma unroll
                for (int m = 0; m < 4; ++m) { const float r = row_rs(ssq, row0 + ai * HALF + m * 16, fq); if (fq == 0) my[(ai * 4 + m) * 16] = r; } }
        if (t <= 1) {
            const float sc = (t == 1) ? 0.0625f : 1.0f, lgs = (t == 1) ? -lg2_gamma_h(hh) : lg2_gamma_h(hh);
#pragma unroll
            for (int ai = 0; ai < 2; ++ai) {
                u32x4 cv[4][2];
#pragma unroll
                for (int m = 0; m < 4; ++m) { const u32x4* cp = (const u32x4*)(cs + ((size_t)(row0 + ai * HALF + m * 16) * 128 + cw));
                    cv[m][0] = cp[0]; cv[m][1] = cp[1]; }
#pragma unroll
                for (int m = 0; m < 4; ++m) { const int row = row0 + ai * HALF + m * 16;
                    int rl = row; asm volatile("" : "+v"(rl));
                    const float rs = my[(ai * 4 + m) * 16] * sc * __builtin_amdgcn_exp2f((float)((rl & 127) + 1) * lgs);
                    const f32x4 xa0 = acc[ai][0][m][0] * rs, xa1 = acc[ai][0][m][1] * rs, xb0 = acc[ai][1][m][0] * rs, xb1 = acc[ai][1][m][1] * rs;
                    const unsigned cw8[8] = {cv[m][0].x, cv[m][0].y, cv[m][0].z, cv[m][0].w, cv[m][1].x, cv[m][1].y, cv[m][1].z, cv[m][1].w};
                    float co[8], si[8];
#pragma unroll
                    for (int j = 0; j < 8; ++j) { const h2_t hv = __builtin_bit_cast(h2_t, cw8[j]); co[j] = (float)hv.x; si[j] = (float)hv.y; }
                    const float x1[8] = {xa0[0], xa0[1], xa0[2], xa0[3], xa1[0], xa1[1], xa1[2], xa1[3]};
                    const float x2[8] = {xb0[0], xb0[1], xb0[2], xb0[3], xb1[0], xb1[1], xb1[2], xb1[3]};
                    float o1[8], o2[8];
#pragma unroll
                    for (int j = 0; j < 8; ++j) { o1[j] = x1[j] * co[j] - x2[j] * si[j]; o2[j] = x1[j] * si[j] + x2[j] * co[j]; }
                    u32x4 w1, w2;
                    w1.x = cvt_pk_bf16(o1[0], o1[1]); w1.y = cvt_pk_bf16(o1[2], o1[3]); w1.z = cvt_pk_bf16(o1[4], o1[5]); w1.w = cvt_pk_bf16(o1[6], o1[7]);
                    w2.x = cvt_pk_bf16(o2[0], o2[1]); w2.y = cvt_pk_bf16(o2[2], o2[3]); w2.z = cvt_pk_bf16(o2[4], o2[5]); w2.w = cvt_pk_bf16(o2[6], o2[7]);
                    bf16_t* rowp = base + (size_t)row * LDT + col0;
                    *(u32x4*)rowp = w1; *(u32x4*)(rowp + HALF) = w2; }
                asm volatile("" ::: "memory"); }
        } else if (t == 2) other<2>(acc, base, row0, col0, my, t, hh, wc, fq);
        else if (t == 3) other<3>(acc, base, row0, col0, my, t, hh, wc, fq);
        else if (t == 4) other<4>(acc, base, row0, col0, my, t, hh, wc, fq);
        else if (t == 5) other<5>(acc, base, row0, col0, my, t, hh, wc, fq);
        else other<6>(acc, base, row0, col0, my, t, hh, wc, fq);
    }
    template <int TT> __device__ __forceinline__ void other(const f32x4 (&acc)[2][2][4][2], bf16_t* base, int row0, int col0, PG8_LAS float* my, int t, int hh, int wc, int fq) const {
        asm volatile("" : "+v"(row0), "+v"(col0), "+v"(fq));
        f32x4 bv[2][2];
#pragma unroll
        for (int bj = 0; bj < 2; ++bj)
#pragma unroll
            for (int n = 0; n < 2; ++n) bv[bj][n] = (TT >= 6) ? *(const f32x4*)(bgate + (t - 6) * 2048 + col0 + bj * HALF + 4 * n) : (f32x4){0.f, 0.f, 0.f, 0.f};
        float psm = 0.f, pqm = 0.f;
#pragma unroll
        for (int ai = 0; ai < 2; ++ai)
#pragma unroll
            for (int m = 0; m < 4; ++m) { bf16_t* rowp = base + (size_t)(row0 + ai * HALF + m * 16) * LDT + col0;
                const float rs = my[(ai * 4 + m) * 16]; float ps = 0.f, pq = 0.f; u32x4 gq = {0u, 0u, 0u, 0u};
#pragma unroll
                for (int bj = 0; bj < 2; ++bj) { f32x4 v0 = acc[ai][bj][m][0] * rs + bv[bj][0], v1 = acc[ai][bj][m][1] * rs + bv[bj][1];
                    if (TT == 3) {
#pragma unroll
                        for (int j = 0; j < 4; ++j) { v0[j] = silu_f(v0[j]); v1[j] = silu_f(v1[j]); } }
                    else if (TT == 4 || TT == 5) { f32x2 a = gelu_pk((f32x2){v0[0], v0[1]}), b = gelu_pk((f32x2){v0[2], v0[3]}), c = gelu_pk((f32x2){v1[0], v1[1]}), d = gelu_pk((f32x2){v1[2], v1[3]});
                        v0 = (f32x4){a.x, a.y, b.x, b.y}; v1 = (f32x4){c.x, c.y, d.x, d.y};
                        if (TT == 5) { ps += ((v0[0] + v0[1]) + (v0[2] + v0[3])) + ((v1[0] + v1[1]) + (v1[2] + v1[3]));
                            pq += ((v0[0] * v0[0] + v0[1] * v0[1]) + (v0[2] * v0[2] + v0[3] * v0[3])) + ((v1[0] * v1[0] + v1[1] * v1[1]) + (v1[2] * v1[2] + v1[3] * v1[3])); } }
                    else if (TT >= 6) {
#pragma unroll
                        for (int j = 0; j < 4; ++j) { v0[j] = sigmoid_f(v0[j]); v1[j] = sigmoid_f(v1[j]); } }
                    if (TT >= 6) { unsigned b0 = 0u, b1 = 0u;
#pragma unroll
                        for (int j = 0; j < 4; ++j) { b0 = __builtin_amdgcn_cvt_pk_u8_f32(__builtin_rintf(v0[j] * 255.0f), j, b0); b1 = __builtin_amdgcn_cvt_pk_u8_f32(__builtin_rintf(v1[j] * 255.0f), j, b1); }
                        if (bj == 0) { gq.x = b0; gq.y = b1; } else { gq.z = b0; gq.w = b1; } }
                    else { u32x4 w; w.x = cvt_pk_bf16(v0[0], v0[1]); w.y = cvt_pk_bf16(v0[2], v0[3]); w.z = cvt_pk_bf16(v1[0], v1[1]); w.w = cvt_pk_bf16(v1[2], v1[3]);
                        *(u32x4*)(rowp + bj * HALF) = w; } }
                if (TT >= 6) *(u32x4*)((unsigned char*)base + (size_t)(row0 + ai * HALF + m * 16) * GATE_PITCH + hh * 256 + (wc * 4 + fq) * 16) = gq;
                if (TT == 5) { ps += __shfl_xor(ps, 16); pq += __shfl_xor(pq, 16); ps += __shfl_xor(ps, 32); pq += __shfl_xor(pq, 32);
                    if (m == 0 || fq == m) { psm = ps; pqm = pq; }
                    if (m == 3) *(f32x2*)(sgst + ((size_t)((row0 + ai * HALF + fq * 16) * 8 + hh) * 4 + wc) * 2) = (f32x2){psm, pqm}; } }
    }
};
template <int MODE> struct EpiBr {
    static constexpr bool PERM = true, AFTER_DRAIN = false; static constexpr int NST = 0;
    bf16_t* T; const bf16_t* gate; const bf16_t* gate2;
    __device__ __forceinline__ void operator()(const f32x4 (&acc)[2][2][4][2], const Unit& u, int wr, int wc, int fr, int fq) const {
        const int row0 = u.pm * BM + wr * 64 + fr, col0 = u.pn * BM + wc * 32 + 8 * fq;
        const bool addp = (MODE == 1) || (MODE == 2 && u.z != 0); const bf16_t* const gt = (MODE == 2 && u.z != 0) ? gate2 : gate;
#pragma unroll
        for (int ai = 0; ai < 2; ++ai) {
            u32x4 gv[4], pv[4][2];
#pragma unroll
            for (int m = 0; m < 4; ++m) { gv[m] = *(const u32x4*)((const unsigned char*)gt + (size_t)(row0 + ai * HALF + m * 16) * GATE_PITCH + u.pn * 256 + (wc * 4 + fq) * 16);
#pragma unroll
                for (int bj = 0; bj < 2; ++bj) { const size_t off = (size_t)(row0 + ai * HALF + m * 16) * LDT + col0 + bj * HALF;
                    pv[m][bj] = addp ? *(const u32x4*)(T + off) : (u32x4){0u, 0u, 0u, 0u}; } }
#pragma unroll
            for (int m = 0; m < 4; ++m)
#pragma unroll
                for (int bj = 0; bj < 2; ++bj) { const size_t off = (size_t)(row0 + ai * HALF + m * 16) * LDT + col0 + bj * HALF; const unsigned g0 = bj ? gv[m].z : gv[m].x, g1 = bj ? gv[m].w : gv[m].y;
                    const f32x4 a0 = acc[ai][bj][m][0] * (1.0f / 255.0f), a1 = acc[ai][bj][m][1] * (1.0f / 255.0f);
                    float o[8] = {a0[0] * (float)(g0 & 255u), a0[1] * (float)((g0 >> 8) & 255u), a0[2] * (float)((g0 >> 16) & 255u), a0[3] * (float)(g0 >> 24), a1[0] * (float)(g1 & 255u), a1[1] * (float)((g1 >> 8) & 255u), a1[2] * (float)((g1 >> 16) & 255u), a1[3] * (float)(g1 >> 24)};
                    { const u32x4 pw = pv[m][bj];
                        o[0] += bf_lo(pw.x); o[1] += bf_hi(pw.x); o[2] += bf_lo(pw.y); o[3] += bf_hi(pw.y); o[4] += bf_lo(pw.z); o[5] += bf_hi(pw.z); o[6] += bf_lo(pw.w); o[7] += bf_hi(pw.w); }
                    u32x4 w; w.x = cvt_pk_bf16(o[0], o[1]); w.y = cvt_pk_bf16(o[2], o[3]); w.z = cvt_pk_bf16(o[4], o[5]); w.w = cvt_pk_bf16(o[6], o[7]);
                    *(u32x4*)(T + off) = w; }
            asm volatile("" ::: "memory"); }
    }
};
template <class Epi, class Sched, bool ALIGN_EPI = false, bool SP2 = false>
__device__ __forceinline__ void gemm_phase(PG8_LAS unsigned char* lds, const Gemm g, const Sched& S, const Epi& E) {
    int tid_l = threadIdx.x; asm volatile("" : "+v"(tid_l));
    const int tid = tid_l, wid = __builtin_amdgcn_readfirstlane(tid >> 6), lane = tid & 63, wr = wid >> 2, wc = wid & 3, fr = lane & 15, fq = lane >> 4;
    const int K = g.K, nt = K / BK;
    unsigned voffA, voffB;
    { int R, C; stage_rc(tid * 16, R, C); const int Rb = Epi::PERM ? ((R & ~31) + perm32(R & 31)) : R;
        voffA = (unsigned)(R * g.lda + C) * 2u; voffB = (unsigned)(Rb * g.ldb + C) * 2u; }
    const size_t voffA_step = (size_t)64 * g.lda * 2, voffB_step = (size_t)64 * g.ldb * 2;
    const size_t kstep = (size_t)(BK * 2);
    const size_t hstepA = (size_t)HALF * g.lda * 2, hstepB = (size_t)HALF * g.ldb * 2;
    const size_t tstepA = 2 * hstepA, tstepB = 2 * hstepB;
    const unsigned ldsw = (unsigned)wid * 1024u;
    const int aoff = lds_byte(wr * 64 + fr, fq * 8), boff = lds_byte(wc * 32 + fr, fq * 8);
#define PG8_SA(b, h) (((b) * 2 + (h)) * HTB)
#define PG8_SB(b, h) ((4 + (b) * 2 + (h)) * HTB)
#define PG8_STAGE(bufoff, gbase, voff) do { _Pragma("unroll") for (int _i = 0; _i < 2; ++_i) \
        __builtin_amdgcn_global_load_lds((const unsigned*)((const char*)(gbase) + _i * voff##_step + (voff)), (PG8_LAS unsigned*)(lds + (bufoff) + ldsw + _i * 8192), 16, 0, 0); } while (0)
#define PG8_LDA(dst, b, h) do { _Pragma("unroll") for (int m = 0; m < 4; ++m) _Pragma("unroll") for (int k = 0; k < 2; ++k) dst[m][k] = *(const PG8_LAS bf16x8*)(lds + PG8_SA(b, h) + aoff + m * 2048 + k * 1024); } while (0)
#define PG8_LDB(dst, b, h) do { _Pragma("unroll") for (int n = 0; n < 2; ++n) _Pragma("unroll") for (int k = 0; k < 2; ++k) dst[n][k] = *(const PG8_LAS bf16x8*)(lds + PG8_SB(b, h) + boff + n * 2048 + k * 1024); } while (0)
#define PG8_MMA(ai, bj, At, Bt) do { __builtin_amdgcn_s_setprio(1); _Pragma("unroll") for (int m = 0; m < 4; ++m) _Pragma("unroll") for (int n = 0; n < 2; ++n) _Pragma("unroll") for (int k = 0; k < 2; ++k) \
        acc[ai][bj][m][n] = __builtin_amdgcn_mfma_f32_16x16x32_bf16(Bt[n][k], At[m][k], acc[ai][bj][m][n], 0, 0, 0); __builtin_amdgcn_s_setprio(0); } while (0)
#define PG8_MMAZ(ai, bj, At, Bt) do { __builtin_amdgcn_s_setprio(1); _Pragma("unroll") for (int m = 0; m < 4; ++m) _Pragma("unroll") for (int n = 0; n < 2; ++n) { \
        acc[ai][bj][m][n] = __builtin_amdgcn_mfma_f32_16x16x32_bf16(Bt[n][0], At[m][0], (f32x4){0.f, 0.f, 0.f, 0.f}, 0, 0, 0); \
        acc[ai][bj][m][n] = __builtin_amdgcn_mfma_f32_16x16x32_bf16(Bt[n][1], At[m][1], acc[ai][bj][m][n], 0, 0, 0); } __builtin_amdgcn_s_setprio(0); } while (0)
#define PG8_WAIT_V(n) asm volatile("s_waitcnt vmcnt(" #n ")" ::: "memory")
#define PG8_WAIT_L(n) asm volatile("s_waitcnt lgkmcnt(" #n ")" ::: "memory")
#define PG8_BAR __builtin_amdgcn_s_barrier()
#define PG8_SCHED __builtin_amdgcn_sched_barrier(0)
    Unit cur, nxt; int ui = 0;
    if (!S.next(0, cur)) return;
    f32x4 acc[2][2][4][2];
    if constexpr (!SP2) {
#pragma unroll
    for (int a = 0; a < 2; ++a)
#pragma unroll
        for (int b = 0; b < 2; ++b)
#pragma unroll
            for (int m = 0; m < 4; ++m)
#pragma unroll
                for (int n = 0; n < 2; ++n) acc[a][b][m][n] = (f32x4){0.f, 0.f, 0.f, 0.f};
    }
    bf16x8 At[4][2], B0[2][2], B1[2][2];
    const char* cA = (const char*)S.opA(g, cur) + (size_t)cur.pm * tstepA; const char* cB = (const char*)S.opB(g, cur) + (size_t)cur.pn * tstepB;
    S.a_ready(cur);
    if constexpr (SP2) {
        PG8_STAGE(PG8_SB(0, 0), cB, voffB); PG8_STAGE(PG8_SB(0, 1), cB + hstepB, voffB); PG8_STAGE(PG8_SA(0, 0), cA, voffA); PG8_STAGE(PG8_SA(0, 1), cA + hstepA, voffA);
        if (wr == 1) PG8_BAR;
        PG8_WAIT_V(2); PG8_BAR;
        PG8_STAGE(PG8_SB(1, 0), cB + kstep, voffB); PG8_STAGE(PG8_SA(1, 0), cA + kstep, voffA); PG8_STAGE(PG8_SB(1, 1), cB + hstepB + kstep, voffB);
        if (Epi::NST > 0) PG8_WAIT_V(0); else PG8_WAIT_V(6);
        PG8_BAR;
    } else {
        PG8_STAGE(PG8_SB(0, 0), cB, voffB); PG8_STAGE(PG8_SA(0, 0), cA, voffA); PG8_STAGE(PG8_SB(0, 1), cB + hstepB, voffB); PG8_STAGE(PG8_SA(0, 1), cA + hstepA, voffA);
        if (wr == 1) PG8_BAR;
        PG8_WAIT_V(4); PG8_BAR;
        PG8_STAGE(PG8_SB(1, 0), cB + kstep, voffB); PG8_STAGE(PG8_SA(1, 0), cA + kstep, voffA); PG8_STAGE(PG8_SB(1, 1), cB + hstepB + kstep, voffB);
        PG8_WAIT_V(6); PG8_BAR;
    }
    for (;;) {
        const bool has_next = S.next(ui + 1, nxt);
        const char* nA = has_next ? (const char*)S.opA(g, nxt) + (size_t)nxt.pm * tstepA : cA; const char* nB = has_next ? (const char*)S.opB(g, nxt) + (size_t)nxt.pn * tstepB : cB;
#define PG8_TRIP_HEAD(T) const int t = (T); const bool last = (t == nt - 2); \
            const char* a1 = cA + (size_t)(t + 1) * kstep; \
            const char* a2 = last ? nA : cA + (size_t)(t + 2) * kstep; const char* b2 = last ? nB : cB + (size_t)(t + 2) * kstep; \
            const char* a3 = a2 + kstep; const char* b3 = b2 + kstep; \
            if (last && has_next) S.a_ready(nxt);
#define PG8_TRIP_SP2(W12, MM0) \
            PG8_LDB(B0, 0, 0); PG8_LDB(B1, 0, 1); PG8_SCHED; PG8_LDA(At, 0, 0); PG8_STAGE(PG8_SA(1, 1), a1 + hstepA, voffA); \
            W12; PG8_WAIT_L(0); PG8_BAR; MM0(0, 0, At, B0); MM0(0, 1, At, B1); PG8_BAR; PG8_SCHED; \
            PG8_LDA(At, 0, 1); PG8_STAGE(PG8_SB(0, 0), b2, voffB); PG8_STAGE(PG8_SB(0, 1), b2 + hstepB, voffB); PG8_STAGE(PG8_SA(0, 0), a2, voffA); \
            W12; PG8_WAIT_L(0); PG8_BAR; MM0(1, 0, At, B0); MM0(1, 1, At, B1); PG8_BAR; PG8_SCHED; \
            PG8_LDB(B0, 1, 0); PG8_LDB(B1, 1, 1); PG8_SCHED; PG8_LDA(At, 1, 0); PG8_STAGE(PG8_SA(0, 1), a2 + hstepA, voffA); \
            PG8_WAIT_V(8); PG8_WAIT_L(0); PG8_BAR; PG8_MMA(0, 0, At, B0); PG8_MMA(0, 1, At, B1); PG8_BAR; PG8_SCHED; \
            PG8_LDA(At, 1, 1); PG8_STAGE(PG8_SB(1, 0), b3, voffB); PG8_STAGE(PG8_SB(1, 1), b3 + hstepB, voffB); PG8_STAGE(PG8_SA(1, 0), a3, voffA); \
            PG8_WAIT_V(8); PG8_WAIT_L(0); PG8_BAR; PG8_MMA(1, 0, At, B0); PG8_MMA(1, 1, At, B1); PG8_BAR; PG8_SCHED;
        if constexpr (SP2) {
            { PG8_TRIP_HEAD(0) PG8_TRIP_SP2(asm volatile("s_waitcnt vmcnt(%0)" :: "n"(8 + Epi::NST) : "memory"), PG8_MMAZ) }
            for (int tt = 2; tt < nt; tt += 2) { PG8_TRIP_HEAD(tt) PG8_TRIP_SP2(PG8_WAIT_V(8), PG8_MMA) }
        } else {
        for (int tt = 0; tt < nt; tt += 2) { PG8_TRIP_HEAD(tt)
            PG8_LDB(B0, 0, 0); PG8_SCHED; PG8_LDA(At, 0, 0); PG8_STAGE(PG8_SA(1, 1), a1 + hstepA, voffA);
            PG8_WAIT_L(8); PG8_BAR; PG8_WAIT_L(0); PG8_MMA(0, 0, At, B0); PG8_BAR; PG8_SCHED;
            PG8_LDB(B1, 0, 1); PG8_STAGE(PG8_SB(0, 0), b2, voffB);
            PG8_BAR; PG8_WAIT_L(0); PG8_MMA(0, 1, At, B1); PG8_BAR;
            PG8_LDA(At, 0, 1); PG8_STAGE(PG8_SA(0, 0), a2, voffA);
            PG8_BAR; PG8_WAIT_L(0); PG8_MMA(1, 0, At, B0); PG8_BAR; PG8_SCHED;
            PG8_STAGE(PG8_SB(0, 1), b2 + hstepB, voffB);
            PG8_WAIT_V(6); PG8_BAR; PG8_MMA(1, 1, At, B1); PG8_BAR;
            PG8_LDB(B0, 1, 0); PG8_SCHED; PG8_LDA(At, 1, 0); PG8_STAGE(PG8_SA(0, 1), a2 + hstepA, voffA);
            PG8_WAIT_L(8); PG8_BAR; PG8_WAIT_L(0); PG8_MMA(0, 0, At, B0); PG8_BAR; PG8_SCHED;
            PG8_LDB(B1, 1, 1); PG8_STAGE(PG8_SB(1, 0), b3, voffB);
            PG8_BAR; PG8_WAIT_L(0); PG8_MMA(0, 1, At, B1); PG8_BAR;
            PG8_LDA(At, 1, 1); PG8_STAGE(PG8_SA(1, 0), a3, voffA);
            PG8_BAR; PG8_WAIT_L(0); PG8_MMA(1, 0, At, B0); PG8_BAR; PG8_SCHED;
            PG8_STAGE(PG8_SB(1, 1), b3 + hstepB, voffB);
            PG8_WAIT_V(6); PG8_BAR; PG8_MMA(1, 1, At, B1); PG8_BAR;
        }
        }
#undef PG8_TRIP_HEAD
#undef PG8_TRIP_SP2
        if constexpr (ALIGN_EPI) { if (wr == 0) PG8_BAR; }
        if constexpr (!Epi::AFTER_DRAIN) { E(acc, cur, wr, wc, fr, fq); S.done(cur); }
        if (!has_next) break;
        if constexpr (!SP2) {
#pragma unroll
        for (int a = 0; a < 2; ++a)
#pragma unroll
            for (int b = 0; b < 2; ++b)
#pragma unroll
                for (int m = 0; m < 4; ++m)
#pragma unroll
                    for (int n = 0; n < 2; ++n) acc[a][b][m][n] = (f32x4){0.f, 0.f, 0.f, 0.f};
        }
        cur = nxt; cA = nA; cB = nB; ++ui;
        if constexpr (ALIGN_EPI) { if (wr == 1) PG8_BAR; }
    }
    PG8_WAIT_V(0);
    if constexpr (!ALIGN_EPI) { if (wr == 0) PG8_BAR; }
    PG8_BAR;
    if constexpr (Epi::AFTER_DRAIN) { E.fused(acc, cur, wr, wc, fr, fq, lds, wid, lane); S.done(cur); }
#undef PG8_SA
#undef PG8_SB
#undef PG8_STAGE
#undef PG8_LDA
#undef PG8_LDB
#undef PG8_MMA
#undef PG8_MMAZ
#undef PG8_WAIT_V
#undef PG8_WAIT_L
#undef PG8_BAR
#undef PG8_SCHED
}
}
#define GAS __attribute__((address_space(1)))
#define LAS __attribute__((address_space(3)))
typedef unsigned short bf16;
typedef unsigned v4u __attribute__((ext_vector_type(4)));
typedef float f32x4 __attribute__((ext_vector_type(4)));
typedef short bf16x8 __attribute__((ext_vector_type(8)));
typedef GAS unsigned gu32;
typedef GAS unsigned long long gu64;
#define RLX_AGENT __ATOMIC_RELAXED, __HIP_MEMORY_SCOPE_AGENT
#define LDS_WAIT() asm volatile("s_waitcnt lgkmcnt(0)" ::: "memory")
#define VM_WAIT() asm volatile("s_waitcnt vmcnt(0)" ::: "memory")
__device__ __forceinline__ unsigned long long rt() { return __builtin_amdgcn_s_memrealtime(); }
__device__ __forceinline__ unsigned f2bf(float f) { unsigned u = __builtin_bit_cast(unsigned, f); return (u + 0x7fffu + ((u >> 16) & 1u)) >> 16; }
__device__ __forceinline__ unsigned pk2(float lo, float hi) { return f2bf(lo) | (f2bf(hi) << 16); }
#define XB_TMO      128
#define XB_XCNT(j)  (256  + 64 * (j))
#define XB_XSUB(j)  (1280 + 64 * (j))
#define XB_XGEN(j)  (2304 + 64 * (j))
#define XB_TOP      3328
#define XB_TOPGEN   3392
#define XCD_BAR_WORDS 3456
#define XB_SPIN_CAP (1u << 18)

__device__ __forceinline__ unsigned xb_ld(unsigned* p)              { return __hip_atomic_load(p, __ATOMIC_RELAXED, __HIP_MEMORY_SCOPE_AGENT); }
__device__ __forceinline__ unsigned xb_add(unsigned* p, unsigned v) { return __hip_atomic_fetch_add(p, v, __ATOMIC_RELAXED, __HIP_MEMORY_SCOPE_AGENT); }
__device__ __forceinline__ unsigned xb_xcc_id() { return (unsigned)__builtin_amdgcn_s_getreg((3 << 11) | 20) & 0xFu; }
#define XB_SPIN(cond, bar) do { unsigned _sp = 0; while (cond) { __builtin_amdgcn_s_sleep(1); \
    if ((++_sp & 255u) == 0u) { if (xb_ld(&(bar)[XB_TMO])) break; if (_sp > XB_SPIN_CAP) { atomicAdd(&(bar)[XB_TMO], 1u); break; } } } } while (0)

struct XcdBarrier {
    unsigned* bar; unsigned x;
    volatile LAS unsigned* st;
};

__device__ __forceinline__ XcdBarrier xcd_barrier_post(unsigned* bar, volatile LAS unsigned* st) {
    XcdBarrier b; b.bar = bar; b.x = xb_xcc_id(); b.st = st;
    if (threadIdx.x == 0) (void)xb_add(&bar[XB_XCNT(b.x)], 1u);
    return b;
}
__device__ __forceinline__ void xcd_barrier_complete(unsigned* bar, unsigned x, unsigned& nloc, unsigned& nx) {
    const unsigned G = gridDim.x * gridDim.y * gridDim.z;
    unsigned sum, cnt, mine, sp = 0u;
    for (;;) {
        sum = 0u; cnt = 0u; mine = 0u;
#pragma unroll
        for (unsigned j = 0; j < 16; ++j) { const unsigned c = xb_ld(&bar[XB_XCNT(j)]); sum += c; cnt += (c > 0u) ? 1u : 0u; mine = (j == x) ? c : mine; }
        if (sum == G) break;
        __builtin_amdgcn_s_sleep(1);
        if ((++sp & 255u) == 0u) { if (xb_ld(&bar[XB_TMO])) break; if (sp > XB_SPIN_CAP) { atomicAdd(&bar[XB_TMO], 1u); break; } }
    }
    nloc = mine > 0u ? mine : 1u; nx = cnt > 0u ? cnt : 1u;
}

__device__ __forceinline__ void xcd_barrier(const XcdBarrier& b) {
    asm volatile("s_waitcnt vmcnt(0)" ::: "memory");
    __syncthreads();
    if (threadIdx.x == 0) {
        unsigned* bar = b.bar; const unsigned bx_ = xb_xcc_id();
        __builtin_amdgcn_s_waitcnt(0);
        unsigned nloc = b.st[0], nx = b.st[1];
        if (nloc == 0u) { xcd_barrier_complete(bar, bx_, nloc, nx); b.st[0] = nloc; b.st[1] = nx; }
        const unsigned old = xb_add(&bar[XB_XSUB(bx_)], 1u);
        const unsigned gen = old / nloc;
        if (old + 1u == (gen + 1u) * nloc) {
            __builtin_amdgcn_fence(__ATOMIC_RELEASE, "agent");
            asm volatile("s_waitcnt vmcnt(0)" ::: "memory");
            const unsigned og = xb_add(&bar[XB_TOP], 1u);
            const unsigned tg = og / nx;
            if (og + 1u == (tg + 1u) * nx) xb_add(&bar[XB_TOPGEN], 1u);
            else XB_SPIN(xb_ld(&bar[XB_TOPGEN]) == tg, bar);
            __builtin_amdgcn_fence(__ATOMIC_ACQUIRE, "agent");
            xb_add(&bar[XB_XGEN(bx_)], 1u);
            asm volatile("s_waitcnt vmcnt(0)" ::: "memory");
        } else {
            XB_SPIN(xb_ld(&bar[XB_XGEN(bx_)]) == gen, bar);
            __builtin_amdgcn_fence(__ATOMIC_ACQUIRE, "agent");
            asm volatile("s_waitcnt vmcnt(0)" ::: "memory");
        }
    }
    __syncthreads();
}

constexpr int NWAVES = 8;
constexpr int BATCH = 4, SEQ = 8192, D = 2048, DEPTH = 4, HEADS = 8, FF = 5632, INCOLS = 16384, NCHUNK = SEQ / 128;
constexpr int M = BATCH * SEQ;
constexpr float EPS = 1e-6f;
constexpr size_t MiB = 1u << 20;
constexpr size_t WS_CTL = 0, CTL_ZERO_BYTES = 1 * MiB;
constexpr size_t WS_CS = 1 * MiB;
constexpr size_t WS_WMASK = 33 * MiB;
constexpr size_t WS_WGU1 = 34 * MiB, WS_WD1 = 78 * MiB, WS_WIN = 100 * MiB, WS_WBR = 164 * MiB, WS_WBS = 172 * MiB, WS_WOUT = 180 * MiB, WS_WGU2 = 188 * MiB, WS_WD2 = 232 * MiB;
constexpr size_t WS_H = 256 * MiB;
constexpr size_t WS_BIG = 392 * MiB;
constexpr size_t WS_RT = 1452 * MiB;
constexpr size_t WS_SGST = WS_RT + 96 * MiB;
constexpr size_t WS_OPRE = WS_RT + 112 * MiB;
constexpr size_t WS_END = 1708 * MiB;
constexpr int LDT = pg8::LDT;
constexpr size_t TSTRIDE = (size_t)M * LDT;
constexpr int CW_BAR = 4096;
constexpr size_t WS_SSQ = WS_RT + 32 * MiB, SSQ_STRIDE = (size_t)M * 32;
constexpr int RING_BYTES = 131072;
constexpr int LDSCTL_OFF = RING_BYTES, MISC_OFF = LDSCTL_OFF + 320;
constexpr int RS_OFF = RING_BYTES + 1024;
constexpr int LDS_BYTES = 147456;

typedef short s16x4 __attribute__((ext_vector_type(4)));
typedef short v4i16_t __attribute__((ext_vector_type(4)));
typedef unsigned u32x2 __attribute__((ext_vector_type(2)));
typedef float f32x2v __attribute__((ext_vector_type(2)));

__device__ __forceinline__ float wave_sum(float v) {
#pragma unroll
    for (int o = 1; o < 64; o <<= 1) v += __shfl_xor(v, o);
    return v;
}
typedef float f32x2_t __attribute__((ext_vector_type(2))); typedef __bf16 bf16x2_t __attribute__((ext_vector_type(2)));
__device__ __forceinline__ unsigned cvtpk(float lo, float hi) { f32x2_t v = {lo, hi}; bf16x2_t b = __builtin_convertvector(v, bf16x2_t); return __builtin_bit_cast(unsigned, b); }
__device__ __forceinline__ float bflo(unsigned u) { return __uint_as_float(u << 16); }
__device__ __forceinline__ float bfhi(unsigned u) { return __uint_as_float(u & 0xffff0000u); }
__device__ __forceinline__ s16x4 vtr(const LAS unsigned char* p) { return __builtin_bit_cast(s16x4, __builtin_amdgcn_ds_read_tr16_b64_v4i16((LAS v4i16_t*)p)); }
__device__ __forceinline__ bf16x8 lds_tr_frag(const LAS unsigned char* tile, int strideB, int k0, int c0, int lane) {
    const int g = lane >> 4, q = (lane & 15) >> 2, p = lane & 3;
    const LAS unsigned char* a = tile + (k0 + 8 * g + q) * strideB + (c0 + 4 * p) * 2;
    const s16x4 lo = vtr(a), hi = vtr(a + 4 * strideB);
    return __builtin_shufflevector(lo, hi, 0, 1, 2, 3, 4, 5, 6, 7);
}
__device__ __forceinline__ bf16x8 lds_tr_frag_c(const LAS unsigned char* tile, int strideB, int k0, int c0, int lane) {
    const int g = lane >> 4, q = (lane & 15) >> 2, p = lane & 3;
    const LAS unsigned char* a = tile + (k0 + 4 * g + q) * strideB + (c0 + 4 * p) * 2;
    const s16x4 lo = vtr(a), hi = vtr(a + 16 * strideB);
    return __builtin_shufflevector(lo, hi, 0, 1, 2, 3, 4, 5, 6, 7);
}
#define MFMA16(a, b, c) __builtin_amdgcn_mfma_f32_16x16x32_bf16((a), (b), (c), 0, 0, 0)
__device__ __forceinline__ float log2_gamma(int h) {
    const float x = __builtin_amdgcn_exp2f(-5.0f - (float)h);
    const float l = -x * (1.0f + x * (0.5f + x * (0.33333334f + x * (0.25f + x * (0.2f + x * 0.16666667f)))));
    return l * 1.44269504f;
}

__device__ __forceinline__ void conv_item(const float* W, int K, int N, bf16* WT, int mode, const float* gain, LAS float* scr, int item, int lane) {
    const int nblk = N / 32, kb = item / nblk, nb = item % nblk, k0 = 64 * kb, n0 = 32 * nb;
#pragma unroll
    for (int i = 0; i < 8; ++i) { const int kk = 8 * i + (lane >> 3), nn = 4 * (lane & 7);
        const f32x4 v = *(const f32x4*)(W + (size_t)(k0 + kk) * N + n0 + nn);
        LAS float* d = scr + kk * 33 + nn; d[0] = v[0]; d[1] = v[1]; d[2] = v[2]; d[3] = v[3]; }
    LDS_WAIT(); asm volatile("" ::: "memory");
    int r0 = n0;
    if (mode == 3) r0 = ((((n0 >> 11) + 5) & 7) << 11) + (n0 & 2047);
    if (mode == 1) { const int isg = n0 >= FF, j0 = isg ? n0 - FF : n0; r0 = 256 * (j0 >> 7) + (j0 & 127) + (isg ? 128 : 0); }
    const int c = lane & 7;
    f32x4 ga = {1.f, 1.f, 1.f, 1.f}, gb = {1.f, 1.f, 1.f, 1.f};
    if (gain) { ga = *(const f32x4*)(gain + k0 + 8 * c); gb = *(const f32x4*)(gain + k0 + 8 * c + 4); }
#pragma unroll
    for (int j = 0; j < 4; ++j) { const int n = (lane >> 3) + 8 * j; const LAS float* s = scr + (8 * c) * 33 + n;
        v4u o; o.x = pk2(s[0 * 33] * ga[0], s[1 * 33] * ga[1]); o.y = pk2(s[2 * 33] * ga[2], s[3 * 33] * ga[3]); o.z = pk2(s[4 * 33] * gb[0], s[5 * 33] * gb[1]); o.w = pk2(s[6 * 33] * gb[2], s[7 * 33] * gb[3]);
        *(GAS v4u*)(WT + (size_t)(r0 + n) * K + k0 + 8 * c) = o; }
    LDS_WAIT(); asm volatile("" ::: "memory");
}
struct ConvSrc { const float *gu1, *d1, *win, *br, *bs, *wo, *gu2, *d2, *sw, *g1, *gm, *g2; };
__device__ __forceinline__ void phase_conv(LAS unsigned char* lds, unsigned char* ws, const ConvSrc& s, int gw, int NGW, int wave, int lane) {
    asm volatile("" : "+v"(lane));
    LAS float* scr = (LAS float*)(lds + wave * 16384);
    constexpr int I_GU = (D / 64) * (2 * FF / 32), I_D = (FF / 64) * (D / 32), I_IN = (D / 64) * (INCOLS / 32), I_SQ = (D / 64) * (D / 32);
    constexpr int NITEMS = 2 * I_GU + 2 * I_D + I_IN + 3 * I_SQ;
    for (int it = gw; it < NITEMS; it += NGW) {
        int r = it;
        if (r < I_GU) { conv_item(s.gu1, D, 2 * FF, (bf16*)(ws + WS_WGU1), 1, s.g1, scr, r, lane); continue; } r -= I_GU;
        if (r < I_GU) { conv_item(s.gu2, D, 2 * FF, (bf16*)(ws + WS_WGU2), 1, s.g2, scr, r, lane); continue; } r -= I_GU;
        if (r < I_D) { conv_item(s.d1, FF, D, (bf16*)(ws + WS_WD1), 0, nullptr, scr, r, lane); continue; } r -= I_D;
        if (r < I_D) { conv_item(s.d2, FF, D, (bf16*)(ws + WS_WD2), 0, nullptr, scr, r, lane); continue; } r -= I_D;
        if (r < I_IN) { conv_item(s.win, D, INCOLS, (bf16*)(ws + WS_WIN), 3, s.gm, scr, r, lane); continue; } r -= I_IN;
        if (r < I_SQ) { conv_item(s.br, D, D, (bf16*)(ws + WS_WBR), 0, nullptr, scr, r, lane); continue; } r -= I_SQ;
        if (r < I_SQ) { conv_item(s.bs, D, D, (bf16*)(ws + WS_WBS), 0, nullptr, scr, r, lane); continue; } r -= I_SQ;
        conv_item(s.wo, D, D, (bf16*)(ws + WS_WOUT), 0, nullptr, scr, r, lane);
    }
    bf16* wm = (bf16*)(ws + WS_WMASK);
    for (int e = gw * 64 + lane; e < 8 * 128 * 128; e += NGW * 64) { const int j = e & 127, i = (e >> 7) & 127; wm[e] = (bf16)((j <= i) ? f2bf(s.sw[e]) : 0u); }
}
__device__ __forceinline__ void phase_final(const bf16* Xb, float* out, const float* gain, int gw, int NGW, int lane) {
    asm volatile("" : "+v"(lane));
    f32x4 g0[4], g1[4];
#pragma unroll
    for (int j = 0; j < 4; ++j) { g0[j] = *(const f32x4*)(gain + (lane + 64 * j) * 8); g1[j] = *(const f32x4*)(gain + (lane + 64 * j) * 8 + 4); }
    for (int m = gw; m < M; m += NGW) {
        const v4u* xr = (const v4u*)(Xb + (size_t)m * LDT) + lane;
        float x[4][8]; float s = 0.f;
#pragma unroll
        for (int j = 0; j < 4; ++j) { const v4u w = xr[64 * j];
            x[j][0] = bflo(w.x); x[j][1] = bfhi(w.x); x[j][2] = bflo(w.y); x[j][3] = bfhi(w.y); x[j][4] = bflo(w.z); x[j][5] = bfhi(w.z); x[j][6] = bflo(w.w); x[j][7] = bfhi(w.w);
#pragma unroll
            for (int e = 0; e < 8; ++e) s += x[j][e] * x[j][e]; }
        const float rs = 1.0f / sqrtf(wave_sum(s) * (1.0f / D) + EPS);
        float* orow = out + (size_t)m * D;
#pragma unroll
        for (int j = 0; j < 4; ++j) { f32x4 o0, o1;
            o0[0] = x[j][0] * rs * g0[j][0]; o0[1] = x[j][1] * rs * g0[j][1]; o0[2] = x[j][2] * rs * g0[j][2]; o0[3] = x[j][3] * rs * g0[j][3];
            o1[0] = x[j][4] * rs * g1[j][0]; o1[1] = x[j][5] * rs * g1[j][1]; o1[2] = x[j][6] * rs * g1[j][2]; o1[3] = x[j][7] * rs * g1[j][3];
            *(f32x4*)(orow + (lane + 64 * j) * 8) = o0; *(f32x4*)(orow + (lane + 64 * j) * 8 + 4) = o1; }
    }
}
#define LDS_BARRIER() do { asm volatile("s_waitcnt lgkmcnt(0)" ::: "memory"); __builtin_amdgcn_s_barrier(); asm volatile("" ::: "memory"); } while (0)
__device__ __forceinline__ bf16x8 lds_tr_pair(const LAS unsigned char* tile, int strideB, int r0, int r1, int c0, int lane) {
    const int q = (lane & 15) >> 2, p = lane & 3;
    const s16x4 lo = vtr(tile + (r0 + q) * strideB + (c0 + 4 * p) * 2), hi = vtr(tile + (r1 + q) * strideB + (c0 + 4 * p) * 2);
    return __builtin_shufflevector(lo, hi, 0, 1, 2, 3, 4, 5, 6, 7);
}
__device__ __forceinline__ void phase_ret(LAS unsigned char* lds, const bf16* Q, const bf16* Kb, const bf16* V, bf16* Opre, float* stats, int vcu, int G, int tid) {
    asm volatile("" : "+v"(tid));
    const int lane = tid & 63, w = __builtin_amdgcn_readfirstlane(tid >> 6), i16 = lane & 15, g4 = lane >> 4;
    const int ib = (w < 4) ? w : 11 - w;
    LAS unsigned char* K_t = lds;
    LAS unsigned char* V_t = lds + 69632;
    LAS unsigned char* RT_t = lds + 94208;
    for (int u = vcu; u < BATCH * HEADS * 8; u += G) {
        const int es = u & 7, h = (u >> 3) & 7, b = u >> 6, hc = h * 256;
        const float lg2 = log2_gamma(h), gamma_c = __builtin_amdgcn_exp2f(128.0f * lg2);
        const size_t tb = (size_t)b * SEQ;
        f32x4 r[2][2];
#pragma unroll
        for (int a = 0; a < 2; ++a)
#pragma unroll
            for (int c = 0; c < 2; ++c) r[a][c] = (f32x4){0.f, 0.f, 0.f, 0.f};
        { v4u zz = (v4u){0u, 0u, 0u, 0u}; asm volatile("" : "+v"(zz));
          int tz = tid; asm volatile("" : "+v"(tz));
          for (int c = tz; c < 17408 / 16; c += NWAVES * 64) *(LAS v4u*)(RT_t + c * 16) = zz; }
        v4u kpre[8], vpre;
        const bf16* kg = Kb + (tb + (tid >> 5)) * LDT + hc + (tid & 31) * 8;
        const bf16* vg = V + (tb + (tid >> 2)) * LDT + hc + 32 * es + (tid & 3) * 8;
        const bf16* qg = Q + (tb + 16 * ib + i16) * LDT + hc + 8 * g4;
#pragma unroll
        for (int k = 0; k < 8; ++k) kpre[k] = *(const v4u*)(kg + (size_t)k * 16 * LDT);
        vpre = *(const v4u*)vg;
        const int i = 16 * ib + i16;
        bf16x8 qf[8];
#pragma unroll
        for (int ks = 0; ks < 8; ++ks) qf[ks] = *(const bf16x8*)(qg + 32 * ks);
        for (int n = 0; n < NCHUNK; ++n) {
            LDS_BARRIER();
#pragma unroll
            for (int k = 0; k < 8; ++k) *(LAS v4u*)(K_t + ((tid >> 5) + 16 * k) * 544 + (tid & 31) * 16) = kpre[k];
            *(LAS v4u*)(V_t + (tid >> 2) * 96 + (tid & 3) * 16) = vpre;
            {
                const size_t adv = (size_t)((n + 1 < NCHUNK) ? n + 1 : n) * 128 * LDT;
#pragma unroll
                for (int k = 0; k < 8; ++k) kpre[k] = *(const v4u*)(kg + adv + (size_t)k * 16 * LDT);
                vpre = *(const v4u*)(vg + adv);
            }
            LDS_BARRIER();
            const LAS unsigned char* RT_c = RT_t + (n & 1) * 17408; LAS unsigned char* RT_n = RT_t + ((n & 1) ^ 1) * 17408;
#define RET_ST_BLOCK1(S0, AD) do { bf16x8 k0_, k1_, k2_, k3_, k4_, k5_, k6_, k7_; asm volatile( \
                "ds_read_b128 %[k0], %[ad] offset:0\n\t" \
                "ds_read_b128 %[k1], %[ad] offset:64\n\t" \
                "ds_read_b128 %[k2], %[ad] offset:128\n\t" \
                "ds_read_b128 %[k3], %[ad] offset:192\n\t" \
                "ds_read_b128 %[k4], %[ad] offset:256\n\t" \
                "ds_read_b128 %[k5], %[ad] offset:320\n\t" \
                "ds_read_b128 %[k6], %[ad] offset:384\n\t" \
                "ds_read_b128 %[k7], %[ad] offset:448\n\t" \
                "s_waitcnt lgkmcnt(7)\n\t" \
                "v_mfma_f32_16x16x32_bf16 %[s0], %[k0], %[q0], 0\n\t" \
                "s_waitcnt lgkmcnt(6)\n\t" \
                "v_mfma_f32_16x16x32_bf16 %[s0], %[k1], %[q1], %[s0]\n\t" \
                "s_waitcnt lgkmcnt(5)\n\t" \
                "v_mfma_f32_16x16x32_bf16 %[s0], %[k2], %[q2], %[s0]\n\t" \
                "s_waitcnt lgkmcnt(4)\n\t" \
                "v_mfma_f32_16x16x32_bf16 %[s0], %[k3], %[q3], %[s0]\n\t" \
                "s_waitcnt lgkmcnt(3)\n\t" \
                "v_mfma_f32_16x16x32_bf16 %[s0], %[k4], %[q4], %[s0]\n\t" \
                "s_waitcnt lgkmcnt(2)\n\t" \
                "v_mfma_f32_16x16x32_bf16 %[s0], %[k5], %[q5], %[s0]\n\t" \
                "s_waitcnt lgkmcnt(1)\n\t" \
                "v_mfma_f32_16x16x32_bf16 %[s0], %[k6], %[q6], %[s0]\n\t" \
                "s_waitcnt lgkmcnt(0)\n\t" \
                "v_mfma_f32_16x16x32_bf16 %[s0], %[k7], %[q7], %[s0]\n\t" \
                "s_nop 7\n\t" \
                "s_nop 7\n\t" \
                "s_nop 7\n\t" \
                : [s0] "=&v"(S0), [k0] "=&v"(k0_), [k1] "=&v"(k1_), [k2] "=&v"(k2_), [k3] "=&v"(k3_), [k4] "=&v"(k4_), [k5] "=&v"(k5_), [k6] "=&v"(k6_), [k7] "=&v"(k7_) \
                : [ad] "v"(AD), [q0] "v"(qf[0]), [q1] "v"(qf[1]), [q2] "v"(qf[2]), [q3] "v"(qf[3]), [q4] "v"(qf[4]), [q5] "v"(qf[5]), [q6] "v"(qf[6]), [q7] "v"(qf[7]) : "memory"); } while (0)
#define RET_ST_BLOCK2(S0, S1, AD) do { bf16x8 k0_, k1_, k2_, k3_, k4_, k5_, k6_, k7_; asm volatile( \
                "ds_read_b128 %[k0], %[ad] offset:0\n\t" \
                "ds_read_b128 %[k1], %[ad] offset:8704\n\t" \
                "ds_read_b128 %[k2], %[ad] offset:64\n\t" \
                "ds_read_b128 %[k3], %[ad] offset:8768\n\t" \
                "ds_read_b128 %[k4], %[ad] offset:128\n\t" \
                "ds_read_b128 %[k5], %[ad] offset:8832\n\t" \
                "ds_read_b128 %[k6], %[ad] offset:192\n\t" \
                "ds_read_b128 %[k7], %[ad] offset:8896\n\t" \
                "s_waitcnt lgkmcnt(7)\n\t" \
                "v_mfma_f32_16x16x32_bf16 %[s0], %[k0], %[q0], 0\n\t" \
                "ds_read_b128 %[k0], %[ad] offset:256\n\t" \
                "s_waitcnt lgkmcnt(7)\n\t" \
                "v_mfma_f32_16x16x32_bf16 %[s1], %[k1], %[q0], 0\n\t" \
                "ds_read_b128 %[k1], %[ad] offset:8960\n\t" \
                "s_waitcnt lgkmcnt(7)\n\t" \
                "v_mfma_f32_16x16x32_bf16 %[s0], %[k2], %[q1], %[s0]\n\t" \
                "ds_read_b128 %[k2], %[ad] offset:320\n\t" \
                "s_waitcnt lgkmcnt(7)\n\t" \
                "v_mfma_f32_16x16x32_bf16 %[s1], %[k3], %[q1], %[s1]\n\t" \
                "ds_read_b128 %[k3], %[ad] offset:9024\n\t" \
                "s_waitcnt lgkmcnt(7)\n\t" \
                "v_mfma_f32_16x16x32_bf16 %[s0], %[k4], %[q2], %[s0]\n\t" \
                "ds_read_b128 %[k4], %[ad] offset:384\n\t" \
                "s_waitcnt lgkmcnt(7)\n\t" \
                "v_mfma_f32_16x16x32_bf16 %[s1], %[k5], %[q2], %[s1]\n\t" \
                "ds_read_b128 %[k5], %[ad] offset:9088\n\t" \
                "s_waitcnt lgkmcnt(7)\n\t" \
                "v_mfma_f32_16x16x32_bf16 %[s0], %[k6], %[q3], %[s0]\n\t" \
                "ds_read_b128 %[k6], %[ad] offset:448\n\t" \
                "s_waitcnt lgkmcnt(7)\n\t" \
                "v_mfma_f32_16x16x32_bf16 %[s1], %[k7], %[q3], %[s1]\n\t" \
                "ds_read_b128 %[k7], %[ad] offset:9152\n\t" \
                "s_waitcnt lgkmcnt(7)\n\t" \
                "v_mfma_f32_16x16x32_bf16 %[s0], %[k0], %[q4], %[s0]\n\t" \
                "s_waitcnt lgkmcnt(6)\n\t" \
                "v_mfma_f32_16x16x32_bf16 %[s1], %[k1], %[q4], %[s1]\n\t" \
                "s_waitcnt lgkmcnt(5)\n\t" \
                "v_mfma_f32_16x16x32_bf16 %[s0], %[k2], %[q5], %[s0]\n\t" \
                "s_waitcnt lgkmcnt(4)\n\t" \
                "v_mfma_f32_16x16x32_bf16 %[s1], %[k3], %[q5], %[s1]\n\t" \
                "s_waitcnt lgkmcnt(3)\n\t" \
                "v_mfma_f32_16x16x32_bf16 %[s0], %[k4], %[q6], %[s0]\n\t" \
                "s_waitcnt lgkmcnt(2)\n\t" \
                "v_mfma_f32_16x16x32_bf16 %[s1], %[k5], %[q6], %[s1]\n\t" \
                "s_waitcnt lgkmcnt(1)\n\t" \
                "v_mfma_f32_16x16x32_bf16 %[s0], %[k6], %[q7], %[s0]\n\t" \
                "s_waitcnt lgkmcnt(0)\n\t" \
                "v_mfma_f32_16x16x32_bf16 %[s1], %[k7], %[q7], %[s1]\n\t" \
                "s_nop 7\n\t" \
                "s_nop 7\n\t" \
                "s_nop 7\n\t" \
                : [s0] "=&v"(S0), [s1] "=&v"(S1), [k0] "=&v"(k0_), [k1] "=&v"(k1_), [k2] "=&v"(k2_), [k3] "=&v"(k3_), [k4] "=&v"(k4_), [k5] "=&v"(k5_), [k6] "=&v"(k6_), [k7] "=&v"(k7_) \
                : [ad] "v"(AD), [q0] "v"(qf[0]), [q1] "v"(qf[1]), [q2] "v"(qf[2]), [q3] "v"(qf[3]), [q4] "v"(qf[4]), [q5] "v"(qf[5]), [q6] "v"(qf[6]), [q7] "v"(qf[7]) : "memory"); } while (0)
#define RET_ST_BLOCK3(S0, S1, S2, AD) do { bf16x8 k0_, k1_, k2_, k3_, k4_, k5_, k6_, k7_; asm volatile( \
                "ds_read_b128 %[k0], %[ad] offset:0\n\t" \
                "ds_read_b128 %[k1], %[ad] offset:8704\n\t" \
                "ds_read_b128 %[k2], %[ad] offset:17408\n\t" \
                "ds_read_b128 %[k3], %[ad] offset:64\n\t" \
                "ds_read_b128 %[k4], %[ad] offset:8768\n\t" \
                "ds_read_b128 %[k5], %[ad] offset:17472\n\t" \
                "ds_read_b128 %[k6], %[ad] offset:128\n\t" \
                "ds_read_b128 %[k7], %[ad] offset:8832\n\t" \
                "s_waitcnt lgkmcnt(7)\n\t" \
                "v_mfma_f32_16x16x32_bf16 %[s0], %[k0], %[q0], 0\n\t" \
                "ds_read_b128 %[k0], %[ad] offset:17536\n\t" \
                "s_waitcnt lgkmcnt(7)\n\t" \
                "v_mfma_f32_16x16x32_bf16 %[s1], %[k1], %[q0], 0\n\t" \
                "ds_read_b128 %[k1], %[ad] offset:192\n\t" \
                "s_waitcnt lgkmcnt(7)\n\t" \
                "v_mfma_f32_16x16x32_bf16 %[s2], %[k2], %[q0], 0\n\t" \
                "ds_read_b128 %[k2], %[ad] offset:8896\n\t" \
                "s_waitcnt lgkmcnt(7)\n\t" \
                "v_mfma_f32_16x16x32_bf16 %[s0], %[k3], %[q1], %[s0]\n\t" \
                "ds_read_b128 %[k3], %[ad] offset:17600\n\t" \
                "s_waitcnt lgkmcnt(7)\n\t" \
                "v_mfma_f32_16x16x32_bf16 %[s1], %[k4], %[q1], %[s1]\n\t" \
                "ds_read_b128 %[k4], %[ad] offset:256\n\t" \
                "s_waitcnt lgkmcnt(7)\n\t" \
                "v_mfma_f32_16x16x32_bf16 %[s2], %[k5], %[q1], %[s2]\n\t" \
                "ds_read_b128 %[k5], %[ad] offset:8960\n\t" \
                "s_waitcnt lgkmcnt(7)\n\t" \
                "v_mfma_f32_16x16x32_bf16 %[s0], %[k6], %[q2], %[s0]\n\t" \
                "ds_read_b128 %[k6], %[ad] offset:17664\n\t" \
                "s_waitcnt lgkmcnt(7)\n\t" \
                "v_mfma_f32_16x16x32_bf16 %[s1], %[k7], %[q2], %[s1]\n\t" \
                "ds_read_b128 %[k7], %[ad] offset:320\n\t" \
                "s_waitcnt lgkmcnt(7)\n\t" \
                "v_mfma_f32_16x16x32_bf16 %[s2], %[k0], %[q2], %[s2]\n\t" \
                "ds_read_b128 %[k0], %[ad] offset:9024\n\t" \
                "s_waitcnt lgkmcnt(7)\n\t" \
                "v_mfma_f32_16x16x32_bf16 %[s0], %[k1], %[q3], %[s0]\n\t" \
                "ds_read_b128 %[k1], %[ad] offset:17728\n\t" \
                "s_waitcnt lgkmcnt(7)\n\t" \
                "v_mfma_f32_16x16x32_bf16 %[s1], %[k2], %[q3], %[s1]\n\t" \
                "ds_read_b128 %[k2], %[ad] offset:384\n\t" \
                "s_waitcnt lgkmcnt(7)\n\t" \
                "v_mfma_f32_16x16x32_bf16 %[s2], %[k3], %[q3], %[s2]\n\t" \
                "ds_read_b128 %[k3], %[ad] offset:9088\n\t" \
                "s_waitcnt lgkmcnt(7)\n\t" \
                "v_mfma_f32_16x16x32_bf16 %[s0], %[k4], %[q4], %[s0]\n\t" \
                "ds_read_b128 %[k4], %[ad] offset:17792\n\t" \
                "s_waitcnt lgkmcnt(7)\n\t" \
                "v_mfma_f32_16x16x32_bf16 %[s1], %[k5], %[q4], %[s1]\n\t" \
                "ds_read_b128 %[k5], %[ad] offset:448\n\t" \
                "s_waitcnt lgkmcnt(7)\n\t" \
                "v_mfma_f32_16x16x32_bf16 %[s2], %[k6], %[q4], %[s2]\n\t" \
                "ds_read_b128 %[k6], %[ad] offset:9152\n\t" \
                "s_waitcnt lgkmcnt(7)\n\t" \
                "v_mfma_f32_16x16x32_bf16 %[s0], %[k7], %[q5], %[s0]\n\t" \
                "ds_read_b128 %[k7], %[ad] offset:17856\n\t" \
                "s_waitcnt lgkmcnt(7)\n\t" \
                "v_mfma_f32_16x16x32_bf16 %[s1], %[k0], %[q5], %[s1]\n\t" \
                "s_waitcnt lgkmcnt(6)\n\t" \
                "v_mfma_f32_16x16x32_bf16 %[s2], %[k1], %[q5], %[s2]\n\t" \
                "s_waitcnt lgkmcnt(5)\n\t" \
                "v_mfma_f32_16x16x32_bf16 %[s0], %[k2], %[q6], %[s0]\n\t" \
                "s_waitcnt lgkmcnt(4)\n\t" \
                "v_mfma_f32_16x16x32_bf16 %[s1], %[k3], %[q6], %[s1]\n\t" \
                "s_waitcnt lgkmcnt(3)\n\t" \
                "v_mfma_f32_16x16x32_bf16 %[s2], %[k4], %[q6], %[s2]\n\t" \
                "s_waitcnt lgkmcnt(2)\n\t" \
                "v_mfma_f32_16x16x32_bf16 %[s0], %[k5], %[q7], %[s0]\n\t" \
                "s_waitcnt lgkmcnt(1)\n\t" \
                "v_mfma_f32_16x16x32_bf16 %[s1], %[k6], %[q7], %[s1]\n\t" \
                "s_waitcnt lgkmcnt(0)\n\t" \
                "v_mfma_f32_16x16x32_bf16 %[s2], %[k7], %[q7], %[s2]\n\t" \
                "s_nop 7\n\t" \
                "s_nop 7\n\t" \
                "s_nop 7\n\t" \
                : [s0] "=&v"(S0), [s1] "=&v"(S1), [s2] "=&v"(S2), [k0] "=&v"(k0_), [k1] "=&v"(k1_), [k2] "=&v"(k2_), [k3] "=&v"(k3_), [k4] "=&v"(k4_), [k5] "=&v"(k5_), [k6] "=&v"(k6_), [k7] "=&v"(k7_) \
                : [ad] "v"(AD), [q0] "v"(qf[0]), [q1] "v"(qf[1]), [q2] "v"(qf[2]), [q3] "v"(qf[3]), [q4] "v"(qf[4]), [q5] "v"(qf[5]), [q6] "v"(qf[6]), [q7] "v"(qf[7]) : "memory"); } while (0)
#define RET_ST_BLOCK4(S0, S1, S2, S3, AD) do { bf16x8 k0_, k1_, k2_, k3_, k4_, k5_, k6_, k7_; asm volatile( \
                "ds_read_b128 %[k0], %[ad] offset:0\n\t" \
                "ds_read_b128 %[k1], %[ad] offset:8704\n\t" \
                "ds_read_b128 %[k2], %[ad] offset:17408\n\t" \
                "ds_read_b128 %[k3], %[ad] offset:26112\n\t" \
                "ds_read_b128 %[k4], %[ad] offset:64\n\t" \
                "ds_read_b128 %[k5], %[ad] offset:8768\n\t" \
                "ds_read_b128 %[k6], %[ad] offset:17472\n\t" \
                "ds_read_b128 %[k7], %[ad] offset:26176\n\t" \
                "s_waitcnt lgkmcnt(7)\n\t" \
                "v_mfma_f32_16x16x32_bf16 %[s0], %[k0], %[q0], 0\n\t" \
                "ds_read_b128 %[k0], %[ad] offset:128\n\t" \
                "s_waitcnt lgkmcnt(7)\n\t" \
                "v_mfma_f32_16x16x32_bf16 %[s1], %[k1], %[q0], 0\n\t" \
                "ds_read_b128 %[k1], %[ad] offset:8832\n\t" \
                "s_waitcnt lgkmcnt(7)\n\t" \
                "v_mfma_f32_16x16x32_bf16 %[s2], %[k2], %[q0], 0\n\t" \
                "ds_read_b128 %[k2], %[ad] offset:17536\n\t" \
                "s_waitcnt lgkmcnt(7)\n\t" \
                "v_mfma_f32_16x16x32_bf16 %[s3], %[k3], %[q0], 0\n\t" \
                "ds_read_b128 %[k3], %[ad] offset:26240\n\t" \
                "s_waitcnt lgkmcnt(7)\n\t" \
                "v_mfma_f32_16x16x32_bf16 %[s0], %[k4], %[q1], %[s0]\n\t" \
                "ds_read_b128 %[k4], %[ad] offset:192\n\t" \
                "s_waitcnt lgkmcnt(7)\n\t" \
                "v_mfma_f32_16x16x32_bf16 %[s1], %[k5], %[q1], %[s1]\n\t" \
                "ds_read_b128 %[k5], %[ad] offset:8896\n\t" \
                "s_waitcnt lgkmcnt(7)\n\t" \
                "v_mfma_f32_16x16x32_bf16 %[s2], %[k6], %[q1], %[s2]\n\t" \
                "ds_read_b128 %[k6], %[ad] offset:17600\n\t" \
                "s_waitcnt lgkmcnt(7)\n\t" \
                "v_mfma_f32_16x16x32_bf16 %[s3], %[k7], %[q1], %[s3]\n\t" \
                "ds_read_b128 %[k7], %[ad] offset:26304\n\t" \
                "s_waitcnt lgkmcnt(7)\n\t" \
                "v_mfma_f32_16x16x32_bf16 %[s0], %[k0], %[q2], %[s0]\n\t" \
                "ds_read_b128 %[k0], %[ad] offset:256\n\t" \
                "s_waitcnt lgkmcnt(7)\n\t" \
                "v_mfma_f32_16x16x32_bf16 %[s1], %[k1], %[q2], %[s1]\n\t" \
                "ds_read_b128 %[k1], %[ad] offset:8960\n\t" \
                "s_waitcnt lgkmcnt(7)\n\t" \
                "v_mfma_f32_16x16x32_bf16 %[s2], %[k2], %[q2], %[s2]\n\t" \
                "ds_read_b128 %[k2], %[ad] offset:17664\n\t" \
                "s_waitcnt lgkmcnt(7)\n\t" \
                "v_mfma_f32_16x16x32_bf16 %[s3], %[k3], %[q2], %[s3]\n\t" \
                "ds_read_b128 %[k3], %[ad] offset:26368\n\t" \
                "s_waitcnt lgkmcnt(7)\n\t" \
                "v_mfma_f32_16x16x32_bf16 %[s0], %[k4], %[q3], %[s0]\n\t" \
                "ds_read_b128 %[k4], %[ad] offset:320\n\t" \
                "s_waitcnt lgkmcnt(7)\n\t" \
                "v_mfma_f32_16x16x32_bf16 %[s1], %[k5], %[q3], %[s1]\n\t" \
                "ds_read_b128 %[k5], %[ad] offset:9024\n\t" \
                "s_waitcnt lgkmcnt(7)\n\t" \
                "v_mfma_f32_16x16x32_bf16 %[s2], %[k6], %[q3], %[s2]\n\t" \
                "ds_read_b128 %[k6], %[ad] offset:17728\n\t" \
                "s_waitcnt lgkmcnt(7)\n\t" \
                "v_mfma_f32_16x16x32_bf16 %[s3], %[k7], %[q3], %[s3]\n\t" \
                "ds_read_b128 %[k7], %[ad] offset:26432\n\t" \
                "s_waitcnt lgkmcnt(7)\n\t" \
                "v_mfma_f32_16x16x32_bf16 %[s0], %[k0], %[q4], %[s0]\n\t" \
                "ds_read_b128 %[k0], %[ad] offset:384\n\t" \
                "s_waitcnt lgkmcnt(7)\n\t" \
                "v_mfma_f32_16x16x32_bf16 %[s1], %[k1], %[q4], %[s1]\n\t" \
                "ds_read_b128 %[k1], %[ad] offset:9088\n\t" \
                "s_waitcnt lgkmcnt(7)\n\t" \
                "v_mfma_f32_16x16x32_bf16 %[s2], %[k2], %[q4], %[s2]\n\t" \
                "ds_read_b128 %[k2], %[ad] offset:17792\n\t" \
                "s_waitcnt lgkmcnt(7)\n\t" \
                "v_mfma_f32_16x16x32_bf16 %[s3], %[k3], %[q4], %[s3]\n\t" \
                "ds_read_b128 %[k3], %[ad] offset:26496\n\t" \
                "s_waitcnt lgkmcnt(7)\n\t" \
                "v_mfma_f32_16x16x32_bf16 %[s0], %[k4], %[q5], %[s0]\n\t" \
                "ds_read_b128 %[k4], %[ad] offset:448\n\t" \
                "s_waitcnt lgkmcnt(7)\n\t" \
                "v_mfma_f32_16x16x32_bf16 %[s1], %[k5], %[q5], %[s1]\n\t" \
                "ds_read_b128 %[k5], %[ad] offset:9152\n\t" \
                "s_waitcnt lgkmcnt(7)\n\t" \
                "v_mfma_f32_16x16x32_bf16 %[s2], %[k6], %[q5], %[s2]\n\t" \
                "ds_read_b128 %[k6], %[ad] offset:17856\n\t" \
                "s_waitcnt lgkmcnt(7)\n\t" \
                "v_mfma_f32_16x16x32_bf16 %[s3], %[k7], %[q5], %[s3]\n\t" \
                "ds_read_b128 %[k7], %[ad] offset:26560\n\t" \
                "s_waitcnt lgkmcnt(7)\n\t" \
                "v_mfma_f32_16x16x32_bf16 %[s0], %[k0], %[q6], %[s0]\n\t" \
                "s_waitcnt lgkmcnt(6)\n\t" \
                "v_mfma_f32_16x16x32_bf16 %[s1], %[k1], %[q6], %[s1]\n\t" \
                "s_waitcnt lgkmcnt(5)\n\t" \
                "v_mfma_f32_16x16x32_bf16 %[s2], %[k2], %[q6], %[s2]\n\t" \
                "s_waitcnt lgkmcnt(4)\n\t" \
                "v_mfma_f32_16x16x32_bf16 %[s3], %[k3], %[q6], %[s3]\n\t" \
                "s_waitcnt lgkmcnt(3)\n\t" \
                "v_mfma_f32_16x16x32_bf16 %[s0], %[k4], %[q7], %[s0]\n\t" \
                "s_waitcnt lgkmcnt(2)\n\t" \
                "v_mfma_f32_16x16x32_bf16 %[s1], %[k5], %[q7], %[s1]\n\t" \
                "s_waitcnt lgkmcnt(1)\n\t" \
                "v_mfma_f32_16x16x32_bf16 %[s2], %[k6], %[q7], %[s2]\n\t" \
                "s_waitcnt lgkmcnt(0)\n\t" \
                "v_mfma_f32_16x16x32_bf16 %[s3], %[k7], %[q7], %[s3]\n\t" \
                "s_nop 7\n\t" \
                "s_nop 7\n\t" \
                "s_nop 7\n\t" \
                : [s0] "=&v"(S0), [s1] "=&v"(S1), [s2] "=&v"(S2), [s3] "=&v"(S3), [k0] "=&v"(k0_), [k1] "=&v"(k1_), [k2] "=&v"(k2_), [k3] "=&v"(k3_), [k4] "=&v"(k4_), [k5] "=&v"(k5_), [k6] "=&v"(k6_), [k7] "=&v"(k7_) \
                : [ad] "v"(AD), [q0] "v"(qf[0]), [q1] "v"(qf[1]), [q2] "v"(qf[2]), [q3] "v"(qf[3]), [q4] "v"(qf[4]), [q5] "v"(qf[5]), [q6] "v"(qf[6]), [q7] "v"(qf[7]) : "memory"); } while (0)
#define RET_PACK(P0) do { _Pragma("unroll") for (int p_ = 0; p_ < 2; ++p_) { float m[8]; \
                _Pragma("unroll") for (int rr = 0; rr < 4; ++rr) { const int j0 = 32 * (P0 + p_) + 4 * g4 + rr, j1 = j0 + 16; \
                    m[rr] = (j0 <= i) ? sacc[2 * p_][rr] : 0.f; \
                    m[4 + rr] = (j1 <= i) ? sacc[2 * p_ + 1][rr] : 0.f; } \
                v4u sw; sw.x = cvtpk(m[0], m[1]); sw.y = cvtpk(m[2], m[3]); sw.z = cvtpk(m[4], m[5]); sw.w = cvtpk(m[6], m[7]); \
                sf[P0 + p_] = __builtin_bit_cast(bf16x8, sw); } } while (0)
            bf16x8 sf[4];
            { f32x4 sacc[4];
              const unsigned kad = (unsigned)(size_t)(K_t + i16 * 544 + 16 * g4);
#define RET_ST_N(NB_, AD_) do { const f32x4 z4_ = (f32x4){0.f, 0.f, 0.f, 0.f}; \
                if ((NB_) == 4) RET_ST_BLOCK4(sacc[0], sacc[1], sacc[2], sacc[3], AD_); \
                else if ((NB_) == 3) { RET_ST_BLOCK3(sacc[0], sacc[1], sacc[2], AD_); sacc[3] = z4_; } \
                else if ((NB_) == 2) { RET_ST_BLOCK2(sacc[0], sacc[1], AD_); sacc[2] = z4_; sacc[3] = z4_; } \
                else { RET_ST_BLOCK1(sacc[0], AD_); sacc[1] = z4_; sacc[2] = z4_; sacc[3] = z4_; } } while (0)
              const int nb1 = (ib < 3) ? ib + 1 : 4;
              RET_ST_N(nb1, kad);
              RET_PACK(0);
              if (ib >= 4) { const unsigned kad2 = kad + 34816u; const int nb2 = ib - 3; RET_ST_N(nb2, kad2); RET_PACK(2); }
              else { sf[2] = __builtin_bit_cast(bf16x8, (v4u){0u, 0u, 0u, 0u}); sf[3] = sf[2]; } }
#undef RET_ST_N
#undef RET_PACK
#undef RET_ST_BLOCK1
#undef RET_ST_BLOCK2
#undef RET_ST_BLOCK3
#undef RET_ST_BLOCK4
            f32x4 o[2];
            o[0] = (f32x4){0.f, 0.f, 0.f, 0.f}; o[1] = (f32x4){0.f, 0.f, 0.f, 0.f};
#pragma unroll
            for (int k2 = 0; k2 < 8; k2 += 2) {
                bf16x8 rf[2][2];
#pragma unroll
                for (int kk = 0; kk < 2; ++kk)
#pragma unroll
                    for (int eb = 0; eb < 2; ++eb) rf[kk][eb] = *(const LAS bf16x8*)(RT_c + (16 * eb + i16) * 544 + (32 * (k2 + kk) + 8 * g4) * 2);
                asm volatile("" ::: "memory");
#pragma unroll
                for (int kk = 0; kk < 2; ++kk)
#pragma unroll
                    for (int eb = 0; eb < 2; ++eb) o[eb] = MFMA16(rf[kk][eb], qf[k2 + kk], o[eb]);
            }
            bf16x8 vfi[4][2];
#pragma unroll
            for (int p = 0; p < 4; ++p)
#pragma unroll
                for (int eb = 0; eb < 2; ++eb) vfi[p][eb] = lds_tr_pair(V_t, 96, 32 * p + 4 * g4, 32 * p + 16 + 4 * g4, 16 * eb, lane);
            asm volatile("" ::: "memory");
#pragma unroll
            for (int p = 0; p < 4; ++p)
#pragma unroll
                for (int eb = 0; eb < 2; ++eb) o[eb] = MFMA16(vfi[p][eb], sf[p], o[eb]);
            { const size_t advq = (size_t)((n + 1 < NCHUNK) ? n + 1 : n) * 128 * LDT;
#pragma unroll
              for (int ks = 0; ks < 8; ++ks) qf[ks] = *(const bf16x8*)(qg + advq + 32 * ks); }
            { const size_t token = tb + (size_t)n * 128 + i; float s = 0.f, q = 0.f;
#pragma unroll
              for (int eb = 0; eb < 2; ++eb) { u32x2 pk; pk.x = cvtpk(o[eb][0], o[eb][1]); pk.y = cvtpk(o[eb][2], o[eb][3]);
                  *(u32x2*)(Opre + token * LDT + hc + 32 * es + 16 * eb + 4 * g4) = pk;
#pragma unroll
                  for (int rr = 0; rr < 4; ++rr) { s += o[eb][rr]; q += o[eb][rr] * o[eb][rr]; } }
              s += __shfl_xor(s, 16); q += __shfl_xor(q, 16); s += __shfl_xor(s, 32); q += __shfl_xor(q, 32);
              if (g4 == 0) *(f32x2v*)(stats + ((token * 8 + h) * 8 + es) * 2) = (f32x2v){s, q}; }
            if (n + 1 < NCHUNK) {
#pragma unroll
                for (int k2 = 0; k2 < 4; k2 += 2) {
                    bf16x8 kfs[2][2], vfs[2][2];
#pragma unroll
                    for (int kk = 0; kk < 2; ++kk) { kfs[kk][0] = lds_tr_frag_c(K_t, 544, 32 * (k2 + kk), 32 * w, lane); kfs[kk][1] = lds_tr_frag_c(K_t, 544, 32 * (k2 + kk), 32 * w + 16, lane);
                        vfs[kk][0] = lds_tr_frag_c(V_t, 96, 32 * (k2 + kk), 0, lane); vfs[kk][1] = lds_tr_frag_c(V_t, 96, 32 * (k2 + kk), 16, lane); }
                    asm volatile("" ::: "memory");
#pragma unroll
                    for (int kk = 0; kk < 2; ++kk) { r[0][0] = MFMA16(kfs[kk][0], vfs[kk][0], r[0][0]); r[0][1] = MFMA16(kfs[kk][0], vfs[kk][1], r[0][1]);
                        r[1][0] = MFMA16(kfs[kk][1], vfs[kk][0], r[1][0]); r[1][1] = MFMA16(kfs[kk][1], vfs[kk][1], r[1][1]); }
                }
#pragma unroll
                for (int a = 0; a < 2; ++a)
#pragma unroll
                    for (int c = 0; c < 2; ++c) r[a][c] = r[a][c] * gamma_c;
#pragma unroll
                for (int db = 0; db < 2; ++db)
#pragma unroll
                    for (int eb = 0; eb < 2; ++eb) { u32x2 pk; pk.x = cvtpk(r[db][eb][0], r[db][eb][1]); pk.y = cvtpk(r[db][eb][2], r[db][eb][3]);
                        *(LAS u32x2*)(RT_n + (16 * eb + i16) * 544 + (32 * w + 16 * db + 4 * g4) * 2) = pk; }
            }
        }
        LDS_BARRIER();
    }
}
__device__ __forceinline__ void phase_sgumix2(LAS unsigned char* lds, const bf16* WM, const bf16* VS, const float* sgst, const float* lngain, bf16* U, const float* sb, int vcu, int G, int tid) {
    asm volatile("" : "+v"(tid));
    const int lane = tid & 63, w = __builtin_amdgcn_readfirstlane(tid >> 6), i16 = lane & 15, g4 = lane >> 4;
    LAS unsigned char* W_t = lds;
    LAS unsigned char* V_t = lds + 34816;
    LAS float* mr = (LAS float*)(lds + 102400);
    for (int bn = vcu; bn < BATCH * NCHUNK; bn += G) {
        const size_t t0 = (size_t)bn * 128;
        LDS_BARRIER();
        if (tid < 128) { const f32x4* sp = (const f32x4*)(sgst + (t0 + tid) * 64); float s = 0.f, q = 0.f;
#pragma unroll
            for (int k = 0; k < 16; ++k) { const f32x4 v = sp[k]; s += v[0]; q += v[1]; s += v[2]; q += v[3]; }
            const float mean = s * (1.0f / 2048.0f), var = q * (1.0f / 2048.0f) - mean * mean;
            mr[tid * 2] = mean; mr[tid * 2 + 1] = 1.0f / sqrtf(fmaxf(var, 0.f) + EPS); }
        v4u wpre[4], vpre[8]; f32x4 gpre[2];
        const bf16* vg = VS + (t0 + (tid >> 5)) * LDT + (tid & 31) * 8;
        const bf16* wg = WM + (tid >> 4) * 128 + (tid & 15) * 8;
#pragma unroll
        for (int k = 0; k < 4; ++k) wpre[k] = *(const v4u*)(wg + k * 32 * 128);
#pragma unroll
        for (int k = 0; k < 8; ++k) vpre[k] = *(const v4u*)(vg + (size_t)k * 16 * LDT);
        gpre[0] = *(const f32x4*)(lngain + (tid & 31) * 8); gpre[1] = *(const f32x4*)(lngain + (tid & 31) * 8 + 4);
        for (int g = 0; g < 8; ++g) {
            const int c0 = g * 256;
            LDS_BARRIER();
#pragma unroll
            for (int k = 0; k < 4; ++k) *(LAS v4u*)(W_t + ((tid >> 4) + 32 * k) * 272 + (tid & 15) * 16) = wpre[k];
#pragma unroll
            for (int k = 0; k < 8; ++k) { const int row = (tid >> 5) + 16 * k; const float mean = mr[row * 2], rstd = mr[row * 2 + 1]; const v4u x = vpre[k];
                v4u o; o.x = cvtpk((bflo(x.x) - mean) * rstd * gpre[0][0], (bfhi(x.x) - mean) * rstd * gpre[0][1]); o.y = cvtpk((bflo(x.y) - mean) * rstd * gpre[0][2], (bfhi(x.y) - mean) * rstd * gpre[0][3]);
                o.z = cvtpk((bflo(x.z) - mean) * rstd * gpre[1][0], (bfhi(x.z) - mean) * rstd * gpre[1][1]); o.w = cvtpk((bflo(x.w) - mean) * rstd * gpre[1][2], (bfhi(x.w) - mean) * rstd * gpre[1][3]);
                *(LAS v4u*)(V_t + row * 528 + (tid & 31) * 16) = o; }
            { const int gn = (g + 1 < 8) ? g + 1 : g;
#pragma unroll
              for (int k = 0; k < 4; ++k) wpre[k] = *(const v4u*)(wg + (size_t)gn * 16384 + k * 32 * 128);
#pragma unroll
              for (int k = 0; k < 8; ++k) vpre[k] = *(const v4u*)(vg + gn * 256 + (size_t)k * 16 * LDT);
              gpre[0] = *(const f32x4*)(lngain + gn * 256 + (tid & 31) * 8); gpre[1] = *(const f32x4*)(lngain + gn * 256 + (tid & 31) * 8 + 4); }
            LDS_BARRIER();
            u32x2 uw[2][8];
#pragma unroll
            for (int ib = 0; ib < 8; ++ib)
#pragma unroll
                for (int cb = 0; cb < 2; ++cb) uw[cb][ib] = *(const u32x2*)(U + (t0 + 16 * ib + i16) * LDT + c0 + 32 * w + 16 * cb + 4 * g4);
            f32x4 acc[2][8];
#pragma unroll
            for (int a = 0; a < 2; ++a)
#pragma unroll
                for (int b = 0; b < 8; ++b) acc[a][b] = (f32x4){0.f, 0.f, 0.f, 0.f};
#pragma unroll
            for (int ks = 0; ks < 4; ++ks) {
                const bf16x8 vf0 = lds_tr_frag(V_t, 528, 32 * ks, 32 * w, lane), vf1 = lds_tr_frag(V_t, 528, 32 * ks, 32 * w + 16, lane);
#pragma unroll
                for (int ib = 0; ib < 8; ++ib) if (2 * ks <= ib) {
                    const bf16x8 wf = *(const LAS bf16x8*)(W_t + (16 * ib + i16) * 272 + (32 * ks + 8 * g4) * 2);
                    acc[0][ib] = MFMA16(vf0, wf, acc[0][ib]); acc[1][ib] = MFMA16(vf1, wf, acc[1][ib]); }
            }
#pragma unroll
            for (int ib = 0; ib < 8; ++ib) { const int i = 16 * ib + i16; const float bias = sb[g * 128 + i];
#pragma unroll
                for (int cb = 0; cb < 2; ++cb) { const u32x2 x = uw[cb][ib]; const f32x4 a = acc[cb][ib];
                    u32x2 o; o.x = cvtpk(bflo(x.x) * (a[0] + bias), bfhi(x.x) * (a[1] + bias)); o.y = cvtpk(bflo(x.y) * (a[2] + bias), bfhi(x.y) * (a[3] + bias));
                    *(u32x2*)(U + (t0 + i) * LDT + c0 + 32 * w + 16 * cb + 4 * g4) = o; } }
        }
    }
    LDS_BARRIER();
}
__device__ __forceinline__ void phase_retln(const bf16* Opre, const float* stats, const bf16* Gi, bf16* Gt, const float* gn, int gw, int NGW, int lane) {
    asm volatile("" : "+v"(lane));
    f32x4 gv[8];
#pragma unroll
    for (int h = 0; h < 8; ++h) gv[h] = *(const f32x4*)(gn + h * 256 + 4 * lane);
    for (int m = gw; m < M; m += NGW) {
        f32x2v st = *(const f32x2v*)(stats + ((size_t)m * 64 + lane) * 2);
        float s = st.x, q = st.y;
        s += __shfl_xor(s, 1); q += __shfl_xor(q, 1); s += __shfl_xor(s, 2); q += __shfl_xor(q, 2); s += __shfl_xor(s, 4); q += __shfl_xor(q, 4);
        const float mean_l = s * (1.0f / 256.0f), var_l = q * (1.0f / 256.0f) - mean_l * mean_l, rstd_l = 1.0f / sqrtf(fmaxf(var_l, 0.f) + EPS);
        const u32x2* op = (const u32x2*)(Opre + (size_t)m * LDT) + lane; u32x2* gp = (u32x2*)(Gt + (size_t)m * LDT) + lane; const u32x2* gi = (const u32x2*)(Gi + (size_t)m * LDT) + lane;
#pragma unroll
        for (int h = 0; h < 8; ++h) { const float mean = __shfl(mean_l, 8 * h), rstd = __shfl(rstd_l, 8 * h);
            const u32x2 ow = op[64 * h], gw2 = gi[64 * h];
            u32x2 y; y.x = cvtpk((bflo(ow.x) - mean) * rstd * gv[h][0] * bflo(gw2.x), (bfhi(ow.x) - mean) * rstd * gv[h][1] * bfhi(gw2.x));
            y.y = cvtpk((bflo(ow.y) - mean) * rstd * gv[h][2] * bflo(gw2.y), (bfhi(ow.y) - mean) * rstd * gv[h][3] * bfhi(gw2.y));
            gp[64 * h] = y; }
    }
}

__device__ __forceinline__ int fresh_tid() { int t = threadIdx.x; asm volatile("" : "+v"(t)); return t; }
struct Args { const void* in[19]; float* out; unsigned char* ws; };
__global__ void __launch_bounds__(NWAVES * 64, 2) fwd(Args args) {
    extern __shared__ __attribute__((aligned(16))) unsigned char lds_raw[];
    LAS unsigned char* lds = (LAS unsigned char*)lds_raw;
    volatile LAS unsigned* MISC = (volatile LAS unsigned*)(lds + MISC_OFF);
#define TID fresh_tid()
#define LANE (fresh_tid() & 63)
    const int wave = __builtin_amdgcn_readfirstlane(TID >> 6);
    const int G = gridDim.x; const int bx = blockIdx.x; const int vcu = (G % 8 == 0) ? (bx % 8) * (G / 8) + bx / 8 : bx;
    const int gw = vcu * NWAVES + wave, NGW = G * NWAVES;
    unsigned char* ws = args.ws; float* X = args.out;
    for (int u = TID; u < (LDS_BYTES - LDSCTL_OFF) / 4; u += NWAVES * 64) ((LAS unsigned*)(lds + LDSCTL_OFF))[u] = 0u;
    __syncthreads();
    XcdBarrier bar = xcd_barrier_post((unsigned*)(ws + WS_CTL) + CW_BAR, MISC + 8);

    bf16* Hb = (bf16*)(ws + WS_H);
    bf16* BIG = (bf16*)(ws + WS_BIG);
    bf16 *tQ = BIG, *tK = BIG + TSTRIDE, *tV = BIG + 2 * TSTRIDE, *tG = BIG + 3 * TSTRIDE, *tU = BIG + 4 * TSTRIDE, *tVS = BIG + 5 * TSTRIDE, *tGA = BIG + 6 * TSTRIDE, *tGB = BIG + 7 * TSTRIDE;
    unsigned* CS = (unsigned*)(ws + WS_CS);
    bf16* RT = (bf16*)(ws + WS_RT);

    float* SSQ = (float*)(ws + WS_SSQ);
    {
        for (int m = gw; m < M; m += NGW) {
            const f32x4* xr = (const f32x4*)((const float*)args.in[0] + (size_t)m * D) + LANE; u32x2* ho = (u32x2*)(Hb + (size_t)m * LDT) + LANE;
            float sq = 0.f;
#pragma unroll
            for (int j = 0; j < 8; ++j) { const f32x4 v = xr[64 * j]; u32x2 w; w.x = cvtpk(v[0], v[1]); w.y = cvtpk(v[2], v[3]); ho[64 * j] = w; sq += (v[0] * v[0] + v[1] * v[1]) + (v[2] * v[2] + v[3] * v[3]); }
            sq = wave_sum(sq);
            if (LANE < 32) SSQ[(size_t)m * 32 + LANE] = (LANE == 0) ? sq : 0.0f;
        }
        const size_t gt = (size_t)bx * (NWAVES * 64) + TID, gs = (size_t)G * (NWAVES * 64);
        const int* pos = (const int*)args.in[1];
        for (size_t i = gt; i < (size_t)M * 128; i += gs) { const int tkn = (int)(i >> 7), j = (int)(i & 127);
            double inv = 0.15915494309189535;
            inv *= (j & 1) ? 0.930572040929699 : 1.0; inv *= (j & 2) ? 0.8659643233600653 : 1.0; inv *= (j & 4) ? 0.7498942093324559 : 1.0; inv *= (j & 8) ? 0.5623413251903491 : 1.0;
            inv *= (j & 16) ? 0.31622776601683794 : 1.0; inv *= (j & 32) ? 0.1 : 1.0; inv *= (j & 64) ? 0.01 : 1.0;
            double t = (double)pos[tkn] * inv; t -= floor(t); const float tf = (float)t;
            pg8::h2_t hv; hv.x = (_Float16)__builtin_amdgcn_cosf(tf); hv.y = (_Float16)__builtin_amdgcn_sinf(tf); CS[i] = __builtin_bit_cast(unsigned, hv); }
    }
    for (int it = 0; it < 2 * DEPTH; ++it) {
        const int l = it >> 1, second = it & 1;
        if (!second) {
            ConvSrc cs;
            cs.gu1 = (const float*)args.in[3] + (size_t)l * D * 2 * FF; cs.d1 = (const float*)args.in[4] + (size_t)l * FF * D; cs.win = (const float*)args.in[6] + (size_t)l * D * INCOLS;
            cs.br = (const float*)args.in[12] + (size_t)l * D * D; cs.bs = (const float*)args.in[13] + (size_t)l * D * D; cs.wo = (const float*)args.in[14] + (size_t)l * D * D;
            cs.gu2 = (const float*)args.in[16] + (size_t)l * D * 2 * FF; cs.d2 = (const float*)args.in[17] + (size_t)l * FF * D; cs.sw = (const float*)args.in[10] + (size_t)l * 8 * 128 * 128;
            cs.g1 = (const float*)args.in[2] + (size_t)l * D; cs.gm = (const float*)args.in[5] + (size_t)l * D; cs.g2 = (const float*)args.in[15] + (size_t)l * D;
            phase_conv(lds, ws, cs, gw, NGW, wave, LANE);
            xcd_barrier(bar);
        }
        {
            const int ci = 3 * l + (second ? 2 : 0);
            pg8::Gemm g{Hb, (const bf16*)(ws + (second ? WS_WGU2 : WS_WGU1)), M, 2 * FF, D, LDT, D}; pg8::StaticOrder S; S.init(M, 2 * FF, G, bx);
            pg8::EpiSwiglu E{BIG, FF, SSQ + (size_t)ci * SSQ_STRIDE, (LAS float*)(lds + RS_OFF), -1};
            pg8::gemm_phase<pg8::EpiSwiglu, pg8::StaticOrder, true, true>(lds, g, S, E);
        }
        xcd_barrier(bar);
        {
            const int pi = 3 * l + (second ? 3 : 1);
            pg8::Gemm g{BIG, (const bf16*)(ws + (second ? WS_WD2 : WS_WD1)), M, D, FF, FF, FF}; pg8::ReverseOrder S; S.init(M, D, G, bx);
            pg8::EpiResid E{0.5f, Hb, SSQ + (size_t)pi * SSQ_STRIDE};
            pg8::gemm_phase<pg8::EpiResid, pg8::ReverseOrder, true, true>(lds, g, S, E);
        }
        xcd_barrier(bar);
        if (!second) {
            {
                const int ci = 3 * l + 1;
                pg8::Gemm g{Hb, (const bf16*)(ws + WS_WIN), M, INCOLS, D, LDT, D}; pg8::StaticOrder S; S.init(M, INCOLS, G, bx);
                pg8::EpiIn E{BIG, TSTRIDE, CS, (const float*)args.in[7] + (size_t)l * 2 * D, SSQ + (size_t)ci * SSQ_STRIDE, (LAS float*)(lds + RS_OFF), -1, (float*)(ws + WS_SGST)};
                pg8::gemm_phase<pg8::EpiIn, pg8::StaticOrder, true, true>(lds, g, S, E);
            }
            xcd_barrier(bar);
            phase_ret(lds, tQ, tK, tV, (bf16*)(ws + WS_OPRE), (float*)(ws + WS_RT), vcu, G, TID);
            xcd_barrier(bar);
            phase_sgumix2(lds, (const bf16*)(ws + WS_WMASK), tVS, (const float*)(ws + WS_SGST), (const float*)args.in[9] + (size_t)l * 2048, tU, (const float*)args.in[11] + (size_t)l * 8 * 128, vcu, G, TID);
            phase_retln((const bf16*)(ws + WS_OPRE), (const float*)(ws + WS_RT), tG, tG, (const float*)args.in[8] + (size_t)l * 2048, gw, NGW, LANE);
            xcd_barrier(bar);
            {
                pg8::Gemm g{tG, (const bf16*)(ws + WS_WBR), M, D, D, LDT, D}; pg8::DualOrder S; S.init(M, D, G, bx); S.A2 = tU; S.B2 = (const bf16*)(ws + WS_WBS);
                pg8::EpiBr<2> E{tQ, tGA, tGB};
                pg8::gemm_phase<pg8::EpiBr<2>, pg8::DualOrder, true, true>(lds, g, S, E);
            }
            xcd_barrier(bar);
            {
                const int pi = 3 * l + 2;
                pg8::Gemm g{tQ, (const bf16*)(ws + WS_WOUT), M, D, D, LDT, D}; pg8::StaticOrder S; S.init(M, D, G, bx);
                pg8::EpiResid E{1.0f, Hb, SSQ + (size_t)pi * SSQ_STRIDE};
                pg8::gemm_phase<pg8::EpiResid, pg8::StaticOrder, true, true>(lds, g, S, E);
            }
            xcd_barrier(bar);
        }
    }
    phase_final(Hb, X, (const float*)args.in[18], gw, NGW, LANE);
}

extern "C" void kernel_launch(void* const* d_in, const int* in_sizes, int n_in, void* d_out, int out_size, void* d_ws, size_t ws_size, hipStream_t stream) {
    static int grid = 0;
    if (grid == 0) {
        if (n_in != 19 || in_sizes[0] != M * D || out_size != M * D || ws_size < WS_END) { fprintf(stderr, "kernel_launch: unexpected shapes / workspace (n_in %d, in0 %d, out %d, ws %zu, need %zu); nothing launched\n", n_in, n_in > 0 ? in_sizes[0] : -1, out_size, ws_size, (size_t)WS_END); grid = -1; return; }
        int dev = 0, cus = 0, per_cu = 0;
        if (hipGetDevice(&dev) != hipSuccess || hipDeviceGetAttribute(&cus, hipDeviceAttributeMultiprocessorCount, dev) != hipSuccess) { fprintf(stderr, "kernel_launch: device query failed\n"); grid = -1; return; }
        if (hipFuncSetAttribute((const void*)fwd, hipFuncAttributeMaxDynamicSharedMemorySize, LDS_BYTES) != hipSuccess) { fprintf(stderr, "kernel_launch: hipFuncSetAttribute failed\n"); grid = -1; return; }
        if (hipOccupancyMaxActiveBlocksPerMultiprocessor(&per_cu, (const void*)fwd, NWAVES * 64, LDS_BYTES) != hipSuccess || per_cu < 1) fprintf(stderr, "kernel_launch: note: occupancy query reports %d workgroups per CU\n", per_cu);
        (void)hipGetLastError();
        grid = cus;
    }
    if (grid < 0) return;
    if (hipMemsetAsync((char*)d_ws + WS_CTL, 0, CTL_ZERO_BYTES, stream) != hipSuccess) { fprintf(stderr, "kernel_launch: memset failed\n"); return; }
    Args a{};
    for (int i = 0; i < 19; ++i) a.in[i] = d_in[i];
    a.out = (float*)d_out; a.ws = (unsigned char*)d_ws;
    hipLaunchKernelGGL(fwd, dim3(grid), dim3(NWAVES * 64), LDS_BYTES, stream, a);
    const hipError_t le = hipPeekAtLastError();
    if (le != hipSuccess) fprintf(stderr, "kernel_launch: launch failed: %s\n", hipGetErrorName(le));
}
```

```cpp
#include <hip/hip_runtime.h>
#include <cstdio>
#include <cstdint>
#include <cmath>
namespace pg8 {
#define PG8_LAS __attribute__((address_space(3)))
typedef unsigned short bf16_t;
typedef short bf16x8 __attribute__((ext_vector_type(8)));
typedef float f32x4 __attribute__((ext_vector_type(4)));
typedef unsigned u32x4 __attribute__((ext_vector_type(4)));
constexpr int LDT = 2048 + 64;
constexpr int BM = 256, BK = 64, HALF = 128, HTB = HALF * BK * 2  , STAGE_BYTES = 8 * HTB, NXCD = 8, WGM = 8;

__host__ __device__ __forceinline__ int lds_byte(int r, int c) { const int st = (r >> 4) * 2 + (c >> 5), rr = r & 15, cc = c & 31, ob = rr * 64 + cc * 2; return st * 1024 + (ob ^ (((ob >> 9) & 1) << 5)); }
__host__ __device__ __forceinline__ void stage_rc(int b, int& R, int& C) { const int st = b / 1024, sb = b % 1024, swz = sb ^ (((sb >> 9) & 1) << 5); R = (st >> 1) * 16 + swz / 64; C = (st & 1) * 32 + (swz % 64) / 2; }
__host__ __device__ __forceinline__ int perm32(int rho) { const int n = rho >> 4, i = rho & 15; return 8 * (i >> 2) + 4 * n + (i & 3); }

struct Unit { int pm, pn, z; };
struct Gemm { const bf16_t* A; const bf16_t* Bt; int M, N, K; int lda, ldb; };

struct StaticOrder {
    int nM, nN, nwg, G, c;
    __host__ __device__ void init(int M, int N, int G_, int c_) { nM = M / BM; nN = N / BM; nwg = nM * nN; G = G_; c = c_; }
    __host__ __device__ bool next(int i, Unit& u) const {
        const long L = (long)i * G + c; if (L >= nwg) return false;
        int wgid = (int)L; { const int q = nwg / NXCD, r = nwg % NXCD, xcd = wgid % NXCD, off = wgid / NXCD; wgid = (xcd < r ? xcd * (q + 1) : r * (q + 1) + (xcd - r) * q) + off; }
        const int nig = WGM * nN, gid = wgid / nig, fm = gid * WGM, gsz = (nM - fm) < WGM ? (nM - fm) : WGM;
        u.pm = fm + ((wgid % nig) % gsz); u.pn = (wgid % nig) / gsz; u.z = 0; return true;
    }
    __device__ __forceinline__ void a_ready(const Unit&) const {}
    __device__ __forceinline__ void done(const Unit&) const {}
    __device__ __forceinline__ const bf16_t* opA(const Gemm& g, const Unit&) const { return g.A; }
    __device__ __forceinline__ const bf16_t* opB(const Gemm& g, const Unit&) const { return g.Bt; }
};
struct ReverseOrder : StaticOrder {
    __device__ bool next(int i, Unit& u) const { const int rounds = nwg / G; if (i >= rounds) return false; return StaticOrder::next(rounds - 1 - i, u); }
};
struct DualOrder : StaticOrder {
    const bf16_t* A2; const bf16_t* B2;
    __device__ bool next(int i, Unit& u) const { const int rounds = nwg / G; if (i >= 2 * rounds) return false; const bool ok = StaticOrder::next(i >= rounds ? i - rounds : i, u); u.z = (i >= rounds) ? 1 : 0; return ok; }
    __device__ __forceinline__ const bf16_t* opA(const Gemm& g, const Unit& u) const { return u.z ? A2 : g.A; }
    __device__ __forceinline__ const bf16_t* opB(const Gemm& g, const Unit& u) const { return u.z ? B2 : g.Bt; }
};
typedef float f32x2_c __attribute__((ext_vector_type(2))); typedef __bf16 bf16x2_c __attribute__((ext_vector_type(2)));
__device__ __forceinline__ unsigned cvt_pk_bf16(float lo, float hi) { f32x2_c v = {lo, hi}; bf16x2_c b = __builtin_convertvector(v, bf16x2_c); return __builtin_bit_cast(unsigned, b); }
typedef float f32x2 __attribute__((ext_vector_type(2)));
__device__ __forceinline__ f32x2 gelu_pk(f32x2 v) {
    const f32x2 av = __builtin_elementwise_abs(v), d = av * 0.2316418882f + 1.0f;
    f32x2 t; t.x = __builtin_amdgcn_rcpf(d.x); t.y = __builtin_amdgcn_rcpf(d.y);
    f32x2 q = t * 0.5307027145f + (-0.7265760135f); q = q * t + 0.7107068705f; q = q * t + (-0.142248368f); q = q * t + 0.127414796f; q = q * t;
    const f32x2 s = (v * v) * (-0.72134752044f);
    f32x2 e; e.x = __builtin_amdgcn_exp2f(s.x); e.y = __builtin_amdgcn_exp2f(s.y);
    const f32x2 m = v * (q * e), r = v - m;
    f32x2 o; o.x = v.x < 0.f ? m.x : r.x; o.y = v.y < 0.f ? m.y : r.y; return o;
}

__device__ __forceinline__ float bf_lo(unsigned u) { return __uint_as_float(u << 16); }
__device__ __forceinline__ float bf_hi(unsigned u) { return __uint_as_float(u & 0xffff0000u); }
__device__ __forceinline__ float silu_f(float g) { return g * __builtin_amdgcn_rcpf(1.0f + __builtin_amdgcn_exp2f(-1.44269504f * g)); }
__device__ __forceinline__ float sigmoid_f(float g) { return __builtin_amdgcn_rcpf(1.0f + __builtin_amdgcn_exp2f(-1.44269504f * g)); }

__device__ __forceinline__ float row_rs(const float* ssq, int row, int fq) {
    const float* pp = ssq + (size_t)row * 32 + 8 * fq; const f32x4 p0 = *(const f32x4*)pp, p1 = *(const f32x4*)(pp + 4);
    float s = ((p0[0] + p0[1]) + (p0[2] + p0[3])) + ((p1[0] + p1[1]) + (p1[2] + p1[3]));
    s += __shfl_xor(s, 16); s += __shfl_xor(s, 32);
    return __builtin_amdgcn_rsqf(s * (1.0f / 2048.0f) + 1e-6f);
}
struct EpiSwiglu {
    static constexpr bool PERM = true, AFTER_DRAIN = false; static constexpr int NST = 8;
    bf16_t* O; int ldc; const float* ssq;
    PG8_LAS float* rsl; mutable int cpm;
    __device__ __forceinline__ void operator()(const f32x4 (&acc)[2][2][4][2], const Unit& u, int wr, int wc, int fr, int fq) const {
        const int row0 = u.pm * BM + wr * 64 + fr, col0 = u.pn * HALF + wc * 32 + 8 * fq;
        PG8_LAS float* my = rsl + (wr * 4 + wc) * 128 + fr;
        if (u.pm != cpm) { cpm = u.pm;
#pragma unroll
            for (int ai = 0; ai < 2; ++ai)
#pragma unroll
                for (int m = 0; m < 4; ++m) { const float r = row_rs(ssq, row0 + ai * HALF + m * 16, fq); if (fq == 0) my[(ai * 4 + m) * 16] = r; } }
#pragma unroll
        for (int ai = 0; ai < 2; ++ai)
#pragma unroll
            for (int m = 0; m < 4; ++m) { bf16_t* rowp = O + (size_t)(row0 + ai * HALF + m * 16) * ldc + col0;
                const float rs = my[(ai * 4 + m) * 16];
                const f32x4 a0 = acc[ai][0][m][0] * rs, a1 = acc[ai][0][m][1] * rs, g0 = acc[ai][1][m][0] * rs, g1 = acc[ai][1][m][1] * rs;
                u32x4 w; w.x = cvt_pk_bf16(a0[0] * silu_f(g0[0]), a0[1] * silu_f(g0[1])); w.y = cvt_pk_bf16(a0[2] * silu_f(g0[2]), a0[3] * silu_f(g0[3]));
                w.z = cvt_pk_bf16(a1[0] * silu_f(g1[0]), a1[1] * silu_f(g1[1])); w.w = cvt_pk_bf16(a1[2] * silu_f(g1[2]), a1[3] * silu_f(g1[3]));
                *(u32x4*)rowp = w; }
    }
};
struct EpiResid {
    static constexpr bool PERM = true, AFTER_DRAIN = false; static constexpr int NST = 8;
    float scale; bf16_t* Hx; float* ssq;
    __device__ __forceinline__ void operator()(const f32x4 (&acc)[2][2][4][2], const Unit& u, int wr, int wc, int fr, int fq) const {
        const int row0 = u.pm * BM + wr * 64 + fr, col0 = u.pn * BM + wc * 32 + 8 * fq;
#pragma unroll
        for (int ai = 0; ai < 2; ++ai) {
            u32x4 xv[4][2];
#pragma unroll
            for (int m = 0; m < 4; ++m)
#pragma unroll
                for (int bj = 0; bj < 2; ++bj) xv[m][bj] = *(const u32x4*)(Hx + (size_t)(row0 + ai * HALF + m * 16) * LDT + col0 + bj * HALF);
            float ssm[4];
#pragma unroll
            for (int m = 0; m < 4; ++m) { const int row = row0 + ai * HALF + m * 16; bf16_t* hp = Hx + (size_t)row * LDT + col0;
                float ss = 0.f;
#pragma unroll
                for (int bj = 0; bj < 2; ++bj) { const u32x4 x = xv[m][bj]; const f32x4 a0 = acc[ai][bj][m][0], a1 = acc[ai][bj][m][1];
                    const float y0 = bf_lo(x.x) + a0[0] * scale, y1 = bf_hi(x.x) + a0[1] * scale, y2 = bf_lo(x.y) + a0[2] * scale, y3 = bf_hi(x.y) + a0[3] * scale;
                    const float y4 = bf_lo(x.z) + a1[0] * scale, y5 = bf_hi(x.z) + a1[1] * scale, y6 = bf_lo(x.w) + a1[2] * scale, y7 = bf_hi(x.w) + a1[3] * scale;
                    ss += ((y0 * y0 + y1 * y1) + (y2 * y2 + y3 * y3)) + ((y4 * y4 + y5 * y5) + (y6 * y6 + y7 * y7));
                    u32x4 w; w.x = cvt_pk_bf16(y0, y1); w.y = cvt_pk_bf16(y2, y3); w.z = cvt_pk_bf16(y4, y5); w.w = cvt_pk_bf16(y6, y7);
                    *(u32x4*)(hp + bj * HALF) = w; }
                ss += __shfl_xor(ss, 16); ss += __shfl_xor(ss, 32); ssm[m] = ss; }
            { const float sv = (fq == 0) ? ssm[0] : (fq == 1) ? ssm[1] : (fq == 2) ? ssm[2] : ssm[3];
              ssq[(size_t)(row0 + ai * HALF + fq * 16) * 32 + u.pn * 4 + wc] = sv; }
            asm volatile("" ::: "memory"); }
    }
};
__device__ __forceinline__ float lg2_gamma_h(int h) {
    const float x = __builtin_amdgcn_exp2f(-5.0f - (float)h);
    const float l = -x * (1.0f + x * (0.5f + x * (0.33333334f + x * (0.25f + x * (0.2f + x * 0.16666667f)))));
    return l * 1.44269504f;
}
constexpr int GATE_PITCH = 2112;
typedef _Float16 h2_t __attribute__((ext_vector_type(2)));
struct EpiIn {
    static constexpr bool PERM = true, AFTER_DRAIN = false; static constexpr int NST = 8;
    bf16_t* O; size_t tstride; const unsigned* cs; const float* bgate; const float* ssq; PG8_LAS float* rsl; mutable int cpm; float* sgst;
    __device__ __forceinline__ void operator()(const f32x4 (&acc)[2][2][4][2], const Unit& u, int wr, int wc, int fr, int fq) const {
        const int t = ((u.pn >> 3) + 3) & 7, hh = u.pn & 7;
        bf16_t* base = O + (size_t)t * tstride;
        const int row0 = u.pm * BM + wr * 64 + fr, cw = wc * 32 + 8 * fq, col0 = hh * BM + cw;
        PG8_LAS float* my = rsl + (wr * 4 + wc) * 128 + fr;
        if (u.pm != cpm) { cpm = u.pm;
#pragma unroll
            for (int ai = 0; ai < 2; ++ai)
#pragma unroll
                for (int m = 0; m < 4; ++m) { const float r = row_rs(ssq, row0 + ai * HALF + m * 16, fq); if (fq == 0) my[(ai * 4 + m) * 16] = r; } }
        if (t <= 1) {
            const float sc = (t == 1) ? 0.0625f : 1.0f, lgs = (t == 1) ? -lg2_gamma_h(hh) : lg2_gamma_h(hh);
#pragma unroll
            for (int ai = 0; ai < 2; ++ai) {
                u32x4 cv[4][2];
#pragma unroll
                for (int m = 0; m < 4; ++m) { const u32x4* cp = (const u32x4*)(cs + ((size_t)(row0 + ai * HALF + m * 16) * 128 + cw));
                    cv[m][0] = cp[0]; cv[m][1] = cp[1]; }
#pragma unroll
                for (int m = 0; m < 4; ++m) { const int row = row0 + ai * HALF + m * 16;
                    int rl = row; asm volatile("" : "+v"(rl));
                    const float rs = my[(ai * 4 + m) * 16] * sc * __builtin_amdgcn_exp2f((float)((rl & 127) + 1) * lgs);
                    const f32x4 xa0 = acc[ai][0][m][0] * rs, xa1 = acc[ai][0][m][1] * rs, xb0 = acc[ai][1][m][0] * rs, xb1 = acc[ai][1][m][1] * rs;
                    const unsigned cw8[8] = {cv[m][0].x, cv[m][0].y, cv[m][0].z, cv[m][0].w, cv[m][1].x, cv[m][1].y, cv[m][1].z, cv[m][1].w};
                    float co[8], si[8];
#pragma unroll
                    for (int j = 0; j < 8; ++j) { const h2_t hv = __builtin_bit_cast(h2_t, cw8[j]); co[j] = (float)hv.x; si[j] = (float)hv.y; }
                    const float x1[8] = {xa0[0], xa0[1], xa0[2], xa0[3], xa1[0], xa1[1], xa1[2], xa1[3]};
                    const float x2[8] = {xb0[0], xb0[1], xb0[2], xb0[3], xb1[0], xb1[1], xb1[2], xb1[3]};
                    float o1[8], o2[8];
#pragma unroll
                    for (int j = 0; j < 8; ++j) { o1[j] = x1[j] * co[j] - x2[j] * si[j]; o2[j] = x1[j] * si[j] + x2[j] * co[j]; }
                    u32x4 w1, w2;
                    w1.x = cvt_pk_bf16(o1[0], o1[1]); w1.y = cvt_pk_bf16(o1[2], o1[3]); w1.z = cvt_pk_bf16(o1[4], o1[5]); w1.w = cvt_pk_bf16(o1[6], o1[7]);
                    w2.x = cvt_pk_bf16(o2[0], o2[1]); w2.y = cvt_pk_bf16(o2[2], o2[3]); w2.z = cvt_pk_bf16(o2[4], o2[5]); w2.w = cvt_pk_bf16(o2[6], o2[7]);
                    bf16_t* rowp = base + (size_t)row * LDT + col0;
                    *(u32x4*)rowp = w1; *(u32x4*)(rowp + HALF) = w2; }
                asm volatile("" ::: "memory"); }
        } else if (t == 2) other<2>(acc, base, row0, col0, my, t, hh, wc, fq);
        else if (t == 3) other<3>(acc, base, row0, col0, my, t, hh, wc, fq);
        else if (t == 4) other<4>(acc, base, row0, col0, my, t, hh, wc, fq);
        else if (t == 5) other<5>(acc, base, row0, col0, my, t, hh, wc, fq);
        else other<6>(acc, base, row0, col0, my, t, hh, wc, fq);
    }
    template <int TT> __device__ __forceinline__ void other(const f32x4 (&acc)[2][2][4][2], bf16_t* base, int row0, int col0, PG8_LAS float* my, int t, int hh, int wc, int fq) const {
        asm volatile("" : "+v"(row0), "+v"(col0), "+v"(fq));
        f32x4 bv[2][2];
#pragma unroll
        for (int bj = 0; bj < 2; ++bj)
#pragma unroll
            for (int n = 0; n < 2; ++n) bv[bj][n] = (TT >= 6) ? *(const f32x4*)(bgate + (t - 6) * 2048 + col0 + bj * HALF + 4 * n) : (f32x4){0.f, 0.f, 0.f, 0.f};
        float psm = 0.f, pqm = 0.f;
#pragma unroll
        for (int ai = 0; ai < 2; ++ai)
#pragma unroll
            for (int m = 0; m < 4; ++m) { bf16_t* rowp = base + (size_t)(row0 + ai * HALF + m * 16) * LDT + col0;
                const float rs = my[(ai * 4 + m) * 16]; float ps = 0.f, pq = 0.f; u32x4 gq = {0u, 0u, 0u, 0u};
#pragma unroll
                for (int bj = 0; bj < 2; ++bj) { f32x4 v0 = acc[ai][bj][m][0] * rs + bv[bj][0], v1 = acc[ai][bj][m][1] * rs + bv[bj][1];
                    if (TT == 3) {
#pragma unroll
                        for (int j = 0; j < 4; ++j) { v0[j] = silu_f(v0[j]); v1[j] = silu_f(v1[j]); } }
                    else if (TT == 4 || TT == 5) { f32x2 a = gelu_pk((f32x2){v0[0], v0[1]}), b = gelu_pk((f32x2){v0[2], v0[3]}), c = gelu_pk((f32x2){v1[0], v1[1]}), d = gelu_pk((f32x2){v1[2], v1[3]});
                        v0 = (f32x4){a.x, a.y, b.x, b.y}; v1 = (f32x4){c.x, c.y, d.x, d.y};
                        if (TT == 5) { ps += ((v0[0] + v0[1]) + (v0[2] + v0[3])) + ((v1[0] + v1[1]) + (v1[2] + v1[3]));
                            pq += ((v0[0] * v0[0] + v0[1] * v0[1]) + (v0[2] * v0[2] + v0[3] * v0[3])) + ((v1[0] * v1[0] + v1[1] * v1[1]) + (v1[2] * v1[2] + v1[3] * v1[3])); } }
                    else if (TT >= 6) {
#pragma unroll
                        for (int j = 0; j < 4; ++j) { v0[j] = sigmoid_f(v0[j]); v1[j] = sigmoid_f(v1[j]); } }
                    if (TT >= 6) { unsigned b0 = 0u, b1 = 0u;
#pragma unroll
                        for (int j = 0; j < 4; ++j) { b0 = __builtin_amdgcn_cvt_pk_u8_f32(__builtin_rintf(v0[j] * 255.0f), j, b0); b1 = __builtin_amdgcn_cvt_pk_u8_f32(__builtin_rintf(v1[j] * 255.0f), j, b1); }
                        if (bj == 0) { gq.x = b0; gq.y = b1; } else { gq.z = b0; gq.w = b1; } }
                    else { u32x4 w; w.x = cvt_pk_bf16(v0[0], v0[1]); w.y = cvt_pk_bf16(v0[2], v0[3]); w.z = cvt_pk_bf16(v1[0], v1[1]); w.w = cvt_pk_bf16(v1[2], v1[3]);
                        *(u32x4*)(rowp + bj * HALF) = w; } }
                if (TT >= 6) *(u32x4*)((unsigned char*)base + (size_t)(row0 + ai * HALF + m * 16) * GATE_PITCH + hh * 256 + (wc * 4 + fq) * 16) = gq;
                if (TT == 5) { ps += __shfl_xor(ps, 16); pq += __shfl_xor(pq, 16); ps += __shfl_xor(ps, 32); pq += __shfl_xor(pq, 32);
                    if (m == 0 || fq == m) { psm = ps; pqm = pq; }
                    if (m == 3) *(f32x2*)(sgst + ((size_t)((row0 + ai * HALF + fq * 16) * 8 + hh) * 4 + wc) * 2) = (f32x2){psm, pqm}; } }
    }
};
template <int MODE> struct EpiBr {
    static constexpr bool PERM = true, AFTER_DRAIN = false; static constexpr int NST = 0;
    bf16_t* T; const bf16_t* gate; const bf16_t* gate2;
    __device__ __forceinline__ void operator()(const f32x4 (&acc)[2][2][4][2], const Unit& u, int wr, int wc, int fr, int fq) const {
        const int row0 = u.pm * BM + wr * 64 + fr, col0 = u.pn * BM + wc * 32 + 8 * fq;
        const bool addp = (MODE == 1) || (MODE == 2 && u.z != 0); const bf16_t* const gt = (MODE == 2 && u.z != 0) ? gate2 : gate;
#pragma unroll
        for (int ai = 0; ai < 2; ++ai) {
            u32x4 gv[4], pv[4][2];
#pragma unroll
            for (int m = 0; m < 4; ++m) { gv[m] = *(const u32x4*)((const unsigned char*)gt + (size_t)(row0 + ai * HALF + m * 16) * GATE_PITCH + u.pn * 256 + (wc * 4 + fq) * 16);
#pragma unroll
                for (int bj = 0; bj < 2; ++bj) { const size_t off = (size_t)(row0 + ai * HALF + m * 16) * LDT + col0 + bj * HALF;
                    pv[m][bj] = addp ? *(const u32x4*)(T + off) : (u32x4){0u, 0u, 0u, 0u}; } }
#pragma unroll
            for (int m = 0; m < 4; ++m)
#pragma unroll
                for (int bj = 0; bj < 2; ++bj) { const size_t off = (size_t)(row0 + ai * HALF + m * 16) * LDT + col0 + bj * HALF; const unsigned g0 = bj ? gv[m].z : gv[m].x, g1 = bj ? gv[m].w : gv[m].y;
                    const f32x4 a0 = acc[ai][bj][m][0] * (1.0f / 255.0f), a1 = acc[ai][bj][m][1] * (1.0f / 255.0f);
                    float o[8] = {a0[0] * (float)(g0 & 255u), a0[1] * (float)((g0 >> 8) & 255u), a0[2] * (float)((g0 >> 16) & 255u), a0[3] * (float)(g0 >> 24), a1[0] * (float)(g1 & 255u), a1[1] * (float)((g1 >> 8) & 255u), a1[2] * (float)((g1 >> 16) & 255u), a1[3] * (float)(g1 >> 24)};
                    { const u32x4 pw = pv[m][bj];
                        o[0] += bf_lo(pw.x); o[1] += bf_hi(pw.x); o[2] += bf_lo(pw.y); o[3] += bf_hi(pw.y); o[4] += bf_lo(pw.z); o[5] += bf_hi(pw.z); o[6] += bf_lo(pw.w); o[7] += bf_hi(pw.w); }
                    u32x4 w; w.x = cvt_pk_bf16(o[0], o[1]); w.y = cvt_pk_bf16(o[2], o[3]); w.z = cvt_pk_bf16(o[4], o[5]); w.w = cvt_pk_bf16(o[6], o[7]);
                    *(u32x4*)(T + off) = w; }
            asm volatile("" ::: "memory"); }
    }
};
template <class Epi, class Sched, bool ALIGN_EPI = false, bool SP2 = false>
__device__ __forceinline__ void gemm_phase(PG8_LAS unsigned char* lds, const Gemm g, const Sched& S, const Epi& E) {
    int tid_l = threadIdx.x; asm volatile("" : "+v"(tid_l));
    const int tid = tid_l, wid = __builtin_amdgcn_readfirstlane(tid >> 6), lane = tid & 63, wr = wid >> 2, wc = wid & 3, fr = lane & 15, fq = lane >> 4;
    const int K = g.K, nt = K / BK;
    unsigned voffA, voffB;
    { int R, C; stage_rc(tid * 16, R, C); const int Rb = Epi::PERM ? ((R & ~31) + perm32(R & 31)) : R;
        voffA = (unsigned)(R * g.lda + C) * 2u; voffB = (unsigned)(Rb * g.ldb + C) * 2u; }
    const size_t voffA_step = (size_t)64 * g.lda * 2, voffB_step = (size_t)64 * g.ldb * 2;
    const size_t kstep = (size_t)(BK * 2);
    const size_t hstepA = (size_t)HALF * g.lda * 2, hstepB = (size_t)HALF * g.ldb * 2;
    const size_t tstepA = 2 * hstepA, tstepB = 2 * hstepB;
    const unsigned ldsw = (unsigned)wid * 1024u;
    const int aoff = lds_byte(wr * 64 + fr, fq * 8), boff = lds_byte(wc * 32 + fr, fq * 8);
#define PG8_SA(b, h) (((b) * 2 + (h)) * HTB)
#define PG8_SB(b, h) ((4 + (b) * 2 + (h)) * HTB)
#define PG8_STAGE(bufoff, gbase, voff) do { _Pragma("unroll") for (int _i = 0; _i < 2; ++_i) \
        __builtin_amdgcn_global_load_lds((const unsigned*)((const char*)(gbase) + _i * voff##_step + (voff)), (PG8_LAS unsigned*)(lds + (bufoff) + ldsw + _i * 8192), 16, 0, 0); } while (0)
#define PG8_LDA(dst, b, h) do { _Pragma("unroll") for (int m = 0; m < 4; ++m) _Pragma("unroll") for (int k = 0; k < 2; ++k) dst[m][k] = *(const PG8_LAS bf16x8*)(lds + PG8_SA(b, h) + aoff + m * 2048 + k * 1024); } while (0)
#define PG8_LDB(dst, b, h) do { _Pragma("unroll") for (int n = 0; n < 2; ++n) _Pragma("unroll") for (int k = 0; k < 2; ++k) dst[n][k] = *(const PG8_LAS bf16x8*)(lds + PG8_SB(b, h) + boff + n * 2048 + k * 1024); } while (0)
#define PG8_MMA(ai, bj, At, Bt) do { __builtin_amdgcn_s_setprio(1); _Pragma("unroll") for (int m = 0; m < 4; ++m) _Pragma("unroll") for (int n = 0; n < 2; ++n) _Pragma("unroll") for (int k = 0; k < 2; ++k) \
        acc[ai][bj][m][n] = __builtin_amdgcn_mfma_f32_16x16x32_bf16(Bt[n][k], At[m][k], acc[ai][bj][m][n], 0, 0, 0); __builtin_amdgcn_s_setprio(0); } while (0)
#define PG8_MMAZ(ai, bj, At, Bt) do { __builtin_amdgcn_s_setprio(1); _Pragma("unroll") for (int m = 0; m < 4; ++m) _Pragma("unroll") for (int n = 0; n < 2; ++n) { \
        acc[ai][bj][m][n] = __builtin_amdgcn_mfma_f32_16x16x32_bf16(Bt[n][0], At[m][0], (f32x4){0.f, 0.f, 0.f, 0.f}, 0, 0, 0); \
        acc[ai][bj][m][n] = __builtin_amdgcn_mfma_f32_16x16x32_bf16(Bt[n][1], At[m][1], acc[ai][bj][m][n], 0, 0, 0); } __builtin_amdgcn_s_setprio(0); } while (0)
#define PG8_WAIT_V(n) asm volatile("s_waitcnt vmcnt(" #n ")" ::: "memory")
#define PG8_WAIT_L(n) asm volatile("s_waitcnt lgkmcnt(" #n ")" ::: "memory")
#define PG8_BAR __builtin_amdgcn_s_barrier()
#define PG8_SCHED __builtin_amdgcn_sched_barrier(0)
    Unit cur, nxt; int ui = 0;
    if (!S.next(0, cur)) return;
    f32x4 acc[2][2][4][2];
    if constexpr (!SP2) {
#pragma unroll
    for (int a = 0; a < 2; ++a)
#pragma unroll
        for (int b = 0; b < 2; ++b)
#pragma unroll
            for (int m = 0; m < 4; ++m)
#pragma unroll
                for (int n = 0; n < 2; ++n) acc[a][b][m][n] = (f32x4){0.f, 0.f, 0.f, 0.f};
    }
    bf16x8 At[4][2], B0[2][2], B1[2][2];
    const char* cA = (const char*)S.opA(g, cur) + (size_t)cur.pm * tstepA; const char* cB = (const char*)S.opB(g, cur) + (size_t)cur.pn * tstepB;
    S.a_ready(cur);
    if constexpr (SP2) {
        PG8_STAGE(PG8_SB(0, 0), cB, voffB); PG8_STAGE(PG8_SB(0, 1), cB + hstepB, voffB); PG8_STAGE(PG8_SA(0, 0), cA, voffA); PG8_STAGE(PG8_SA(0, 1), cA + hstepA, voffA);
        if (wr == 1) PG8_BAR;
        PG8_WAIT_V(2); PG8_BAR;
        PG8_STAGE(PG8_SB(1, 0), cB + kstep, voffB); PG8_STAGE(PG8_SA(1, 0), cA + kstep, voffA); PG8_STAGE(PG8_SB(1, 1), cB + hstepB + kstep, voffB);
        if (Epi::NST > 0) PG8_WAIT_V(0); else PG8_WAIT_V(6);
        PG8_BAR;
    } else {
        PG8_STAGE(PG8_SB(0, 0), cB, voffB); PG8_STAGE(PG8_SA(0, 0), cA, voffA); PG8_STAGE(PG8_SB(0, 1), cB + hstepB, voffB); PG8_STAGE(PG8_SA(0, 1), cA + hstepA, voffA);
        if (wr == 1) PG8_BAR;
        PG8_WAIT_V(4); PG8_BAR;
        PG8_STAGE(PG8_SB(1, 0), cB + kstep, voffB); PG8_STAGE(PG8_SA(1, 0), cA + kstep, voffA); PG8_STAGE(PG8_SB(1, 1), cB + hstepB + kstep, voffB);
        PG8_WAIT_V(6); PG8_BAR;
    }
    for (;;) {
        const bool has_next = S.next(ui + 1, nxt);
        const char* nA = has_next ? (const char*)S.opA(g, nxt) + (size_t)nxt.pm * tstepA : cA; const char* nB = has_next ? (const char*)S.opB(g, nxt) + (size_t)nxt.pn * tstepB : cB;
#define PG8_TRIP_HEAD(T) const int t = (T); const bool last = (t == nt - 2); \
            const char* a1 = cA + (size_t)(t + 1) * kstep; \
            const char* a2 = last ? nA : cA + (size_t)(t + 2) * kstep; const char* b2 = last ? nB : cB + (size_t)(t + 2) * kstep; \
            const char* a3 = a2 + kstep; const char* b3 = b2 + kstep; \
            if (last && has_next) S.a_ready(nxt);
#define PG8_TRIP_SP2(W12, MM0) \
            PG8_LDB(B0, 0, 0); PG8_LDB(B1, 0, 1); PG8_SCHED; PG8_LDA(At, 0, 0); PG8_STAGE(PG8_SA(1, 1), a1 + hstepA, voffA); \
            W12; PG8_WAIT_L(0); PG8_BAR; MM0(0, 0, At, B0); MM0(0, 1, At, B1); PG8_BAR; PG8_SCHED; \
            PG8_LDA(At, 0, 1); PG8_STAGE(PG8_SB(0, 0), b2, voffB); PG8_STAGE(PG8_SB(0, 1), b2 + hstepB, voffB); PG8_STAGE(PG8_SA(0, 0), a2, voffA); \
            W12; PG8_WAIT_L(0); PG8_BAR; MM0(1, 0, At, B0); MM0(1, 1, At, B1); PG8_BAR; PG8_SCHED; \
            PG8_LDB(B0, 1, 0); PG8_LDB(B1, 1, 1); PG8_SCHED; PG8_LDA(At, 1, 0); PG8_STAGE(PG8_SA(0, 1), a2 + hstepA, voffA); \
            PG8_WAIT_V(8); PG8_WAIT_L(0); PG8_BAR; PG8_MMA(0, 0, At, B0); PG8_MMA(0, 1, At, B1); PG8_BAR; PG8_SCHED; \
            PG8_LDA(At, 1, 1); PG8_STAGE(PG8_SB(1, 0), b3, voffB); PG8_STAGE(PG8_SB(1, 1), b3 + hstepB, voffB); PG8_STAGE(PG8_SA(1, 0), a3, voffA); \
            PG8_WAIT_V(8); PG8_WAIT_L(0); PG8_BAR; PG8_MMA(1, 0, At, B0); PG8_MMA(1, 1, At, B1); PG8_BAR; PG8_SCHED;
        if constexpr (SP2) {
            { PG8_TRIP_HEAD(0) PG8_TRIP_SP2(asm volatile("s_waitcnt vmcnt(%0)" :: "n"(8 + Epi::NST) : "memory"), PG8_MMAZ) }
            for (int tt = 2; tt < nt; tt += 2) { PG8_TRIP_HEAD(tt) PG8_TRIP_SP2(PG8_WAIT_V(8), PG8_MMA) }
        } else {
        for (int tt = 0; tt < nt; tt += 2) { PG8_TRIP_HEAD(tt)
            PG8_LDB(B0, 0, 0); PG8_SCHED; PG8_LDA(At, 0, 0); PG8_STAGE(PG8_SA(1, 1), a1 + hstepA, voffA);
            PG8_WAIT_L(8); PG8_BAR; PG8_WAIT_L(0); PG8_MMA(0, 0, At, B0); PG8_BAR; PG8_SCHED;
            PG8_LDB(B1, 0, 1); PG8_STAGE(PG8_SB(0, 0), b2, voffB);
            PG8_BAR; PG8_WAIT_L(0); PG8_MMA(0, 1, At, B1); PG8_BAR;
            PG8_LDA(At, 0, 1); PG8_STAGE(PG8_SA(0, 0), a2, voffA);
            PG8_BAR; PG8_WAIT_L(0); PG8_MMA(1, 0, At, B0); PG8_BAR; PG8_SCHED;
            PG8_STAGE(PG8_SB(0, 1), b2 + hstepB, voffB);
            PG8_WAIT_V(6); PG8_BAR; PG8_MMA(1, 1, At, B1); PG8_BAR;
            PG8_LDB(B0, 1, 0); PG8_SCHED; PG8_LDA(At, 1, 0); PG8_STAGE(PG8_SA(0, 1), a2 + hstepA, voffA);
            PG8_WAIT_L(8); PG8_BAR; PG8_WAIT_L(0); PG8_MMA(0, 0, At, B0); PG8_BAR; PG8_SCHED;
            PG8_LDB(B1, 1, 1); PG8_STAGE(PG8_SB(1, 0), b3, voffB);
            PG8_BAR; PG8_WAIT_L(0); PG8_MMA(0, 1, At, B1); PG8_BAR;
            PG8_LDA(At, 1, 1); PG8_STAGE(PG8_SA(1, 0), a3, voffA);
            PG8_BAR; PG8_WAIT_L(0); PG8_MMA(1, 0, At, B0); PG8_BAR; PG8_SCHED;
            PG8_STAGE(PG8_SB(1, 1), b3 + hstepB, voffB);
            PG8_WAIT_V(6); PG8_BAR; PG8_MMA(1, 1, At, B1); PG8_BAR;
        }
        }
#undef PG8_TRIP_HEAD
#undef PG8_TRIP_SP2
        if constexpr (ALIGN_EPI) { if (wr == 0) PG8_BAR; }
        if constexpr (!Epi::AFTER_DRAIN) { E(acc, cur, wr, wc, fr, fq); S.done(cur); }
        if (!has_next) break;
        if constexpr (!SP2) {
#pragma unroll
        for (int a = 0; a < 2; ++a)
#pragma unroll
            for (int b = 0; b < 2; ++b)
#pragma unroll
                for (int m = 0; m < 4; ++m)
#pragma unroll
                    for (int n = 0; n < 2; ++n) acc[a][b][m][n] = (f32x4){0.f, 0.f, 0.f, 0.f};
        }
        cur = nxt; cA = nA; cB = nB; ++ui;
        if constexpr (ALIGN_EPI) { if (wr == 1) PG8_BAR; }
    }
    PG8_WAIT_V(0);
    if constexpr (!ALIGN_EPI) { if (wr == 0) PG8_BAR; }
    PG8_BAR;
    if constexpr (Epi::AFTER_DRAIN) { E.fused(acc, cur, wr, wc, fr, fq, lds, wid, lane); S.done(cur); }
#undef PG8_SA
#undef PG8_SB
#undef PG8_STAGE
#undef PG8_LDA
#undef PG8_LDB
#undef PG8_MMA
#undef PG8_MMAZ
#undef PG8_WAIT_V
#undef PG8_WAIT_L
#undef PG8_BAR
#undef PG8_SCHED
}
}
#define GAS __attribute__((address_space(1)))
#define LAS __attribute__((address_space(3)))
typedef unsigned short bf16;
typedef unsigned v4u __attribute__((ext_vector_type(4)));
typedef float f32x4 __attribute__((ext_vector_type(4)));
typedef short bf16x8 __attribute__((ext_vector_type(8)));
typedef GAS unsigned gu32;
typedef GAS unsigned long long gu64;
#define RLX_AGENT __ATOMIC_RELAXED, __HIP_MEMORY_SCOPE_AGENT
#define LDS_WAIT() asm volatile("s_waitcnt lgkmcnt(0)" ::: "memory")
#define VM_WAIT() asm volatile("s_waitcnt vmcnt(0)" ::: "memory")
__device__ __forceinline__ unsigned long long rt() { return __builtin_amdgcn_s_memrealtime(); }
__device__ __forceinline__ unsigned f2bf(float f) { unsigned u = __builtin_bit_cast(unsigned, f); return (u + 0x7fffu + ((u >> 16) & 1u)) >> 16; }
__device__ __forceinline__ unsigned pk2(float lo, float hi) { return f2bf(lo) | (f2bf(hi) << 16); }
#define XB_TMO      128
#define XB_XCNT(j)  (256  + 64 * (j))
#define XB_XSUB(j)  (1280 + 64 * (j))
#define XB_XGEN(j)  (2304 + 64 * (j))
#define XB_TOP      3328
#define XB_TOPGEN   3392
#define XCD_BAR_WORDS 3456
#define XB_SPIN_CAP (1u << 18)

__device__ __forceinline__ unsigned xb_ld(unsigned* p)              { return __hip_atomic_load(p, __ATOMIC_RELAXED, __HIP_MEMORY_SCOPE_AGENT); }
__device__ __forceinline__ unsigned xb_add(unsigned* p, unsigned v) { return __hip_atomic_fetch_add(p, v, __ATOMIC_RELAXED, __HIP_MEMORY_SCOPE_AGENT); }
__device__ __forceinline__ unsigned xb_xcc_id() { return (unsigned)__builtin_amdgcn_s_getreg((3 << 11) | 20) & 0xFu; }
#define XB_SPIN(cond, bar) do { unsigned _sp = 0; while (cond) { __builtin_amdgcn_s_sleep(1); \
    if ((++_sp & 255u) == 0u) { if (xb_ld(&(bar)[XB_TMO])) break; if (_sp > XB_SPIN_CAP) { atomicAdd(&(bar)[XB_TMO], 1u); break; } } } } while (0)

struct XcdBarrier {
    unsigned* bar; unsigned x;
    volatile LAS unsigned* st;
};

__device__ __forceinline__ XcdBarrier xcd_barrier_post(unsigned* bar, volatile LAS unsigned* st) {
    XcdBarrier b; b.bar = bar; b.x = xb_xcc_id(); b.st = st;
    if (threadIdx.x == 0) (void)xb_add(&bar[XB_XCNT(b.x)], 1u);
    return b;
}
__device__ __forceinline__ void xcd_barrier_complete(unsigned* bar, unsigned x, unsigned& nloc, unsigned& nx) {
    const unsigned G = gridDim.x * gridDim.y * gridDim.z;
    unsigned sum, cnt, mine, sp = 0u;
    for (;;) {
        sum = 0u; cnt = 0u; mine = 0u;
#pragma unroll
        for (unsigned j = 0; j < 16; ++j) { const unsigned c = xb_ld(&bar[XB_XCNT(j)]); sum += c; cnt += (c > 0u) ? 1u : 0u; mine = (j == x) ? c : mine; }
        if (sum == G) break;
        __builtin_amdgcn_s_sleep(1);
        if ((++sp & 255u) == 0u) { if (xb_ld(&bar[XB_TMO])) break; if (sp > XB_SPIN_CAP) { atomicAdd(&bar[XB_TMO], 1u); break; } }
    }
    nloc = mine > 0u ? mine : 1u; nx = cnt > 0u ? cnt : 1u;
}

__device__ __forceinline__ void xcd_barrier(const XcdBarrier& b) {
    asm volatile("s_waitcnt vmcnt(0)" ::: "memory");
    __syncthreads();
    if (threadIdx.x == 0) {
        unsigned* bar = b.bar; const unsigned bx_ = xb_xcc_id();
        __builtin_amdgcn_s_waitcnt(0);
        unsigned nloc = b.st[0], nx = b.st[1];
        if (nloc == 0u) { xcd_barrier_complete(bar, bx_, nloc, nx); b.st[0] = nloc; b.st[1] = nx; }
        const unsigned old = xb_add(&bar[XB_XSUB(bx_)], 1u);
        const unsigned gen = old / nloc;
        if (old + 1u == (gen + 1u) * nloc) {
            __builtin_amdgcn_fence(__ATOMIC_RELEASE, "agent");
            asm volatile("s_waitcnt vmcnt(0)" ::: "memory");
            const unsigned og = xb_add(&bar[XB_TOP], 1u);
            const unsigned tg = og / nx;
            if (og + 1u == (tg + 1u) * nx) xb_add(&bar[XB_TOPGEN], 1u);
            else XB_SPIN(xb_ld(&bar[XB_TOPGEN]) == tg, bar);
            __builtin_amdgcn_fence(__ATOMIC_ACQUIRE, "agent");
            xb_add(&bar[XB_XGEN(bx_)], 1u);
            asm volatile("s_waitcnt vmcnt(0)" ::: "memory");
        } else {
            XB_SPIN(xb_ld(&bar[XB_XGEN(bx_)]) == gen, bar);
            __builtin_amdgcn_fence(__ATOMIC_ACQUIRE, "agent");
            asm volatile("s_waitcnt vmcnt(0)" ::: "memory");
        }
    }
    __syncthreads();
}

constexpr int NWAVES = 8;
constexpr int BATCH = 4, SEQ = 8192, D = 2048, DEPTH = 4, HEADS = 8, FF = 5632, INCOLS = 16384, NCHUNK = SEQ / 128;
constexpr int M = BATCH * SEQ;
constexpr float EPS = 1e-6f;
constexpr size_t MiB = 1u << 20;
constexpr size_t WS_CTL = 0, CTL_ZERO_BYTES = 1 * MiB;
constexpr size_t WS_CS = 1 * MiB;
constexpr size_t WS_WMASK = 33 * MiB;
constexpr size_t WS_WGU1 = 34 * MiB, WS_WD1 = 78 * MiB, WS_WIN = 100 * MiB, WS_WBR = 164 * MiB, WS_WBS = 172 * MiB, WS_WOUT = 180 * MiB, WS_WGU2 = 188 * MiB, WS_WD2 = 232 * MiB;
constexpr size_t WS_H = 256 * MiB;
constexpr size_t WS_BIG = 392 * MiB;
constexpr size_t WS_RT = 1452 * MiB;
constexpr size_t WS_SGST = WS_RT + 96 * MiB;
constexpr size_t WS_OPRE = WS_RT + 112 * MiB;
constexpr size_t WS_END = 1708 * MiB;
constexpr int LDT = pg8::LDT;
constexpr size_t TSTRIDE = (size_t)M * LDT;
constexpr int CW_BAR = 4096;
constexpr size_t WS_SSQ = WS_RT + 32 * MiB, SSQ_STRIDE = (size_t)M * 32;
constexpr int RING_BYTES = 131072;
constexpr int LDSCTL_OFF = RING_BYTES, MISC_OFF = LDSCTL_OFF + 320;
constexpr int RS_OFF = RING_BYTES + 1024;
constexpr int LDS_BYTES = 147456;

typedef short s16x4 __attribute__((ext_vector_type(4)));
typedef short v4i16_t __attribute__((ext_vector_type(4)));
typedef unsigned u32x2 __attribute__((ext_vector_type(2)));
typedef float f32x2v __attribute__((ext_vector_type(2)));

__device__ __forceinline__ float wave_sum(float v) {
#pragma unroll
    for (int o = 1; o < 64; o <<= 1) v += __shfl_xor(v, o);
    return v;
}
typedef float f32x2_t __attribute__((ext_vector_type(2))); typedef __bf16 bf16x2_t __attribute__((ext_vector_type(2)));
__device__ __forceinline__ unsigned cvtpk(float lo, float hi) { f32x2_t v = {lo, hi}; bf16x2_t b = __builtin_convertvector(v, bf16x2_t); return __builtin_bit_cast(unsigned, b); }
__device__ __forceinline__ float bflo(unsigned u) { return __uint_as_float(u << 16); }
__device__ __forceinline__ float bfhi(unsigned u) { return __uint_as_float(u & 0xffff0000u); }
__device__ __forceinline__ s16x4 vtr(const LAS unsigned char* p) { return __builtin_bit_cast(s16x4, __builtin_amdgcn_ds_read_tr16_b64_v4i16((LAS v4i16_t*)p)); }
__device__ __forceinline__ bf16x8 lds_tr_frag(const LAS unsigned char* tile, int strideB, int k0, int c0, int lane) {
    const int g = lane >> 4, q = (lane & 15) >> 2, p = lane & 3;
    const LAS unsigned char* a = tile + (k0 + 8 * g + q) * strideB + (c0 + 4 * p) * 2;
    const s16x4 lo = vtr(a), hi = vtr(a + 4 * strideB);
    return __builtin_shufflevector(lo, hi, 0, 1, 2, 3, 4, 5, 6, 7);
}
__device__ __forceinline__ bf16x8 lds_tr_frag_c(const LAS unsigned char* tile, int strideB, int k0, int c0, int lane) {
    const int g = lane >> 4, q = (lane & 15) >> 2, p = lane & 3;
    const LAS unsigned char* a = tile + (k0 + 4 * g + q) * strideB + (c0 + 4 * p) * 2;
    const s16x4 lo = vtr(a), hi = vtr(a + 16 * strideB);
    return __builtin_shufflevector(lo, hi, 0, 1, 2, 3, 4, 5, 6, 7);
}
#define MFMA16(a, b, c) __builtin_amdgcn_mfma_f32_16x16x32_bf16((a), (b), (c), 0, 0, 0)
__device__ __forceinline__ float log2_gamma(int h) {
    const float x = __builtin_amdgcn_exp2f(-5.0f - (float)h);
    const float l = -x * (1.0f + x * (0.5f + x * (0.33333334f + x * (0.25f + x * (0.2f + x * 0.16666667f)))));
    return l * 1.44269504f;
}

__device__ __forceinline__ void conv_item(const float* W, int K, int N, bf16* WT, int mode, const float* gain, LAS float* scr, int item, int lane) {
    const int nblk = N / 32, kb = item / nblk, nb = item % nblk, k0 = 64 * kb, n0 = 32 * nb;
#pragma unroll
    for (int i = 0; i < 8; ++i) { const int kk = 8 * i + (lane >> 3), nn = 4 * (lane & 7);
        const f32x4 v = *(const f32x4*)(W + (size_t)(k0 + kk) * N + n0 + nn);
        LAS float* d = scr + kk * 33 + nn; d[0] = v[0]; d[1] = v[1]; d[2] = v[2]; d[3] = v[3]; }
    LDS_WAIT(); asm volatile("" ::: "memory");
    int r0 = n0;
    if (mode == 3) r0 = ((((n0 >> 11) + 5) & 7) << 11) + (n0 & 2047);
    if (mode == 1) { const int isg = n0 >= FF, j0 = isg ? n0 - FF : n0; r0 = 256 * (j0 >> 7) + (j0 & 127) + (isg ? 128 : 0); }
    const int c = lane & 7;
    f32x4 ga = {1.f, 1.f, 1.f, 1.f}, gb = {1.f, 1.f, 1.f, 1.f};
    if (gain) { ga = *(const f32x4*)(gain + k0 + 8 * c); gb = *(const f32x4*)(gain + k0 + 8 * c + 4); }
#pragma unroll
    for (int j = 0; j < 4; ++j) { const int n = (lane >> 3) + 8 * j; const LAS float* s = scr + (8 * c) * 33 + n;
        v4u o; o.x = pk2(s[0 * 33] * ga[0], s[1 * 33] * ga[1]); o.y = pk2(s[2 * 33] * ga[2], s[3 * 33] * ga[3]); o.z = pk2(s[4 * 33] * gb[0], s[5 * 33] * gb[1]); o.w = pk2(s[6 * 33] * gb[2], s[7 * 33] * gb[3]);
        *(GAS v4u*)(WT + (size_t)(r0 + n) * K + k0 + 8 * c) = o; }
    LDS_WAIT(); asm volatile("" ::: "memory");
}
struct ConvSrc { const float *gu1, *d1, *win, *br, *bs, *wo, *gu2, *d2, *sw, *g1, *gm, *g2; };
__device__ __forceinline__ void phase_conv(LAS unsigned char* lds, unsigned char* ws, const ConvSrc& s, int gw, int NGW, int wave, int lane) {
    asm volatile("" : "+v"(lane));
    LAS float* scr = (LAS float*)(lds + wave * 16384);
    constexpr int I_GU = (D / 64) * (2 * FF / 32), I_D = (FF / 64) * (D / 32), I_IN = (D / 64) * (INCOLS / 32), I_SQ = (D / 64) * (D / 32);
    constexpr int NITEMS = 2 * I_GU + 2 * I_D + I_IN + 3 * I_SQ;
    for (int it = gw; it < NITEMS; it += NGW) {
        int r = it;
        if (r < I_GU) { conv_item(s.gu1, D, 2 * FF, (bf16*)(ws + WS_WGU1), 1, s.g1, scr, r, lane); continue; } r -= I_GU;
        if (r < I_GU) { conv_item(s.gu2, D, 2 * FF, (bf16*)(ws + WS_WGU2), 1, s.g2, scr, r, lane); continue; } r -= I_GU;
        if (r < I_D) { conv_item(s.d1, FF, D, (bf16*)(ws + WS_WD1), 0, nullptr, scr, r, lane); continue; } r -= I_D;
        if (r < I_D) { conv_item(s.d2, FF, D, (bf16*)(ws + WS_WD2), 0, nullptr, scr, r, lane); continue; } r -= I_D;
        if (r < I_IN) { conv_item(s.win, D, INCOLS, (bf16*)(ws + WS_WIN), 3, s.gm, scr, r, lane); continue; } r -= I_IN;
        if (r < I_SQ) { conv_item(s.br, D, D, (bf16*)(ws + WS_WBR), 0, nullptr, scr, r, lane); continue; } r -= I_SQ;
        if (r < I_SQ) { conv_item(s.bs, D, D, (bf16*)(ws + WS_WBS), 0, nullptr, scr, r, lane); continue; } r -= I_SQ;
        conv_item(s.wo, D, D, (bf16*)(ws + WS_WOUT), 0, nullptr, scr, r, lane);
    }
    bf16* wm = (bf16*)(ws + WS_WMASK);
    for (int e = gw * 64 + lane; e < 8 * 128 * 128; e += NGW * 64) { const int j = e & 127, i = (e >> 7) & 127; wm[e] = (bf16)((j <= i) ? f2bf(s.sw[e]) : 0u); }
}
__device__ __forceinline__ void phase_final(const bf16* Xb, float* out, const float* gain, int gw, int NGW, int lane) {
    asm volatile("" : "+v"(lane));
    f32x4 g0[4], g1[4];
#pragma unroll
    for (int j = 0; j < 4; ++j) { g0[j] = *(const f32x4*)(gain + (lane + 64 * j) * 8); g1[j] = *(const f32x4*)(gain + (lane + 64 * j) * 8 + 4); }
    for (int m = gw; m < M; m += NGW) {
        const v4u* xr = (const v4u*)(Xb + (size_t)m * LDT) + lane;
        float x[4][8]; float s = 0.f;
#pragma unroll
        for (int j = 0; j < 4; ++j) { const v4u w = xr[64 * j];
            x[j][0] = bflo(w.x); x[j][1] = bfhi(w.x); x[j][2] = bflo(w.y); x[j][3] = bfhi(w.y); x[j][4] = bflo(w.z); x[j][5] = bfhi(w.z); x[j][6] = bflo(w.w); x[j][7] = bfhi(w.w);
#pragma unroll
            for (int e = 0; e < 8; ++e) s += x[j][e] * x[j][e]; }
        const float rs = 1.0f / sqrtf(wave_sum(s) * (1.0f / D) + EPS);
        float* orow = out + (size_t)m * D;
#pragma unroll
        for (int j = 0; j < 4; ++j) { f32x4 o0, o1;
            o0[0] = x[j][0] * rs * g0[j][0]; o0[1] = x[j][1] * rs * g0[j][1]; o0[2] = x[j][2] * rs * g0[j][2]; o0[3] = x[j][3] * rs * g0[j][3];
            o1[0] = x[j][4] * rs * g1[j][0]; o1[1] = x[j][5] * rs * g1[j][1]; o1[2] = x[j][6] * rs * g1[j][2]; o1[3] = x[j][7] * rs * g1[j][3];
            *(f32x4*)(orow + (lane + 64 * j) * 8) = o0; *(f32x4*)(orow + (lane + 64 * j) * 8 + 4) = o1; }
    }
}
#define LDS_BARRIER() do { asm volatile("s_waitcnt lgkmcnt(0)" ::: "memory"); __builtin_amdgcn_s_barrier(); asm volatile("" ::: "memory"); } while (0)
__device__ __forceinline__ bf16x8 lds_tr_pair(const LAS unsigned char* tile, int strideB, int r0, int r1, int c0, int lane) {
    const int q = (lane & 15) >> 2, p = lane & 3;
    const s16x4 lo = vtr(tile + (r0 + q) * strideB + (c0 + 4 * p) * 2), hi = vtr(tile + (r1 + q) * strideB + (c0 + 4 * p) * 2);
    return __builtin_shufflevector(lo, hi, 0, 1, 2, 3, 4, 5, 6, 7);
}
__device__ __forceinline__ void phase_ret(LAS unsigned char* lds, const bf16* Q, const bf16* Kb, const bf16* V, bf16* Opre, float* stats, int vcu, int G, int tid) {
    asm volatile("" : "+v"(tid));
    const int lane = tid & 63, w = __builtin_amdgcn_readfirstlane(tid >> 6), i16 = lane & 15, g4 = lane >> 4;
    const int ib = (w < 4) ? w : 11 - w;
    LAS unsigned char* K_t = lds;
    LAS unsigned char* V_t = lds + 69632;
    LAS unsigned char* RT_t = lds + 94208;
    for (int u = vcu; u < BATCH * HEADS * 8; u += G) {
        const int es = u & 7, h = (u >> 3) & 7, b = u >> 6, hc = h * 256;
        const float lg2 = log2_gamma(h), gamma_c = __builtin_amdgcn_exp2f(128.0f * lg2);
        const size_t tb = (size_t)b * SEQ;
        f32x4 r[2][2];
#pragma unroll
        for (int a = 0; a < 2; ++a)
#pragma unroll
            for (int c = 0; c < 2; ++c) r[a][c] = (f32x4){0.f, 0.f, 0.f, 0.f};
        { v4u zz = (v4u){0u, 0u, 0u, 0u}; asm volatile("" : "+v"(zz));
          int tz = tid; asm volatile("" : "+v"(tz));
          for (int c = tz; c < 17408 / 16; c += NWAVES * 64) *(LAS v4u*)(RT_t + c * 16) = zz; }
        v4u kpre[8], vpre;
        const bf16* kg = Kb + (tb + (tid >> 5)) * LDT + hc + (tid & 31) * 8;
        const bf16* vg = V + (tb + (tid >> 2)) * LDT + hc + 32 * es + (tid & 3) * 8;
        const bf16* qg = Q + (tb + 16 * ib + i16) * LDT + hc + 8 * g4;
#pragma unroll
        for (int k = 0; k < 8; ++k) kpre[k] = *(const v4u*)(kg + (size_t)k * 16 * LDT);
        vpre = *(const v4u*)vg;
        const int i = 16 * ib + i16;
        bf16x8 qf[8];
#pragma unroll
        for (int ks = 0; ks < 8; ++ks) qf[ks] = *(const bf16x8*)(qg + 32 * ks);
        for (int n = 0; n < NCHUNK; ++n) {
            LDS_BARRIER();
#pragma unroll
            for (int k = 0; k < 8; ++k) *(LAS v4u*)(K_t + ((tid >> 5) + 16 * k) * 544 + (tid & 31) * 16) = kpre[k];
            *(LAS v4u*)(V_t + (tid >> 2) * 96 + (tid & 3) * 16) = vpre;
            {
                const size_t adv = (size_t)((n + 1 < NCHUNK) ? n + 1 : n) * 128 * LDT;
#pragma unroll
                for (int k = 0; k < 8; ++k) kpre[k] = *(const v4u*)(kg + adv + (size_t)k * 16 * LDT);
                vpre = *(const v4u*)(vg + adv);
            }
            LDS_BARRIER();
            const LAS unsigned char* RT_c = RT_t + (n & 1) * 17408; LAS unsigned char* RT_n = RT_t + ((n & 1) ^ 1) * 17408;
#define RET_ST_BLOCK1(S0, AD) do { bf16x8 k0_, k1_, k2_, k3_, k4_, k5_, k6_, k7_; asm volatile( \
                "ds_read_b128 %[k0], %[ad] offset:0\n\t" \
                "ds_read_b128 %[k1], %[ad] offset:64\n\t" \
                "ds_read_b128 %[k2], %[ad] offset:128\n\t" \
                "ds_read_b128 %[k3], %[ad] offset:192\n\t" \
                "ds_read_b128 %[k4], %[ad] offset:256\n\t" \
                "ds_read_b128 %[k5], %[ad] offset:320\n\t" \
                "ds_read_b128 %[k6], %[ad] offset:384\n\t" \
                "ds_read_b128 %[k7], %[ad] offset:448\n\t" \
                "s_waitcnt lgkmcnt(7)\n\t" \
                "v_mfma_f32_16x16x32_bf16 %[s0], %[k0], %[q0], 0\n\t" \
                "s_waitcnt lgkmcnt(6)\n\t" \
                "v_mfma_f32_16x16x32_bf16 %[s0], %[k1], %[q1], %[s0]\n\t" \
                "s_waitcnt lgkmcnt(5)\n\t" \
                "v_mfma_f32_16x16x32_bf16 %[s0], %[k2], %[q2], %[s0]\n\t" \
                "s_waitcnt lgkmcnt(4)\n\t" \
                "v_mfma_f32_16x16x32_bf16 %[s0], %[k3], %[q3], %[s0]\n\t" \
                "s_waitcnt lgkmcnt(3)\n\t" \
                "v_mfma_f32_16x16x32_bf16 %[s0], %[k4], %[q4], %[s0]\n\t" \
                "s_waitcnt lgkmcnt(2)\n\t" \
                "v_mfma_f32_16x16x32_bf16 %[s0], %[k5], %[q5], %[s0]\n\t" \
                "s_waitcnt lgkmcnt(1)\n\t" \
                "v_mfma_f32_16x16x32_bf16 %[s0], %[k6], %[q6], %[s0]\n\t" \
                "s_waitcnt lgkmcnt(0)\n\t" \
                "v_mfma_f32_16x16x32_bf16 %[s0], %[k7], %[q7], %[s0]\n\t" \
                "s_nop 7\n\t" \
                "s_nop 7\n\t" \
                "s_nop 7\n\t" \
                : [s0] "=&v"(S0), [k0] "=&v"(k0_), [k1] "=&v"(k1_), [k2] "=&v"(k2_), [k3] "=&v"(k3_), [k4] "=&v"(k4_), [k5] "=&v"(k5_), [k6] "=&v"(k6_), [k7] "=&v"(k7_) \
                : [ad] "v"(AD), [q0] "v"(qf[0]), [q1] "v"(qf[1]), [q2] "v"(qf[2]), [q3] "v"(qf[3]), [q4] "v"(qf[4]), [q5] "v"(qf[5]), [q6] "v"(qf[6]), [q7] "v"(qf[7]) : "memory"); } while (0)
#define RET_ST_BLOCK2(S0, S1, AD) do { bf16x8 k0_, k1_, k2_, k3_, k4_, k5_, k6_, k7_; asm volatile( \
                "ds_read_b128 %[k0], %[ad] offset:0\n\t" \
                "ds_read_b128 %[k1], %[ad] offset:8704\n\t" \
                "ds_read_b128 %[k2], %[ad] offset:64\n\t" \
                "ds_read_b128 %[k3], %[ad] offset:8768\n\t" \
                "ds_read_b128 %[k4], %[ad] offset:128\n\t" \
                "ds_read_b128 %[k5], %[ad] offset:8832\n\t" \
                "ds_read_b128 %[k6], %[ad] offset:192\n\t" \
                "ds_read_b128 %[k7], %[ad] offset:8896\n\t" \
                "s_waitcnt lgkmcnt(7)\n\t" \
                "v_mfma_f32_16x16x32_bf16 %[s0], %[k0], %[q0], 0\n\t" \
                "ds_read_b128 %[k0], %[ad] offset:256\n\t" \
                "s_waitcnt lgkmcnt(7)\n\t" \
                "v_mfma_f32_16x16x32_bf16 %[s1], %[k1], %[q0], 0\n\t" \
                "ds_read_b128 %[k1], %[ad] offset:8960\n\t" \
                "s_waitcnt lgkmcnt(7)\n\t" \
                "v_mfma_f32_16x16x32_bf16 %[s0], %[k2], %[q1], %[s0]\n\t" \
                "ds_read_b128 %[k2], %[ad] offset:320\n\t" \
                "s_waitcnt lgkmcnt(7)\n\t" \
                "v_mfma_f32_16x16x32_bf16 %[s1], %[k3], %[q1], %[s1]\n\t" \
                "ds_read_b128 %[k3], %[ad] offset:9024\n\t" \
                "s_waitcnt lgkmcnt(7)\n\t" \
                "v_mfma_f32_16x16x32_bf16 %[s0], %[k4], %[q2], %[s0]\n\t" \
                "ds_read_b128 %[k4], %[ad] offset:384\n\t" \
                "s_waitcnt lgkmcnt(7)\n\t" \
                "v_mfma_f32_16x16x32_bf16 %[s1], %[k5], %[q2], %[s1]\n\t" \
                "ds_read_b128 %[k5], %[ad] offset:9088\n\t" \
                "s_waitcnt lgkmcnt(7)\n\t" \
                "v_mfma_f32_16x16x32_bf16 %[s0], %[k6], %[q3], %[s0]\n\t" \
                "ds_read_b128 %[k6], %[ad] offset:448\n\t" \
                "s_waitcnt lgkmcnt(7)\n\t" \
                "v_mfma_f32_16x16x32_bf16 %[s1], %[k7], %[q3], %[s1]\n\t" \
                "ds_read_b128 %[k7], %[ad] offset:9152\n\t" \
                "s_waitcnt lgkmcnt(7)\n\t" \
                "v_mfma_f32_16x16x32_bf16 %[s0], %[k0], %[q4], %[s0]\n\t" \
                "s_waitcnt lgkmcnt(6)\n\t" \
                "v_mfma_f32_16x16x32_bf16 %[s1], %[k1], %[q4], %[s1]\n\t" \
                "s_waitcnt lgkmcnt(5)\n\t" \
                "v_mfma_f32_16x16x32_bf16 %[s0], %[k2], %[q5], %[s0]\n\t" \
                "s_waitcnt lgkmcnt(4)\n\t" \
                "v_mfma_f32_16x16x32_bf16 %[s1], %[k3], %[q5], %[s1]\n\t" \
                "s_waitcnt lgkmcnt(3)\n\t" \
                "v_mfma_f32_16x16x32_bf16 %[s0], %[k4], %[q6], %[s0]\n\t" \
                "s_waitcnt lgkmcnt(2)\n\t" \
                "v_mfma_f32_16x16x32_bf16 %[s1], %[k5], %[q6], %[s1]\n\t" \
                "s_waitcnt lgkmcnt(1)\n\t" \
                "v_mfma_f32_16x16x32_bf16 %[s0], %[k6], %[q7], %[s0]\n\t" \
                "s_waitcnt lgkmcnt(0)\n\t" \
                "v_mfma_f32_16x16x32_bf16 %[s1], %[k7], %[q7], %[s1]\n\t" \
                "s_nop 7\n\t" \
                "s_nop 7\n\t" \
                "s_nop 7\n\t" \
                : [s0] "=&v"(S0), [s1] "=&v"(S1), [k0] "=&v"(k0_), [k1] "=&v"(k1_), [k2] "=&v"(k2_), [k3] "=&v"(k3_), [k4] "=&v"(k4_), [k5] "=&v"(k5_), [k6] "=&v"(k6_), [k7] "=&v"(k7_) \
                : [ad] "v"(AD), [q0] "v"(qf[0]), [q1] "v"(qf[1]), [q2] "v"(qf[2]), [q3] "v"(qf[3]), [q4] "v"(qf[4]), [q5] "v"(qf[5]), [q6] "v"(qf[6]), [q7] "v"(qf[7]) : "memory"); } while (0)
#define RET_ST_BLOCK3(S0, S1, S2, AD) do { bf16x8 k0_, k1_, k2_, k3_, k4_, k5_, k6_, k7_; asm volatile( \
                "ds_read_b128 %[k0], %[ad] offset:0\n\t" \
                "ds_read_b128 %[k1], %[ad] offset:8704\n\t" \
                "ds_read_b128 %[k2], %[ad] offset:17408\n\t" \
                "ds_read_b128 %[k3], %[ad] offset:64\n\t" \
                "ds_read_b128 %[k4], %[ad] offset:8768\n\t" \
                "ds_read_b128 %[k5], %[ad] offset:17472\n\t" \
                "ds_read_b128 %[k6], %[ad] offset:128\n\t" \
                "ds_read_b128 %[k7], %[ad] offset:8832\n\t" \
                "s_waitcnt lgkmcnt(7)\n\t" \
                "v_mfma_f32_16x16x32_bf16 %[s0], %[k0], %[q0], 0\n\t" \
                "ds_read_b128 %[k0], %[ad] offset:17536\n\t" \
                "s_waitcnt lgkmcnt(7)\n\t" \
                "v_mfma_f32_16x16x32_bf16 %[s1], %[k1], %[q0], 0\n\t" \
                "ds_read_b128 %[k1], %[ad] offset:192\n\t" \
                "s_waitcnt lgkmcnt(7)\n\t" \
                "v_mfma_f32_16x16x32_bf16 %[s2], %[k2], %[q0], 0\n\t" \
                "ds_read_b128 %[k2], %[ad] offset:8896\n\t" \
                "s_waitcnt lgkmcnt(7)\n\t" \
                "v_mfma_f32_16x16x32_bf16 %[s0], %[k3], %[q1], %[s0]\n\t" \
                "ds_read_b128 %[k3], %[ad] offset:17600\n\t" \
                "s_waitcnt lgkmcnt(7)\n\t" \
                "v_mfma_f32_16x16x32_bf16 %[s1], %[k4], %[q1], %[s1]\n\t" \
                "ds_read_b128 %[k4], %[ad] offset:256\n\t" \
                "s_waitcnt lgkmcnt(7)\n\t" \
                "v_mfma_f32_16x16x32_bf16 %[s2], %[k5], %[q1], %[s2]\n\t" \
                "ds_read_b128 %[k5], %[ad] offset:8960\n\t" \
                "s_waitcnt lgkmcnt(7)\n\t" \
                "v_mfma_f32_16x16x32_bf16 %[s0], %[k6], %[q2], %[s0]\n\t" \
                "ds_read_b128 %[k6], %[ad] offset:17664\n\t" \
                "s_waitcnt lgkmcnt(7)\n\t" \
                "v_mfma_f32_16x16x32_bf16 %[s1], %[k7], %[q2], %[s1]\n\t" \
                "ds_read_b128 %[k7], %[ad] offset:320\n\t" \
                "s_waitcnt lgkmcnt(7)\n\t" \
                "v_mfma_f32_16x16x32_bf16 %[s2], %[k0], %[q2], %[s2]\n\t" \
                "ds_read_b128 %[k0], %[ad] offset:9024\n\t" \
                "s_waitcnt lgkmcnt(7)\n\t" \
                "v_mfma_f32_16x16x32_bf16 %[s0], %[k1], %[q3], %[s0]\n\t" \
                "ds_read_b128 %[k1], %[ad] offset:17728\n\t" \
                "s_waitcnt lgkmcnt(7)\n\t" \
                "v_mfma_f32_16x16x32_bf16 %[s1], %[k2], %[q3], %[s1]\n\t" \
                "ds_read_b128 %[k2], %[ad] offset:384\n\t" \
                "s_waitcnt lgkmcnt(7)\n\t" \
                "v_mfma_f32_16x16x32_bf16 %[s2], %[k3], %[q3], %[s2]\n\t" \
                "ds_read_b128 %[k3], %[ad] offset:9088\n\t" \
                "s_waitcnt lgkmcnt(7)\n\t" \
                "v_mfma_f32_16x16x32_bf16 %[s0], %[k4], %[q4], %[s0]\n\t" \
                "ds_read_b128 %[k4], %[ad] offset:17792\n\t" \
                "s_waitcnt lgkmcnt(7)\n\t" \
                "v_mfma_f32_16x16x32_bf16 %[s1], %[k5], %[q4], %[s1]\n\t" \
                "ds_read_b128 %[k5], %[ad] offset:448\n\t" \
                "s_waitcnt lgkmcnt(7)\n\t" \
                "v_mfma_f32_16x16x32_bf16 %[s2], %[k6], %[q4], %[s2]\n\t" \
                "ds_read_b128 %[k6], %[ad] offset:9152\n\t" \
                "s_waitcnt lgkmcnt(7)\n\t" \
                "v_mfma_f32_16x16x32_bf16 %[s0], %[k7], %[q5], %[s0]\n\t" \
                "ds_read_b128 %[k7], %[ad] offset:17856\n\t" \
                "s_waitcnt lgkmcnt(7)\n\t" \
                "v_mfma_f32_16x16x32_bf16 %[s1], %[k0], %[q5], %[s1]\n\t" \
                "s_waitcnt lgkmcnt(6)\n\t" \
                "v_mfma_f32_16x16x32_bf16 %[s2], %[k1], %[q5], %[s2]\n\t" \
                "s_waitcnt lgkmcnt(5)\n\t" \
                "v_mfma_f32_16x16x32_bf16 %[s0], %[k2], %[q6], %[s0]\n\t" \
                "s_waitcnt lgkmcnt(4)\n\t" \
                "v_mfma_f32_16x16x32_bf16 %[s1], %[k3], %[q6], %[s1]\n\t" \
                "s_waitcnt lgkmcnt(3)\n\t" \
                "v_mfma_f32_16x16x32_bf16 %[s2], %[k4], %[q6], %[s2]\n\t" \
                "s_waitcnt lgkmcnt(2)\n\t" \
                "v_mfma_f32_16x16x32_bf16 %[s0], %[k5], %[q7], %[s0]\n\t" \
                "s_waitcnt lgkmcnt(1)\n\t" \
                "v_mfma_f32_16x16x32_bf16 %[s1], %[k6], %[q7], %[s1]\n\t" \
                "s_waitcnt lgkmcnt(0)\n\t" \
                "v_mfma_f32_16x16x32_bf16 %[s2], %[k7], %[q7], %[s2]\n\t" \
                "s_nop 7\n\t" \
                "s_nop 7\n\t" \
                "s_nop 7\n\t" \
                : [s0] "=&v"(S0), [s1] "=&v"(S1), [s2] "=&v"(S2), [k0] "=&v"(k0_), [k1] "=&v"(k1_), [k2] "=&v"(k2_), [k3] "=&v"(k3_), [k4] "=&v"(k4_), [k5] "=&v"(k5_), [k6] "=&v"(k6_), [k7] "=&v"(k7_) \
                : [ad] "v"(AD), [q0] "v"(qf[0]), [q1] "v"(qf[1]), [q2] "v"(qf[2]), [q3] "v"(qf[3]), [q4] "v"(qf[4]), [q5] "v"(qf[5]), [q6] "v"(qf[6]), [q7] "v"(qf[7]) : "memory"); } while (0)
#define RET_ST_BLOCK4(S0, S1, S2, S3, AD) do { bf16x8 k0_, k1_, k2_, k3_, k4_, k5_, k6_, k7_; asm volatile( \
                "ds_read_b128 %[k0], %[ad] offset:0\n\t" \
                "ds_read_b128 %[k1], %[ad] offset:8704\n\t" \
                "ds_read_b128 %[k2], %[ad] offset:17408\n\t" \
                "ds_read_b128 %[k3], %[ad] offset:26112\n\t" \
                "ds_read_b128 %[k4], %[ad] offset:64\n\t" \
                "ds_read_b128 %[k5], %[ad] offset:8768\n\t" \
                "ds_read_b128 %[k6], %[ad] offset:17472\n\t" \
                "ds_read_b128 %[k7], %[ad] offset:26176\n\t" \
                "s_waitcnt lgkmcnt(7)\n\t" \
                "v_mfma_f32_16x16x32_bf16 %[s0], %[k0], %[q0], 0\n\t" \
                "ds_read_b128 %[k0], %[ad] offset:128\n\t" \
                "s_waitcnt lgkmcnt(7)\n\t" \
                "v_mfma_f32_16x16x32_bf16 %[s1], %[k1], %[q0], 0\n\t" \
                "ds_read_b128 %[k1], %[ad] offset:8832\n\t" \
                "s_waitcnt lgkmcnt(7)\n\t" \
                "v_mfma_f32_16x16x32_bf16 %[s2], %[k2], %[q0], 0\n\t" \
                "ds_read_b128 %[k2], %[ad] offset:17536\n\t" \
                "s_waitcnt lgkmcnt(7)\n\t" \
                "v_mfma_f32_16x16x32_bf16 %[s3], %[k3], %[q0], 0\n\t" \
                "ds_read_b128 %[k3], %[ad] offset:26240\n\t" \
                "s_waitcnt lgkmcnt(7)\n\t" \
                "v_mfma_f32_16x16x32_bf16 %[s0], %[k4], %[q1], %[s0]\n\t" \
                "ds_read_b128 %[k4], %[ad] offset:192\n\t" \
                "s_waitcnt lgkmcnt(7)\n\t" \
                "v_mfma_f32_16x16x32_bf16 %[s1], %[k5], %[q1], %[s1]\n\t" \
                "ds_read_b128 %[k5], %[ad] offset:8896\n\t" \
                "s_waitcnt lgkmcnt(7)\n\t" \
                "v_mfma_f32_16x16x32_bf16 %[s2], %[k6], %[q1], %[s2]\n\t" \
                "ds_read_b128 %[k6], %[ad] offset:17600\n\t" \
                "s_waitcnt lgkmcnt(7)\n\t" \
                "v_mfma_f32_16x16x32_bf16 %[s3], %[k7], %[q1], %[s3]\n\t" \
                "ds_read_b128 %[k7], %[ad] offset:26304\n\t" \
                "s_waitcnt lgkmcnt(7)\n\t" \
                "v_mfma_f32_16x16x32_bf16 %[s0], %[k0], %[q2], %[s0]\n\t" \
                "ds_read_b128 %[k0], %[ad] offset:256\n\t" \
                "s_waitcnt lgkmcnt(7)\n\t" \
                "v_mfma_f32_16x16x32_bf16 %[s1], %[k1], %[q2], %[s1]\n\t" \
                "ds_read_b128 %[k1], %[ad] offset:8960\n\t" \
                "s_waitcnt lgkmcnt(7)\n\t" \
                "v_mfma_f32_16x16x32_bf16 %[s2], %[k2], %[q2], %[s2]\n\t" \
                "ds_read_b128 %[k2], %[ad] offset:17664\n\t" \
                "s_waitcnt lgkmcnt(7)\n\t" \
                "v_mfma_f32_16x16x32_bf16 %[s3], %[k3], %[q2], %[s3]\n\t" \
                "ds_read_b128 %[k3], %[ad] offset:26368\n\t" \
                "s_waitcnt lgkmcnt(7)\n\t" \
                "v_mfma_f32_16x16x32_bf16 %[s0], %[k4], %[q3], %[s0]\n\t" \
                "ds_read_b128 %[k4], %[ad] offset:320\n\t" \
                "s_waitcnt lgkmcnt(7)\n\t" \
                "v_mfma_f32_16x16x32_bf16 %[s1], %[k5], %[q3], %[s1]\n\t" \
                "ds_read_b128 %[k5], %[ad] offset:9024\n\t" \
                "s_waitcnt lgkmcnt(7)\n\t" \
                "v_mfma_f32_16x16x32_bf16 %[s2], %[k6], %[q3], %[s2]\n\t" \
                "ds_read_b128 %[k6], %[ad] offset:17728\n\t" \
                "s_waitcnt lgkmcnt(7)\n\t" \
                "v_mfma_f32_16x16x32_bf16 %[s3], %[k7], %[q3], %[s3]\n\t" \
                "ds_read_b128 %[k7], %[ad] offset:26432\n\t" \
                "s_waitcnt lgkmcnt(7)\n\t" \
                "v_mfma_f32_16x16x32_bf16 %[s0], %[k0], %[q4], %[s0]\n\t" \
                "ds_read_b128 %[k0], %[ad] offset:384\n\t" \
                "s_waitcnt lgkmcnt(7)\n\t" \
                "v_mfma_f32_16x16x32_bf16 %[s1], %[k1], %[q4], %[s1]\n\t" \
                "ds_read_b128 %[k1], %[ad] offset:9088\n\t" \
                "s_waitcnt lgkmcnt(7)\n\t" \
                "v_mfma_f32_16x16x32_bf16 %[s2], %[k2], %[q4], %[s2]\n\t" \
                "ds_read_b128 %[k2], %[ad] offset:17792\n\t" \
                "s_waitcnt lgkmcnt(7)\n\t" \
                "v_mfma_f32_16x16x32_bf16 %[s3], %[k3], %[q4], %[s3]\n\t" \
                "ds_read_b128 %[k3], %[ad] offset:26496\n\t" \
                "s_waitcnt lgkmcnt(7)\n\t" \
                "v_mfma_f32_16x16x32_bf16 %[s0], %[k4], %[q5], %[s0]\n\t" \
                "ds_read_b128 %[k4], %[ad] offset:448\n\t" \
                "s_waitcnt lgkmcnt(7)\n\t" \
                "v_mfma_f32_16x16x32_bf16 %[s1], %[k5], %[q5], %[s1]\n\t" \
                "ds_read_b128 %[k5], %[ad] offset:9152\n\t" \
                "s_waitcnt lgkmcnt(7)\n\t" \
                "v_mfma_f32_16x16x32_bf16 %[s2], %[k6], %[q5], %[s2]\n\t" \
                "ds_read_b128 %[k6], %[ad] offset:17856\n\t" \
                "s_waitcnt lgkmcnt(7)\n\t" \
                "v_mfma_f32_16x16x32_bf16 %[s3], %[k7], %[q5], %[s3]\n\t" \
                "ds_read_b128 %[k7], %[ad] offset:26560\n\t" \
                "s_waitcnt lgkmcnt(7)\n\t" \
                "v_mfma_f32_16x16x32_bf16 %[s0], %[k0], %[q6], %[s0]\n\t" \
                "s_waitcnt lgkmcnt(6)\n\t" \
                "v_mfma_f32_16x16x32_bf16 %[s1], %[k1], %[q6], %[s1]\n\t" \
                "s_waitcnt lgkmcnt(5)\n\t" \
                "v_mfma_f32_16x16x32_bf16 %[s2], %[k2], %[q6], %[s2]\n\t" \
                "s_waitcnt lgkmcnt(4)\n\t" \
                "v_mfma_f32_16x16x32_bf16 %[s3], %[k3], %[q6], %[s3]\n\t" \
                "s_waitcnt lgkmcnt(3)\n\t" \
                "v_mfma_f32_16x16x32_bf16 %[s0], %[k4], %[q7], %[s0]\n\t" \
                "s_waitcnt lgkmcnt(2)\n\t" \
                "v_mfma_f32_16x16x32_bf16 %[s1], %[k5], %[q7], %[s1]\n\t" \
                "s_waitcnt lgkmcnt(1)\n\t" \
                "v_mfma_f32_16x16x32_bf16 %[s2], %[k6], %[q7], %[s2]\n\t" \
                "s_waitcnt lgkmcnt(0)\n\t" \
                "v_mfma_f32_16x16x32_bf16 %[s3], %[k7], %[q7], %[s3]\n\t" \
                "s_nop 7\n\t" \
                "s_nop 7\n\t" \
                "s_nop 7\n\t" \
                : [s0] "=&v"(S0), [s1] "=&v"(S1), [s2] "=&v"(S2), [s3] "=&v"(S3), [k0] "=&v"(k0_), [k1] "=&v"(k1_), [k2] "=&v"(k2_), [k3] "=&v"(k3_), [k4] "=&v"(k4_), [k5] "=&v"(k5_), [k6] "=&v"(k6_), [k7] "=&v"(k7_) \
                : [ad] "v"(AD), [q0] "v"(qf[0]), [q1] "v"(qf[1]), [q2] "v"(qf[2]), [q3] "v"(qf[3]), [q4] "v"(qf[4]), [q5] "v"(qf[5]), [q6] "v"(qf[6]), [q7] "v"(qf[7]) : "memory"); } while (0)
#define RET_PACK(P0) do { _Pragma("unroll") for (int p_ = 0; p_ < 2; ++p_) { float m[8]; \
                _Pragma("unroll") for (int rr = 0; rr < 4; ++rr) { const int j0 = 32 * (P0 + p_) + 4 * g4 + rr, j1 = j0 + 16; \
                    m[rr] = (j0 <= i) ? sacc[2 * p_][rr] : 0.f; \
                    m[4 + rr] = (j1 <= i) ? sacc[2 * p_ + 1][rr] : 0.f; } \
                v4u sw; sw.x = cvtpk(m[0], m[1]); sw.y = cvtpk(m[2], m[3]); sw.z = cvtpk(m[4], m[5]); sw.w = cvtpk(m[6], m[7]); \
                sf[P0 + p_] = __builtin_bit_cast(bf16x8, sw); } } while (0)
            bf16x8 sf[4];
            { f32x4 sacc[4];
              const unsigned kad = (unsigned)(size_t)(K_t + i16 * 544 + 16 * g4);
#define RET_ST_N(NB_, AD_) do { const f32x4 z4_ = (f32x4){0.f, 0.f, 0.f, 0.f}; \
                if ((NB_) == 4) RET_ST_BLOCK4(sacc[0], sacc[1], sacc[2], sacc[3], AD_); \
                else if ((NB_) == 3) { RET_ST_BLOCK3(sacc[0], sacc[1], sacc[2], AD_); sacc[3] = z4_; } \
                else if ((NB_) == 2) { RET_ST_BLOCK2(sacc[0], sacc[1], AD_); sacc[2] = z4_; sacc[3] = z4_; } \
                else { RET_ST_BLOCK1(sacc[0], AD_); sacc[1] = z4_; sacc[2] = z4_; sacc[3] = z4_; } } while (0)
              const int nb1 = (ib < 3) ? ib + 1 : 4;
              RET_ST_N(nb1, kad);
              RET_PACK(0);
              if (ib >= 4) { const unsigned kad2 = kad + 34816u; const int nb2 = ib - 3; RET_ST_N(nb2, kad2); RET_PACK(2); }
              else { sf[2] = __builtin_bit_cast(bf16x8, (v4u){0u, 0u, 0u, 0u}); sf[3] = sf[2]; } }
#undef RET_ST_N
#undef RET_PACK
#undef RET_ST_BLOCK1
#undef RET_ST_BLOCK2
#undef RET_ST_BLOCK3
#undef RET_ST_BLOCK4
            f32x4 o[2];
            o[0] = (f32x4){0.f, 0.f, 0.f, 0.f}; o[1] = (f32x4){0.f, 0.f, 0.f, 0.f};
#pragma unroll
            for (int k2 = 0; k2 < 8; k2 += 2) {
                bf16x8 rf[2][2];
#pragma unroll
                for (int kk = 0; kk < 2; ++kk)
#pragma unroll
                    for (int eb = 0; eb < 2; ++eb) rf[kk][eb] = *(const LAS bf16x8*)(RT_c + (16 * eb + i16) * 544 + (32 * (k2 + kk) + 8 * g4) * 2);
                asm volatile("" ::: "memory");
#pragma unroll
                for (int kk = 0; kk < 2; ++kk)
#pragma unroll
                    for (int eb = 0; eb < 2; ++eb) o[eb] = MFMA16(rf[kk][eb], qf[k2 + kk], o[eb]);
            }
            bf16x8 vfi[4][2];
#pragma unroll
            for (int p = 0; p < 4; ++p)
#pragma unroll
                for (int eb = 0; eb < 2; ++eb) vfi[p][eb] = lds_tr_pair(V_t, 96, 32 * p + 4 * g4, 32 * p + 16 + 4 * g4, 16 * eb, lane);
            asm volatile("" ::: "memory");
#pragma unroll
            for (int p = 0; p < 4; ++p)
#pragma unroll
                for (int eb = 0; eb < 2; ++eb) o[eb] = MFMA16(vfi[p][eb], sf[p], o[eb]);
            { const size_t advq = (size_t)((n + 1 < NCHUNK) ? n + 1 : n) * 128 * LDT;
#pragma unroll
              for (int ks = 0; ks < 8; ++ks) qf[ks] = *(const bf16x8*)(qg + advq + 32 * ks); }
            { const size_t token = tb + (size_t)n * 128 + i; float s = 0.f, q = 0.f;
              { unsigned p0x = cvtpk(o[0][0], o[0][1]), p0y = cvtpk(o[0][2], o[0][3]), p1x = cvtpk(o[1][0], o[1][1]), p1y = cvtpk(o[1][2], o[1][3]);
                const auto rx = __builtin_amdgcn_permlane16_swap(p0x, p1x, false, false), ry = __builtin_amdgcn_permlane16_swap(p0y, p1y, false, false);
                v4u pk; pk.x = rx[0]; pk.y = ry[0]; pk.z = rx[1]; pk.w = ry[1];
                *(v4u*)(Opre + token * LDT + hc + 32 * es + 16 * (g4 & 1) + 8 * (g4 >> 1)) = pk; }
#pragma unroll
              for (int eb = 0; eb < 2; ++eb) {
#pragma unroll
                  for (int rr = 0; rr < 4; ++rr) { s += o[eb][rr]; q += o[eb][rr] * o[eb][rr]; } }
              s += __shfl_xor(s, 16); q += __shfl_xor(q, 16); s += __shfl_xor(s, 32); q += __shfl_xor(q, 32);
              if (g4 == 0) *(f32x2v*)(stats + ((token * 8 + h) * 8 + es) * 2) = (f32x2v){s, q}; }
            if (n + 1 < NCHUNK) {
#pragma unroll
                for (int k2 = 0; k2 < 4; k2 += 2) {
                    bf16x8 kfs[2][2], vfs[2][2];
#pragma unroll
                    for (int kk = 0; kk < 2; ++kk) { kfs[kk][0] = lds_tr_frag_c(K_t, 544, 32 * (k2 + kk), 32 * w, lane); kfs[kk][1] = lds_tr_frag_c(K_t, 544, 32 * (k2 + kk), 32 * w + 16, lane);
                        vfs[kk][0] = lds_tr_frag_c(V_t, 96, 32 * (k2 + kk), 0, lane); vfs[kk][1] = lds_tr_frag_c(V_t, 96, 32 * (k2 + kk), 16, lane); }
                    asm volatile("" ::: "memory");
#pragma unroll
                    for (int kk = 0; kk < 2; ++kk) { r[0][0] = MFMA16(kfs[kk][0], vfs[kk][0], r[0][0]); r[0][1] = MFMA16(kfs[kk][0], vfs[kk][1], r[0][1]);
                        r[1][0] = MFMA16(kfs[kk][1], vfs[kk][0], r[1][0]); r[1][1] = MFMA16(kfs[kk][1], vfs[kk][1], r[1][1]); }
                }
#pragma unroll
                for (int a = 0; a < 2; ++a)
#pragma unroll
                    for (int c = 0; c < 2; ++c) r[a][c] = r[a][c] * gamma_c;
#pragma unroll
                for (int db = 0; db < 2; ++db)
#pragma unroll
                    for (int eb = 0; eb < 2; ++eb) { u32x2 pk; pk.x = cvtpk(r[db][eb][0], r[db][eb][1]); pk.y = cvtpk(r[db][eb][2], r[db][eb][3]);
                        *(LAS u32x2*)(RT_n + (16 * eb + i16) * 544 + (32 * w + 16 * db + 4 * g4) * 2) = pk; }
            }
        }
        LDS_BARRIER();
    }
}
__device__ __forceinline__ void phase_sgumix2(LAS unsigned char* lds, const bf16* WM, const bf16* VS, const float* sgst, const float* lngain, bf16* U, const float* sb, int vcu, int G, int tid) {
    asm volatile("" : "+v"(tid));
    const int lane = tid & 63, w = __builtin_amdgcn_readfirstlane(tid >> 6), i16 = lane & 15, g4 = lane >> 4;
    LAS unsigned char* W_t = lds;
    LAS unsigned char* V_t = lds + 34816;
    LAS float* mr = (LAS float*)(lds + 102400);
    LAS float* sbl = (LAS float*)(lds + 103424);
    for (int bn = vcu; bn < BATCH * NCHUNK; bn += G) {
        const size_t t0 = (size_t)bn * 128;
        LDS_BARRIER();
        if (tid < 128) { const f32x4* sp = (const f32x4*)(sgst + (t0 + tid) * 64); float s = 0.f, q = 0.f;
#pragma unroll
            for (int k = 0; k < 16; ++k) { const f32x4 v = sp[k]; s += v[0]; q += v[1]; s += v[2]; q += v[3]; }
            const float mean = s * (1.0f / 2048.0f), var = q * (1.0f / 2048.0f) - mean * mean;
            mr[tid * 2] = mean; mr[tid * 2 + 1] = 1.0f / sqrtf(fmaxf(var, 0.f) + EPS); }
        { const f32x2v b2 = *(const f32x2v*)(sb + tid * 2); sbl[tid * 2] = b2.x; sbl[tid * 2 + 1] = b2.y; }
        v4u wpre[4], vpre[8]; f32x4 gpre[2];
        const bf16* vg = VS + (t0 + (tid >> 5)) * LDT + (tid & 31) * 8;
        const bf16* wg = WM + (tid >> 4) * 128 + (tid & 15) * 8;
#pragma unroll
        for (int k = 0; k < 4; ++k) wpre[k] = *(const v4u*)(wg + k * 32 * 128);
#pragma unroll
        for (int k = 0; k < 8; ++k) vpre[k] = *(const v4u*)(vg + (size_t)k * 16 * LDT);
        gpre[0] = *(const f32x4*)(lngain + (tid & 31) * 8); gpre[1] = *(const f32x4*)(lngain + (tid & 31) * 8 + 4);
        for (int g = 0; g < 8; ++g) {
            const int c0 = g * 256;
            LDS_BARRIER();
#pragma unroll
            for (int k = 0; k < 4; ++k) *(LAS v4u*)(W_t + ((tid >> 4) + 32 * k) * 272 + (tid & 15) * 16) = wpre[k];
#pragma unroll
            for (int k = 0; k < 8; ++k) { const int row = (tid >> 5) + 16 * k; const float mean = mr[row * 2], rstd = mr[row * 2 + 1]; const v4u x = vpre[k];
                v4u o; o.x = cvtpk((bflo(x.x) - mean) * rstd * gpre[0][0], (bfhi(x.x) - mean) * rstd * gpre[0][1]); o.y = cvtpk((bflo(x.y) - mean) * rstd * gpre[0][2], (bfhi(x.y) - mean) * rstd * gpre[0][3]);
                o.z = cvtpk((bflo(x.z) - mean) * rstd * gpre[1][0], (bfhi(x.z) - mean) * rstd * gpre[1][1]); o.w = cvtpk((bflo(x.w) - mean) * rstd * gpre[1][2], (bfhi(x.w) - mean) * rstd * gpre[1][3]);
                *(LAS v4u*)(V_t + row * 528 + (tid & 31) * 16) = o; }
            { const int gn = (g + 1 < 8) ? g + 1 : g;
#pragma unroll
              for (int k = 0; k < 4; ++k) wpre[k] = *(const v4u*)(wg + (size_t)gn * 16384 + k * 32 * 128);
#pragma unroll
              for (int k = 0; k < 8; ++k) vpre[k] = *(const v4u*)(vg + gn * 256 + (size_t)k * 16 * LDT);
              gpre[0] = *(const f32x4*)(lngain + gn * 256 + (tid & 31) * 8); gpre[1] = *(const f32x4*)(lngain + gn * 256 + (tid & 31) * 8 + 4); }
            LDS_BARRIER();
            v4u ul[8];
#pragma unroll
            for (int ib = 0; ib < 8; ++ib) ul[ib] = *(const v4u*)(U + (t0 + 16 * ib + i16) * LDT + c0 + 32 * w + 16 * (g4 & 1) + 8 * (g4 >> 1));
            f32x4 acc[2][8];
#pragma unroll
            for (int a = 0; a < 2; ++a)
#pragma unroll
                for (int b = 0; b < 8; ++b) acc[a][b] = (f32x4){0.f, 0.f, 0.f, 0.f};
#pragma unroll
            for (int ks = 0; ks < 4; ++ks) {
                const bf16x8 vf0 = lds_tr_frag(V_t, 528, 32 * ks, 32 * w, lane), vf1 = lds_tr_frag(V_t, 528, 32 * ks, 32 * w + 16, lane);
#pragma unroll
                for (int ib = 0; ib < 8; ++ib) if (2 * ks <= ib) {
                    const bf16x8 wf = *(const LAS bf16x8*)(W_t + (16 * ib + i16) * 272 + (32 * ks + 8 * g4) * 2);
                    acc[0][ib] = MFMA16(vf0, wf, acc[0][ib]); acc[1][ib] = MFMA16(vf1, wf, acc[1][ib]); }
            }
#pragma unroll
            for (int ib = 0; ib < 8; ++ib) { const int i = 16 * ib + i16; const float bias = sbl[g * 128 + i];
                u32x2 o[2];
                const auto lx = __builtin_amdgcn_permlane16_swap(ul[ib].x, ul[ib].z, false, false), ly = __builtin_amdgcn_permlane16_swap(ul[ib].y, ul[ib].w, false, false);
#pragma unroll
                for (int cb = 0; cb < 2; ++cb) { const unsigned xx = lx[cb], xy = ly[cb]; const f32x4 a = acc[cb][ib];
                    o[cb].x = cvtpk(bflo(xx) * (a[0] + bias), bfhi(xx) * (a[1] + bias)); o[cb].y = cvtpk(bflo(xy) * (a[2] + bias), bfhi(xy) * (a[3] + bias)); }
                const auto sx = __builtin_amdgcn_permlane16_swap(o[0].x, o[1].x, false, false), sy = __builtin_amdgcn_permlane16_swap(o[0].y, o[1].y, false, false);
                v4u so; so.x = sx[0]; so.y = sy[0]; so.z = sx[1]; so.w = sy[1];
                *(v4u*)(U + (t0 + i) * LDT + c0 + 32 * w + 16 * (g4 & 1) + 8 * (g4 >> 1)) = so; }
        }
    }
    LDS_BARRIER();
}
__device__ __forceinline__ void phase_retln(const bf16* Opre, const float* stats, const bf16* Gi, bf16* Gt, const float* gn, int gw, int NGW, int lane) {
    asm volatile("" : "+v"(lane));
    const int hs = lane >> 5, eo = 8 * (lane & 31);
    f32x4 ga[4], gb[4];
#pragma unroll
    for (int j = 0; j < 4; ++j) { ga[j] = *(const f32x4*)(gn + (2 * j + hs) * 256 + eo); gb[j] = *(const f32x4*)(gn + (2 * j + hs) * 256 + eo + 4); }
    for (int m = gw; m < M; m += NGW) {
        f32x2v st = *(const f32x2v*)(stats + ((size_t)m * 64 + lane) * 2);
        float s = st.x, q = st.y;
        s += __shfl_xor(s, 1); q += __shfl_xor(q, 1); s += __shfl_xor(s, 2); q += __shfl_xor(q, 2); s += __shfl_xor(s, 4); q += __shfl_xor(q, 4);
        const float mean_l = s * (1.0f / 256.0f), var_l = q * (1.0f / 256.0f) - mean_l * mean_l, rstd_l = 1.0f / sqrtf(fmaxf(var_l, 0.f) + EPS);
        const v4u* op = (const v4u*)(Opre + (size_t)m * LDT) + lane; v4u* gp = (v4u*)(Gt + (size_t)m * LDT) + lane; const v4u* gi = (const v4u*)(Gi + (size_t)m * LDT) + lane;
#pragma unroll
        for (int j = 0; j < 4; ++j) { const float mean = __shfl(mean_l, 8 * (2 * j + hs)), rstd = __shfl(rstd_l, 8 * (2 * j + hs));
            const v4u ow = op[64 * j], gw2 = gi[64 * j];
            v4u y; y.x = cvtpk((bflo(ow.x) - mean) * rstd * ga[j][0] * bflo(gw2.x), (bfhi(ow.x) - mean) * rstd * ga[j][1] * bfhi(gw2.x));
            y.y = cvtpk((bflo(ow.y) - mean) * rstd * ga[j][2] * bflo(gw2.y), (bfhi(ow.y) - mean) * rstd * ga[j][3] * bfhi(gw2.y));
            y.z = cvtpk((bflo(ow.z) - mean) * rstd * gb[j][0] * bflo(gw2.z), (bfhi(ow.z) - mean) * rstd * gb[j][1] * bfhi(gw2.z));
            y.w = cvtpk((bflo(ow.w) - mean) * rstd * gb[j][2] * bflo(gw2.w), (bfhi(ow.w) - mean) * rstd * gb[j][3] * bfhi(gw2.w));
            gp[64 * j] = y; }
    }
}

__device__ __forceinline__ int fresh_tid() { int t = threadIdx.x; asm volatile("" : "+v"(t)); return t; }
struct Args { const void* in[19]; float* out; unsigned char* ws; };
__global__ void __launch_bounds__(NWAVES * 64, 2) fwd(Args args) {
    extern __shared__ __attribute__((aligned(16))) unsigned char lds_raw[];
    LAS unsigned char* lds = (LAS unsigned char*)lds_raw;
    volatile LAS unsigned* MISC = (volatile LAS unsigned*)(lds + MISC_OFF);
#define TID fresh_tid()
#define LANE (fresh_tid() & 63)
    const int wave = __builtin_amdgcn_readfirstlane(TID >> 6);
    const int G = gridDim.x; const int bx = blockIdx.x; const int vcu = (G % 8 == 0) ? (bx % 8) * (G / 8) + bx / 8 : bx;
    const int gw = vcu * NWAVES + wave, NGW = G * NWAVES;
    unsigned char* ws = args.ws; float* X = args.out;
    for (int u = TID; u < (LDS_BYTES - LDSCTL_OFF) / 4; u += NWAVES * 64) ((LAS unsigned*)(lds + LDSCTL_OFF))[u] = 0u;
    __syncthreads();
    XcdBarrier bar = xcd_barrier_post((unsigned*)(ws + WS_CTL) + CW_BAR, MISC + 8);

    bf16* Hb = (bf16*)(ws + WS_H);
    bf16* BIG = (bf16*)(ws + WS_BIG);
    bf16 *tQ = BIG, *tK = BIG + TSTRIDE, *tV = BIG + 2 * TSTRIDE, *tG = BIG + 3 * TSTRIDE, *tU = BIG + 4 * TSTRIDE, *tVS = BIG + 5 * TSTRIDE, *tGA = BIG + 6 * TSTRIDE, *tGB = BIG + 7 * TSTRIDE;
    unsigned* CS = (unsigned*)(ws + WS_CS);
    bf16* RT = (bf16*)(ws + WS_RT);

    float* SSQ = (float*)(ws + WS_SSQ);
    {
        for (int m = gw; m < M; m += NGW) {
            const f32x4* xr = (const f32x4*)((const float*)args.in[0] + (size_t)m * D) + 2 * LANE; v4u* ho = (v4u*)(Hb + (size_t)m * LDT) + LANE;
            float sq = 0.f;
#pragma unroll
            for (int j = 0; j < 4; ++j) { const f32x4 v = xr[128 * j], v2 = xr[128 * j + 1]; v4u w; w.x = cvtpk(v[0], v[1]); w.y = cvtpk(v[2], v[3]); w.z = cvtpk(v2[0], v2[1]); w.w = cvtpk(v2[2], v2[3]); ho[64 * j] = w;
                sq += ((v[0] * v[0] + v[1] * v[1]) + (v[2] * v[2] + v[3] * v[3])) + ((v2[0] * v2[0] + v2[1] * v2[1]) + (v2[2] * v2[2] + v2[3] * v2[3])); }
            sq = wave_sum(sq);
            if (LANE < 32) SSQ[(size_t)m * 32 + LANE] = (LANE == 0) ? sq : 0.0f;
        }
        const size_t gt = (size_t)bx * (NWAVES * 64) + TID, gs = (size_t)G * (NWAVES * 64);
        const int* pos = (const int*)args.in[1];
        for (size_t i = gt; i < (size_t)M * 128; i += gs) { const int tkn = (int)(i >> 7), j = (int)(i & 127);
            double inv = 0.15915494309189535;
            inv *= (j & 1) ? 0.930572040929699 : 1.0; inv *= (j & 2) ? 0.8659643233600653 : 1.0; inv *= (j & 4) ? 0.7498942093324559 : 1.0; inv *= (j & 8) ? 0.5623413251903491 : 1.0;
            inv *= (j & 16) ? 0.31622776601683794 : 1.0; inv *= (j & 32) ? 0.1 : 1.0; inv *= (j & 64) ? 0.01 : 1.0;
            double t = (double)pos[tkn] * inv; t -= floor(t); const float tf = (float)t;
            pg8::h2_t hv; hv.x = (_Float16)__builtin_amdgcn_cosf(tf); hv.y = (_Float16)__builtin_amdgcn_sinf(tf); CS[i] = __builtin_bit_cast(unsigned, hv); }
    }
    for (int it = 0; it < 2 * DEPTH; ++it) {
        const int l = it >> 1, second = it & 1;
        if (!second) {
            ConvSrc cs;
            cs.gu1 = (const float*)args.in[3] + (size_t)l * D * 2 * FF; cs.d1 = (const float*)args.in[4] + (size_t)l * FF * D; cs.win = (const float*)args.in[6] + (size_t)l * D * INCOLS;
            cs.br = (const float*)args.in[12] + (size_t)l * D * D; cs.bs = (const float*)args.in[13] + (size_t)l * D * D; cs.wo = (const float*)args.in[14] + (size_t)l * D * D;
            cs.gu2 = (const float*)args.in[16] + (size_t)l * D * 2 * FF; cs.d2 = (const float*)args.in[17] + (size_t)l * FF * D; cs.sw = (const float*)args.in[10] + (size_t)l * 8 * 128 * 128;
            cs.g1 = (const float*)args.in[2] + (size_t)l * D; cs.gm = (const float*)args.in[5] + (size_t)l * D; cs.g2 = (const float*)args.in[15] + (size_t)l * D;
            phase_conv(lds, ws, cs, gw, NGW, wave, LANE);
            xcd_barrier(bar);
        }
        {
            const int ci = 3 * l + (second ? 2 : 0);
            pg8::Gemm g{Hb, (const bf16*)(ws + (second ? WS_WGU2 : WS_WGU1)), M, 2 * FF, D, LDT, D}; pg8::StaticOrder S; S.init(M, 2 * FF, G, bx);
            pg8::EpiSwiglu E{BIG, FF, SSQ + (size_t)ci * SSQ_STRIDE, (LAS float*)(lds + RS_OFF), -1};
            pg8::gemm_phase<pg8::EpiSwiglu, pg8::StaticOrder, true, true>(lds, g, S, E);
        }
        xcd_barrier(bar);
        {
            const int pi = 3 * l + (second ? 3 : 1);
            pg8::Gemm g{BIG, (const bf16*)(ws + (second ? WS_WD2 : WS_WD1)), M, D, FF, FF, FF}; pg8::ReverseOrder S; S.init(M, D, G, bx);
            pg8::EpiResid E{0.5f, Hb, SSQ + (size_t)pi * SSQ_STRIDE};
            pg8::gemm_phase<pg8::EpiResid, pg8::ReverseOrder, true, true>(lds, g, S, E);
        }
        xcd_barrier(bar);
        if (!second) {
            {
                const int ci = 3 * l + 1;
                pg8::Gemm g{Hb, (const bf16*)(ws + WS_WIN), M, INCOLS, D, LDT, D}; pg8::StaticOrder S; S.init(M, INCOLS, G, bx);
                pg8::EpiIn E{BIG, TSTRIDE, CS, (const float*)args.in[7] + (size_t)l * 2 * D, SSQ + (size_t)ci * SSQ_STRIDE, (LAS float*)(lds + RS_OFF), -1, (float*)(ws + WS_SGST)};
                pg8::gemm_phase<pg8::EpiIn, pg8::StaticOrder, true, true>(lds, g, S, E);
            }
            xcd_barrier(bar);
            phase_ret(lds, tQ, tK, tV, (bf16*)(ws + WS_OPRE), (float*)(ws + WS_RT), vcu, G, TID);
            xcd_barrier(bar);
            phase_sgumix2(lds, (const bf16*)(ws + WS_WMASK), tVS, (const float*)(ws + WS_SGST), (const float*)args.in[9] + (size_t)l * 2048, tU, (const float*)args.in[11] + (size_t)l * 8 * 128, vcu, G, TID);
            phase_retln((const bf16*)(ws + WS_OPRE), (const float*)(ws + WS_RT), tG, tG, (const float*)args.in[8] + (size_t)l * 2048, gw, NGW, LANE);
            xcd_barrier(bar);
            {
                pg8::Gemm g{tG, (const bf16*)(ws + WS_WBR), M, D, D, LDT, D}; pg8::DualOrder S; S.init(M, D, G, bx); S.A2 = tU; S.B2 = (const bf16*)(ws + WS_WBS);
                pg8::EpiBr<2> E{tQ, tGA, tGB};
                pg8::gemm_phase<pg8::EpiBr<2>, pg8::DualOrder, true, true>(lds, g, S, E);
            }
            xcd_barrier(bar);
            {
                const int pi = 3 * l + 2;
                pg8::Gemm g{tQ, (const bf16*)(ws + WS_WOUT), M, D, D, LDT, D}; pg8::StaticOrder S; S.init(M, D, G, bx);
                pg8::EpiResid E{1.0f, Hb, SSQ + (size_t)pi * SSQ_STRIDE};
                pg8::gemm_phase<pg8::EpiResid, pg8::StaticOrder, true, true>(lds, g, S, E);
            }
            xcd_barrier(bar);
        }
    }
    phase_final(Hb, X, (const float*)args.in[18], gw, NGW, LANE);
}

extern "C" void kernel_launch(void* const* d_in, const int* in_sizes, int n_in, void* d_out, int out_size, void* d_ws, size_t ws_size, hipStream_t stream) {
    static int grid = 0;
    if (grid == 0) {
        if (n_in != 19 || in_sizes[0] != M * D || out_size != M * D || ws_size < WS_END) { fprintf(stderr, "kernel_launch: unexpected shapes / workspace (n_in %d, in0 %d, out %d, ws %zu, need %zu); nothing launched\n", n_in, n_in > 0 ? in_sizes[0] : -1, out_size, ws_size, (size_t)WS_END); grid = -1; return; }
        int dev = 0, cus = 0, per_cu = 0;
        if (hipGetDevice(&dev) != hipSuccess || hipDeviceGetAttribute(&cus, hipDeviceAttributeMultiprocessorCount, dev) != hipSuccess) { fprintf(stderr, "kernel_launch: device query failed\n"); grid = -1; return; }
        if (hipFuncSetAttribute((const void*)fwd, hipFuncAttributeMaxDynamicSharedMemorySize, LDS_BYTES) != hipSuccess) { fprintf(stderr, "kernel_launch: hipFuncSetAttribute failed\n"); grid = -1; return; }
        if (hipOccupancyMaxActiveBlocksPerMultiprocessor(&per_cu, (const void*)fwd, NWAVES * 64, LDS_BYTES) != hipSuccess || per_cu < 1) fprintf(stderr, "kernel_launch: note: occupancy query reports %d workgroups per CU\n", per_cu);
        (void)hipGetLastError();
        grid = cus;
    }
    if (grid < 0) return;
    if (hipMemsetAsync((char*)d_ws + WS_CTL, 0, CTL_ZERO_BYTES, stream) != hipSuccess) { fprintf(stderr, "kernel_launch: memset failed\n"); return; }
    Args a{};
    for (int i = 0; i < 19; ++i) a.in[i] = d_in[i];
    a.out = (float*)d_out; a.ws = (unsigned char*)d_ws;
    hipLaunchKernelGGL(fwd, dim3(grid), dim3(NWAVES * 64), LDS_BYTES, stream, a);
    const hipError_t le = hipPeekAtLastError();
    if (le != hipSuccess) fprintf(stderr, "kernel_launch: launch failed: %s\n", hipGetErrorName(le));
}
```
